# Optimizing an MI355X kernel written in HIP

```python
import math
import jax
import jax.numpy as jnp
from jax import lax
import numpy as np

D_MODEL = 1024
BATCH = 4
SEQ = 8192
DEPTH = 2

HEAD_DIM = 64
SB_HEADS = 4
MOBA_HEADS = 4
NSA_HEADS = 8
NSA_KV_GROUPS = 2
NSA_HPG = NSA_HEADS // NSA_KV_GROUPS
N_BRANCHES = 3
SB_WIDTH = SB_HEADS * HEAD_DIM
MOBA_WIDTH = MOBA_HEADS * HEAD_DIM
NSA_WIDTH = NSA_HEADS * HEAD_DIM
NSA_KV_WIDTH = NSA_KV_GROUPS * HEAD_DIM
MIX_WIDTH = SB_WIDTH + MOBA_WIDTH + NSA_WIDTH
N_IN = 3 * SB_WIDTH + 3 * MOBA_WIDTH + NSA_WIDTH + 6 * NSA_KV_WIDTH + N_BRANCHES * NSA_HEADS + N_BRANCHES * D_MODEL

SB_Q_BLOCK = 128
SPARSE_Q_BLOCK = 64
MOBA_BLOCK = 256
MOBA_TOPK = 3
CMP_BLOCK = 32
CMP_STRIDE = 16
CMP_HIDDEN = 4 * HEAD_DIM
SLC_BLOCK = 64
SLC_TOPN = 16
WINDOW = 512
N_BUCKETS = 32
REL_MAX_DISTANCE = 128
N_BIAS_HEADS = MOBA_HEADS + NSA_HEADS
D_FF = -(-8 * D_MODEL // (3 * 256)) * 256
NORM_EPS = 1e-6
NEG = -1e30
BIG = 1e30
TINY = 1e-30

kernel_name = 'hybrid_stickbreak_moba_nsa_block'


def rms_norm(x, g):
    xf = x.astype(jnp.float32)
    y = xf * lax.rsqrt(jnp.mean(xf * xf, axis=-1, keepdims=True) + NORM_EPS)
    return (y * g.astype(jnp.float32)).astype(x.dtype)


def masked_softmax(logits, mask):
    l = jnp.where(mask, logits.astype(jnp.float32), NEG)
    p = jnp.where(mask, jnp.exp(l - jnp.max(l, axis=-1, keepdims=True)), 0.0)
    return p / jnp.maximum(jnp.sum(p, axis=-1, keepdims=True), TINY)


def t5_bucket(dist):
    n = jnp.maximum(dist, 0)
    max_exact = N_BUCKETS // 2
    nf = jnp.maximum(n, 1).astype(jnp.float32)
    large = max_exact + (jnp.log(nf / max_exact) / math.log(REL_MAX_DISTANCE / max_exact) * (N_BUCKETS - max_exact)).astype(jnp.int32)
    large = jnp.minimum(large, N_BUCKETS - 1)
    return jnp.where(n < max_exact, n, large)


def to_heads(t, n_heads):
    b, s, _ = t.shape
    return t.reshape(b, s, n_heads, HEAD_DIM).transpose(0, 2, 1, 3)


def from_heads(t):
    b, h, s, d = t.shape
    return t.transpose(0, 2, 1, 3).reshape(b, s, h * d)


def stick_breaking_attention(q, k, v):
    s_len = q.shape[2]
    scale = HEAD_DIM ** -0.5
    outs = []
    for blk in range(s_len // SB_Q_BLOCK):
        q0 = blk * SB_Q_BLOCK
        kl = q0 + SB_Q_BLOCK
        z = jnp.einsum('bhqd,bhkd->bhqk', q[:, :, q0:kl], k[:, :, :kl]).astype(jnp.float32) * scale
        causal = jnp.arange(kl)[None, :] < (q0 + jnp.arange(SB_Q_BLOCK))[:, None]
        log_stay = jnp.where(causal, jax.nn.log_sigmoid(-z), 0.0)
        log_after = lax.cumsum(log_stay, axis=3, reverse=True) - log_stay
        a = jnp.where(causal, jnp.exp(jax.nn.log_sigmoid(z) + log_after), 0.0)
        outs.append(jnp.einsum('bhqk,bhkd->bhqd', a.astype(v.dtype), v[:, :, :kl]))
    return jnp.concatenate(outs, axis=2)


def moba_attention(q, k, v, tbl):
    b, h, s_len, d = q.shape
    qb = SPARSE_Q_BLOCK
    nblk = -(-s_len // MOBA_BLOCK)
    pad = nblk * MOBA_BLOCK - s_len
    kp = jnp.pad(k, ((0, 0), (0, 0), (0, pad), (0, 0)))
    vp = jnp.pad(v, ((0, 0), (0, 0), (0, pad), (0, 0)))
    kb = kp.reshape(b, h, nblk, MOBA_BLOCK, d)
    vb = vp.reshape(b, h, nblk, MOBA_BLOCK, d)
    kmean = jnp.mean(kb.astype(jnp.float32), axis=3).astype(k.dtype)
    topk = min(MOBA_TOPK, nblk)
    scale = HEAD_DIM ** -0.5
    bi = jnp.arange(b)[:, None, None, None]
    hi = jnp.arange(h)[None, :, None, None]
    hb = jnp.arange(h)[None, :, None, None, None]
    in_blk = jnp.arange(MOBA_BLOCK)
    blk_ids = jnp.arange(nblk)

    def chunk(c):
        q0 = c * qb
        tpos = q0 + jnp.arange(qb)
        cur = q0 // MOBA_BLOCK
        qc = lax.dynamic_slice_in_dim(q, q0, qb, axis=2)
        score = jnp.einsum('bhqd,bhnd->bhqn', qc, kmean).astype(jnp.float32)
        score = jnp.where(blk_ids < cur, score, NEG)
        _, idx = lax.top_k(score, topk)
        k_sel = kb[bi, hi, idx]
        v_sel = vb[bi, hi, idx]
        pos_sel = idx[..., None] * MOBA_BLOCK + in_blk
        l_sel = jnp.einsum('bhqd,bhqnkd->bhqnk', qc, k_sel).astype(jnp.float32) * scale
        l_sel = l_sel + tbl[hb, t5_bucket(tpos[:, None, None] - pos_sel)]
        own0 = cur * MOBA_BLOCK
        k_own = lax.dynamic_slice_in_dim(kp, own0, MOBA_BLOCK, axis=2)
        v_own = lax.dynamic_slice_in_dim(vp, own0, MOBA_BLOCK, axis=2)
        dist_own = tpos[:, None] - (own0 + in_blk)[None, :]
        l_own = jnp.einsum('bhqd,bhkd->bhqk', qc, k_own).astype(jnp.float32) * scale + tbl[:, t5_bucket(dist_own)]
        m_sel = jnp.broadcast_to((jnp.arange(topk) < cur)[:, None], (topk, MOBA_BLOCK)).reshape(topk * MOBA_BLOCK)
        mask = jnp.concatenate([jnp.broadcast_to(m_sel, (qb, topk * MOBA_BLOCK)), dist_own >= 0], axis=-1)
        logits = jnp.concatenate([l_sel.reshape(b, h, qb, topk * MOBA_BLOCK), l_own], axis=-1)
        p = masked_softmax(logits, mask)
        p_sel = p[..., :topk * MOBA_BLOCK].reshape(b, h, qb, topk, MOBA_BLOCK).astype(v.dtype)
        p_own = p[..., topk * MOBA_BLOCK:].astype(v.dtype)
        return jnp.einsum('bhqnk,bhqnkd->bhqd', p_sel, v_sel) + jnp.einsum('bhqk,bhkd->bhqd', p_own, v_own)

    o = lax.map(chunk, jnp.arange(s_len // qb))
    return o.transpose(1, 2, 0, 3, 4).reshape(b, h, s_len, d)


def nsa_compress(t, pos, w1, w2):
    b, g, s_len, d = t.shape
    n_cmp = (s_len - CMP_BLOCK) // CMP_STRIDE + 1
    idx = np.arange(n_cmp)[:, None] * CMP_STRIDE + np.arange(CMP_BLOCK)[None, :]
    blocks = (t[:, :, idx] + pos).reshape(b, g, n_cmp, CMP_BLOCK * d)
    return jax.nn.gelu(blocks @ w1) @ w2


def nsa_attention(q, k_cmp, v_cmp, k_slc, v_slc, k_win, v_win, gates, k_cmp_norm, cmp_pos, cmp_w1, cmp_w2, tbl):
    b, g, hpg, s_len, d = q.shape
    qb = SPARSE_Q_BLOCK
    scale = HEAD_DIM ** -0.5
    n_cmp = (s_len - CMP_BLOCK) // CMP_STRIDE + 1
    cmp_start = np.arange(n_cmp) * CMP_STRIDE
    cmp_end = jnp.asarray(cmp_start + CMP_BLOCK - 1)
    kc = rms_norm(nsa_compress(k_cmp, cmp_pos[0], cmp_w1[0], cmp_w2[0]), k_cmp_norm)
    vc = nsa_compress(v_cmp, cmp_pos[1], cmp_w1[1], cmp_w2[1])
    n_slc = s_len // SLC_BLOCK
    slc_start = np.arange(n_slc) * SLC_BLOCK
    overlap = jnp.asarray(((cmp_start[:, None] < slc_start[None, :] + SLC_BLOCK)
                           & (cmp_start[:, None] + CMP_BLOCK > slc_start[None, :])).astype(np.float32))
    n_sel = min(SLC_TOPN, n_slc)
    ks_blk = k_slc.reshape(b, g, n_slc, SLC_BLOCK, d)
    vs_blk = v_slc.reshape(b, g, n_slc, SLC_BLOCK, d)
    kw_pad = jnp.pad(k_win, ((0, 0), (0, 0), (WINDOW, 0), (0, 0)))
    vw_pad = jnp.pad(v_win, ((0, 0), (0, 0), (WINDOW, 0), (0, 0)))
    bi = jnp.arange(b)[:, None, None, None]
    gi = jnp.arange(g)[None, :, None, None]
    gb = jnp.arange(g)[None, :, None, None, None, None]
    hb = jnp.arange(hpg)[None, None, :, None, None, None]
    blk_ids = jnp.arange(n_slc)
    in_blk = jnp.arange(SLC_BLOCK)
    win_off = jnp.arange(qb + WINDOW)

    def chunk(c):
        q0 = c * qb
        tpos = q0 + jnp.arange(qb)
        qc = lax.dynamic_slice_in_dim(q, q0, qb, axis=3)
        dist_c = tpos[:, None] - cmp_end[None, :]
        l_c = jnp.einsum('bghqd,bgnd->bghqn', qc, kc).astype(jnp.float32) * scale + tbl[:, :, t5_bucket(dist_c)]
        p_c = masked_softmax(l_c, dist_c >= 0)
        o_c = jnp.einsum('bghqn,bgnd->bghqd', p_c.astype(vc.dtype), vc)
        imp = jnp.einsum('bghqn,nm->bgqm', p_c, overlap)
        cur = tpos // SLC_BLOCK
        forced = (blk_ids == 0) | (blk_ids == cur[:, None]) | (blk_ids == cur[:, None] - 1)
        score = jnp.where(forced, BIG, imp)
        score = jnp.where(blk_ids <= cur[:, None], score, NEG)
        _, sidx = lax.top_k(score, n_sel)
        k_sel = ks_blk[bi, gi, sidx]
        v_sel = vs_blk[bi, gi, sidx]
        dist_s = tpos[:, None, None] - (sidx[..., None] * SLC_BLOCK + in_blk)
        l_s = jnp.einsum('bghqd,bgqnkd->bghqnk', qc, k_sel).astype(jnp.float32) * scale
        l_s = l_s + tbl[gb, hb, t5_bucket(dist_s)[:, :, None]]
        p_s = masked_softmax(l_s.reshape(b, g, hpg, qb, n_sel * SLC_BLOCK),
                             (dist_s >= 0).reshape(b, g, 1, qb, n_sel * SLC_BLOCK))
        o_s = jnp.einsum('bghqnk,bgqnkd->bghqd', p_s.reshape(b, g, hpg, qb, n_sel, SLC_BLOCK).astype(v_sel.dtype), v_sel)
        kwin = lax.dynamic_slice_in_dim(kw_pad, q0, qb + WINDOW, axis=2)
        vwin = lax.dynamic_slice_in_dim(vw_pad, q0, qb + WINDOW, axis=2)
        pos_w = q0 - WINDOW + win_off
        dist_w = tpos[:, None] - pos_w[None, :]
        m_w = (dist_w >= 0) & (dist_w < WINDOW) & (pos_w >= 0)[None, :]
        l_w = jnp.einsum('bghqd,bgkd->bghqk', qc, kwin).astype(jnp.float32) * scale + tbl[:, :, t5_bucket(dist_w)]
        p_w = masked_softmax(l_w, m_w)
        o_w = jnp.einsum('bghqk,bgkd->bghqd', p_w.astype(vwin.dtype), vwin)
        return o_c, o_s, o_w

    o_c, o_s, o_w = lax.map(chunk, jnp.arange(s_len // qb))

    def unchunk(o):
        return o.transpose(1, 2, 3, 0, 4, 5).reshape(b, g, hpg, s_len, d)

    return gates[0] * unchunk(o_c) + gates[1] * unchunk(o_s) + gates[2] * unchunk(o_w)


def split_points():
    widths = [SB_WIDTH] * 3 + [MOBA_WIDTH] * 3 + [NSA_WIDTH] + [NSA_KV_WIDTH] * 6 + [N_BRANCHES * NSA_HEADS, N_BRANCHES * D_MODEL]
    return [int(p) for p in np.cumsum(widths)[:-1]]


def hybrid_layer(x, rel_bias, attn_norm, w_in, moba_q_norm, moba_k_norm, nsa_q_norm, nsa_k_norm,
                 nsa_cmp_pos, nsa_cmp_w1, nsa_cmp_w2, w_branch, w_out, ffn_norm, w_gate_up, w_down):
    b, s_len, _ = x.shape
    h = rms_norm(x, attn_norm)
    (sb_q, sb_k, sb_v, mb_q, mb_k, mb_v, ns_q, ns_kc, ns_vc, ns_ks, ns_vs, ns_kw, ns_vw,
     ns_gate, br_gate) = jnp.split(h @ w_in, split_points(), axis=-1)
    tbl = rel_bias.T
    o_a = from_heads(stick_breaking_attention(to_heads(sb_q, SB_HEADS), to_heads(sb_k, SB_HEADS), to_heads(sb_v, SB_HEADS)))
    o_b = from_heads(moba_attention(rms_norm(to_heads(mb_q, MOBA_HEADS), moba_q_norm),
                                    rms_norm(to_heads(mb_k, MOBA_HEADS), moba_k_norm),
                                    to_heads(mb_v, MOBA_HEADS), tbl[:MOBA_HEADS]))
    nq = rms_norm(ns_q.reshape(b, s_len, NSA_KV_GROUPS, NSA_HPG, HEAD_DIM).transpose(0, 2, 3, 1, 4), nsa_q_norm)

    def kv(t):
        return t.reshape(b, s_len, NSA_KV_GROUPS, HEAD_DIM).transpose(0, 2, 1, 3)

    nsa_gates = jax.nn.sigmoid(ns_gate.reshape(b, s_len, 3, NSA_KV_GROUPS, NSA_HPG)).transpose(2, 0, 3, 4, 1)[..., None]
    o_c = nsa_attention(nq, kv(ns_kc), kv(ns_vc), rms_norm(kv(ns_ks), nsa_k_norm[1]), kv(ns_vs),
                        rms_norm(kv(ns_kw), nsa_k_norm[2]), kv(ns_vw), nsa_gates, nsa_k_norm[0],
                        nsa_cmp_pos, nsa_cmp_w1, nsa_cmp_w2,
                        tbl[MOBA_HEADS:].reshape(NSA_KV_GROUPS, NSA_HPG, N_BUCKETS))
    o_c = o_c.transpose(0, 3, 1, 2, 4).reshape(b, s_len, NSA_WIDTH)
    g = jax.nn.sigmoid(br_gate.reshape(b, s_len, N_BRANCHES, D_MODEL))
    mix = (g[:, :, 0] * (o_a @ w_branch[:SB_WIDTH])
           + g[:, :, 1] * (o_b @ w_branch[SB_WIDTH:SB_WIDTH + MOBA_WIDTH])
           + g[:, :, 2] * (o_c @ w_branch[SB_WIDTH + MOBA_WIDTH:]))
    x = x + mix @ w_out
    gate, up = jnp.split(rms_norm(x, ffn_norm) @ w_gate_up, 2, axis=-1)
    return x + (jax.nn.silu(gate) * up) @ w_down


def setup_inputs(seed: int = 0) -> dict:
    key = jax.random.key(seed)
    ks = jax.random.split(key, 18)

    def nrm(k, shape, scale):
        return jax.random.normal(k, shape, jnp.float32) * scale

    w_branch = jnp.concatenate([
        nrm(ks[11], (DEPTH, SB_WIDTH, D_MODEL), SB_WIDTH ** -0.5),
        nrm(ks[16], (DEPTH, MOBA_WIDTH, D_MODEL), MOBA_WIDTH ** -0.5),
        nrm(ks[17], (DEPTH, NSA_WIDTH, D_MODEL), NSA_WIDTH ** -0.5)], axis=1)
    return {
        'x': nrm(ks[0], (BATCH, SEQ, D_MODEL), 1.0),
        'rel_bias': nrm(ks[1], (N_BUCKETS, N_BIAS_HEADS), 0.2),
        'attn_norm': 1.0 + nrm(ks[2], (DEPTH, D_MODEL), 0.02),
        'w_in': nrm(ks[3], (DEPTH, D_MODEL, N_IN), D_MODEL ** -0.5),
        'moba_q_norm': 1.0 + nrm(ks[4], (DEPTH, HEAD_DIM), 0.02),
        'moba_k_norm': 1.0 + nrm(ks[5], (DEPTH, HEAD_DIM), 0.02),
        'nsa_q_norm': 1.0 + nrm(ks[6], (DEPTH, HEAD_DIM), 0.02),
        'nsa_k_norm': 1.0 + nrm(ks[7], (DEPTH, 3, HEAD_DIM), 0.02),
        'nsa_cmp_pos': nrm(ks[8], (DEPTH, 2, CMP_BLOCK, HEAD_DIM), 0.1),
        'nsa_cmp_w1': nrm(ks[9], (DEPTH, 2, CMP_BLOCK * HEAD_DIM, CMP_HIDDEN), (CMP_BLOCK * HEAD_DIM) ** -0.5),
        'nsa_cmp_w2': nrm(ks[10], (DEPTH, 2, CMP_HIDDEN, HEAD_DIM), CMP_HIDDEN ** -0.5),
        'w_branch': w_branch,
        'w_out': nrm(ks[12], (DEPTH, D_MODEL, D_MODEL), D_MODEL ** -0.5),
        'ffn_norm': 1.0 + nrm(ks[13], (DEPTH, D_MODEL), 0.02),
        'w_gate_up': nrm(ks[14], (DEPTH, D_MODEL, 2 * D_FF), D_MODEL ** -0.5),
        'w_down': nrm(ks[15], (DEPTH, D_FF, D_MODEL), D_FF ** -0.5),
    }


def reference(x, rel_bias, attn_norm, w_in, moba_q_norm, moba_k_norm, nsa_q_norm, nsa_k_norm,
              nsa_cmp_pos, nsa_cmp_w1, nsa_cmp_w2, w_branch, w_out, ffn_norm, w_gate_up, w_down):
    for layer in range(DEPTH):
        x = hybrid_layer(x, rel_bias, attn_norm[layer], w_in[layer], moba_q_norm[layer], moba_k_norm[layer],
                         nsa_q_norm[layer], nsa_k_norm[layer], nsa_cmp_pos[layer], nsa_cmp_w1[layer],
                         nsa_cmp_w2[layer], w_branch[layer], w_out[layer], ffn_norm[layer],
                         w_gate_up[layer], w_down[layer])
    return x
```

```cpp
#include <hip/hip_runtime.h>
#include <hip/hip_cooperative_groups.h>
#include <cstdio>
#include <cstdint>
namespace cg = cooperative_groups;
namespace pg8 {
#define PG8_LAS __attribute__((address_space(3)))
typedef unsigned short bf16_t;
typedef short bf16x8 __attribute__((ext_vector_type(8)));
typedef float f32x4 __attribute__((ext_vector_type(4)));
typedef unsigned u32x4 __attribute__((ext_vector_type(4)));
constexpr int BM = 256, BK = 64, HALF = 128, HTB = HALF * BK * 2  , STAGE_BYTES = 8 * HTB, NXCD = 8, WGM = 8;

__host__ __device__ __forceinline__ int lds_byte(int r, int c) { const int st = (r >> 4) * 2 + (c >> 5), rr = r & 15, cc = c & 31, ob = rr * 64 + cc * 2; return st * 1024 + (ob ^ (((ob >> 9) & 1) << 5)); }
__host__ __device__ __forceinline__ void stage_rc(int b, int& R, int& C) { const int st = b / 1024, sb = b % 1024, swz = sb ^ (((sb >> 9) & 1) << 5); R = (st >> 1) * 16 + swz / 64; C = (st & 1) * 32 + (swz % 64) / 2; }
__host__ __device__ __forceinline__ int perm32(int rho) { const int n = rho >> 4, i = rho & 15; return 8 * (i >> 2) + 4 * n + (i & 3); }

struct Unit { int pm, pn; };
struct Gemm { const bf16_t* A; const bf16_t* Bt; int M, N, K, lda, ldb; };

struct StaticOrder {
    int nM, nN, nwg, G, c;
    __host__ __device__ void init(int M, int N, int G_, int c_) { nM = M / BM; nN = N / BM; nwg = nM * nN; G = G_; c = c_; }
    __host__ __device__ bool next(int i, Unit& u) const {
        const long L = (long)i * G + c; if (L >= nwg) return false;
        int wgid = (int)L; { const int q = nwg / NXCD, r = nwg % NXCD, xcd = wgid % NXCD, off = wgid / NXCD; wgid = (xcd < r ? xcd * (q + 1) : r * (q + 1) + (xcd - r) * q) + off; }
        const int nig = WGM * nN, gid = wgid / nig, fm = gid * WGM, gsz = (nM - fm) < WGM ? (nM - fm) : WGM;
        u.pm = fm + ((wgid % nig) % gsz); u.pn = (wgid % nig) / gsz; return true;
    }
    __device__ __forceinline__ void a_ready(const Unit&) const {}
    __device__ __forceinline__ void done(const Unit&) const {}
};
template <class Epi, class Sched, bool ALIGN_EPI = false, bool SP2 = false>
__device__ __forceinline__ void gemm_phase(PG8_LAS unsigned char* lds, const Gemm g, const Sched& S, const Epi& E, int tid_in) {
    const int tid = tid_in, wid = __builtin_amdgcn_readfirstlane(tid >> 6), lane = tid & 63, wr = wid >> 2, wc = wid & 3, fr = lane & 15, fq = lane >> 4;
    const int K = g.K, nt = K / BK;
    unsigned voffA[2], voffB[2];
#pragma unroll
    for (int i = 0; i < 2; ++i) { int R, C; stage_rc(tid * 16 + i * 8192, R, C); const int Rb = Epi::PERM ? ((R & ~31) + perm32(R & 31)) : R;
        voffA[i] = (unsigned)(R * g.lda + C) * 2u; voffB[i] = (unsigned)(Rb * g.ldb + C) * 2u; }
    const size_t kstep = (size_t)(BK * 2);
    const size_t hstepA = (size_t)HALF * g.lda * 2, hstepB = (size_t)HALF * g.ldb * 2;
    const size_t tstepA = 2 * hstepA, tstepB = 2 * hstepB;
    const unsigned ldsw = (unsigned)wid * 1024u;
    const int aoff = lds_byte(wr * 64 + fr, fq * 8), boff = lds_byte(wc * 32 + fr, fq * 8);
#define PG8_SA(b, h) (((b) * 2 + (h)) * HTB)
#define PG8_SB(b, h) ((4 + (b) * 2 + (h)) * HTB)
#define PG8_STAGE(bufoff, gbase, voff) do { _Pragma("unroll") for (int _i = 0; _i < 2; ++_i) \
        __builtin_amdgcn_global_load_lds((const unsigned*)((const char*)(gbase) + (voff)[_i]), (PG8_LAS unsigned*)(lds + (bufoff) + ldsw + _i * 8192), 16, 0, 0); } while (0)
#define PG8_LDA(dst, b, h) do { _Pragma("unroll") for (int m = 0; m < 4; ++m) _Pragma("unroll") for (int k = 0; k < 2; ++k) dst[m][k] = *(const PG8_LAS bf16x8*)(lds + PG8_SA(b, h) + aoff + m * 2048 + k * 1024); } while (0)
#define PG8_LDB(dst, b, h) do { _Pragma("unroll") for (int n = 0; n < 2; ++n) _Pragma("unroll") for (int k = 0; k < 2; ++k) dst[n][k] = *(const PG8_LAS bf16x8*)(lds + PG8_SB(b, h) + boff + n * 2048 + k * 1024); } while (0)
#define PG8_MMA(ai, bj, At, Bt) do { __builtin_amdgcn_s_setprio(1); _Pragma("unroll") for (int m = 0; m < 4; ++m) _Pragma("unroll") for (int n = 0; n < 2; ++n) _Pragma("unroll") for (int k = 0; k < 2; ++k) \
        acc[ai][bj][m][n] = __builtin_amdgcn_mfma_f32_16x16x32_bf16(Bt[n][k], At[m][k], acc[ai][bj][m][n], 0, 0, 0); __builtin_amdgcn_s_setprio(0); } while (0)
#define PG8_WAIT_V(n) asm volatile("s_waitcnt vmcnt(" #n ")" ::: "memory")
#define PG8_WAIT_L(n) asm volatile("s_waitcnt lgkmcnt(" #n ")" ::: "memory")
#define PG8_BAR __builtin_amdgcn_s_barrier()
#define PG8_SCHED __builtin_amdgcn_sched_barrier(0)
    Unit cur, nxt; int ui = 0;
    if (!S.next(0, cur)) return;
    f32x4 acc[2][2][4][2];
#pragma unroll
    for (int a = 0; a < 2; ++a)
#pragma unroll
        for (int b = 0; b < 2; ++b)
#pragma unroll
            for (int m = 0; m < 4; ++m)
#pragma unroll
                for (int n = 0; n < 2; ++n) acc[a][b][m][n] = (f32x4){0.f, 0.f, 0.f, 0.f};
    bf16x8 At[4][2], B0[2][2], B1[2][2];
    const char* cA = (const char*)g.A + (size_t)cur.pm * tstepA; const char* cB = (const char*)g.Bt + (size_t)cur.pn * tstepB;
    S.a_ready(cur);
    if constexpr (SP2) {
        PG8_STAGE(PG8_SB(0, 0), cB, voffB); PG8_STAGE(PG8_SB(0, 1), cB + hstepB, voffB); PG8_STAGE(PG8_SA(0, 0), cA, voffA); PG8_STAGE(PG8_SA(0, 1), cA + hstepA, voffA);
        if (wr == 1) PG8_BAR;
        PG8_WAIT_V(2); PG8_BAR;
        PG8_STAGE(PG8_SB(1, 0), cB + kstep, voffB); PG8_STAGE(PG8_SA(1, 0), cA + kstep, voffA); PG8_STAGE(PG8_SB(1, 1), cB + hstepB + kstep, voffB);
        PG8_WAIT_V(6); PG8_BAR;
    } else {
        PG8_STAGE(PG8_SB(0, 0), cB, voffB); PG8_STAGE(PG8_SA(0, 0), cA, voffA); PG8_STAGE(PG8_SB(0, 1), cB + hstepB, voffB); PG8_STAGE(PG8_SA(0, 1), cA + hstepA, voffA);
        if (wr == 1) PG8_BAR;
        PG8_WAIT_V(4); PG8_BAR;
        PG8_STAGE(PG8_SB(1, 0), cB + kstep, voffB); PG8_STAGE(PG8_SA(1, 0), cA + kstep, voffA); PG8_STAGE(PG8_SB(1, 1), cB + hstepB + kstep, voffB);
        PG8_WAIT_V(6); PG8_BAR;
    }
    for (;;) {
        const bool has_next = S.next(ui + 1, nxt);
        const char* nA = has_next ? (const char*)g.A + (size_t)nxt.pm * tstepA : cA; const char* nB = has_next ? (const char*)g.Bt + (size_t)nxt.pn * tstepB : cB;
#pragma unroll 1
        for (int t = 0; t < nt; t += 2) {
            const bool last = (t == nt - 2);
            const char* a1 = cA + (size_t)(t + 1) * kstep;
            const char* a2 = last ? nA : cA + (size_t)(t + 2) * kstep; const char* b2 = last ? nB : cB + (size_t)(t + 2) * kstep;
            const char* a3 = a2 + kstep; const char* b3 = b2 + kstep;
            if (last && has_next) S.a_ready(nxt);
            if constexpr (SP2) {
            PG8_LDB(B0, 0, 0); PG8_LDB(B1, 0, 1); PG8_SCHED; PG8_LDA(At, 0, 0); PG8_STAGE(PG8_SA(1, 1), a1 + hstepA, voffA);
            PG8_WAIT_V(8); PG8_WAIT_L(0); PG8_BAR; PG8_MMA(0, 0, At, B0); PG8_MMA(0, 1, At, B1); PG8_BAR; PG8_SCHED;
            PG8_LDA(At, 0, 1); PG8_STAGE(PG8_SB(0, 0), b2, voffB); PG8_STAGE(PG8_SB(0, 1), b2 + hstepB, voffB); PG8_STAGE(PG8_SA(0, 0), a2, voffA);
            PG8_WAIT_V(8); PG8_WAIT_L(0); PG8_BAR; PG8_MMA(1, 0, At, B0); PG8_MMA(1, 1, At, B1); PG8_BAR; PG8_SCHED;
            PG8_LDB(B0, 1, 0); PG8_LDB(B1, 1, 1); PG8_SCHED; PG8_LDA(At, 1, 0); PG8_STAGE(PG8_SA(0, 1), a2 + hstepA, voffA);
            PG8_WAIT_V(8); PG8_WAIT_L(0); PG8_BAR; PG8_MMA(0, 0, At, B0); PG8_MMA(0, 1, At, B1); PG8_BAR; PG8_SCHED;
            PG8_LDA(At, 1, 1); PG8_STAGE(PG8_SB(1, 0), b3, voffB); PG8_STAGE(PG8_SB(1, 1), b3 + hstepB, voffB); PG8_STAGE(PG8_SA(1, 0), a3, voffA);
            PG8_WAIT_V(8); PG8_WAIT_L(0); PG8_BAR; PG8_MMA(1, 0, At, B0); PG8_MMA(1, 1, At, B1); PG8_BAR; PG8_SCHED;
            } else {
            PG8_LDB(B0, 0, 0); PG8_SCHED; PG8_LDA(At, 0, 0); PG8_STAGE(PG8_SA(1, 1), a1 + hstepA, voffA);
            PG8_WAIT_L(8); PG8_BAR; PG8_WAIT_L(0); PG8_MMA(0, 0, At, B0); PG8_BAR; PG8_SCHED;
            PG8_LDB(B1, 0, 1); PG8_STAGE(PG8_SB(0, 0), b2, voffB);
            PG8_BAR; PG8_WAIT_L(0); PG8_MMA(0, 1, At, B1); PG8_BAR;
            PG8_LDA(At, 0, 1); PG8_STAGE(PG8_SA(0, 0), a2, voffA);
            PG8_BAR; PG8_WAIT_L(0); PG8_MMA(1, 0, At, B0); PG8_BAR; PG8_SCHED;
            PG8_STAGE(PG8_SB(0, 1), b2 + hstepB, voffB);
            PG8_WAIT_V(6); PG8_BAR; PG8_MMA(1, 1, At, B1); PG8_BAR;
            PG8_LDB(B0, 1, 0); PG8_SCHED; PG8_LDA(At, 1, 0); PG8_STAGE(PG8_SA(0, 1), a2 + hstepA, voffA);
            PG8_WAIT_L(8); PG8_BAR; PG8_WAIT_L(0); PG8_MMA(0, 0, At, B0); PG8_BAR; PG8_SCHED;
            PG8_LDB(B1, 1, 1); PG8_STAGE(PG8_SB(1, 0), b3, voffB);
            PG8_BAR; PG8_WAIT_L(0); PG8_MMA(0, 1, At, B1); PG8_BAR;
            PG8_LDA(At, 1, 1); PG8_STAGE(PG8_SA(1, 0), a3, voffA);
            PG8_BAR; PG8_WAIT_L(0); PG8_MMA(1, 0, At, B0); PG8_BAR; PG8_SCHED;
            PG8_STAGE(PG8_SB(1, 1), b3 + hstepB, voffB);
            PG8_WAIT_V(6); PG8_BAR; PG8_MMA(1, 1, At, B1); PG8_BAR;
            }
        }
        if constexpr (ALIGN_EPI) { if (wr == 0) PG8_BAR; }
        if constexpr (!Epi::AFTER_DRAIN) { E(acc, cur, wr, wc, fr, fq); S.done(cur); }
        if (!has_next) break;
#pragma unroll
        for (int a = 0; a < 2; ++a)
#pragma unroll
            for (int b = 0; b < 2; ++b)
#pragma unroll
                for (int m = 0; m < 4; ++m)
#pragma unroll
                    for (int n = 0; n < 2; ++n) acc[a][b][m][n] = (f32x4){0.f, 0.f, 0.f, 0.f};
        cur = nxt; cA = nA; cB = nB; ++ui;
        if constexpr (ALIGN_EPI) { if (wr == 1) PG8_BAR; }
    }
    PG8_WAIT_V(0);
    if constexpr (!ALIGN_EPI) { if (wr == 0) PG8_BAR; }
    PG8_BAR;
    if constexpr (Epi::AFTER_DRAIN) { E.fused(acc, cur, wr, wc, fr, fq, lds, wid, lane); S.done(cur); }
#undef PG8_SA
#undef PG8_SB
#undef PG8_STAGE
#undef PG8_LDA
#undef PG8_LDB
#undef PG8_MMA
#undef PG8_WAIT_V
#undef PG8_WAIT_L
#undef PG8_BAR
#undef PG8_SCHED
}
}

#define LAS __attribute__((address_space(3)))
typedef unsigned short bf16_t;
typedef short bf16x8 __attribute__((ext_vector_type(8)));
typedef float f32x4 __attribute__((ext_vector_type(4)));
typedef float f32x16 __attribute__((ext_vector_type(16)));
typedef unsigned u32x4 __attribute__((ext_vector_type(4)));
typedef unsigned u32x2 __attribute__((ext_vector_type(2)));
typedef float f32x2_t __attribute__((ext_vector_type(2)));
typedef __bf16 bf16x2_t __attribute__((ext_vector_type(2)));

constexpr int MTOK = 32768, DM = 1024, SEQ = 8192;
constexpr int NIN = 5912, NINP = 6144, DFF = 2816;
constexpr float L2E = 1.4426950408889634f;
constexpr size_t MiB = 1048576;
constexpr size_t WS_CTL = 0, WS_WIN = 1 * MiB, WS_WBR = 13 * MiB, WS_WOUT = 15 * MiB, WS_WGU = 17 * MiB, WS_WDN = 28 * MiB, WS_WC1 = 34 * MiB,
                 WS_SMALL = 36 * MiB, WS_CMPH = 37 * MiB, WS_KC = 45 * MiB, WS_VCT = 45 * MiB + 512 * 1024, WS_NSG = 46 * MiB,
                 WS_H = 49 * MiB  , WS_A = 113 * MiB  ,
                 WS_B = 305 * MiB  , WS_END = 481 * MiB;
constexpr size_t HB_SBQ = 0, HB_SBK = 16, HB_SBVT = 32, HB_MBQ = 48, HB_MBK = 64, HB_MBVT = 80, HB_NSQ = 96, HB_KCR = 128, HB_VCR = 136,
                 HB_KS = 144, HB_VST = 152, HB_KW = 160, HB_VWT = 168;
constexpr int LDS_BYTES = 147456;
constexpr int ATT_BT = 36864, ATT_MISC = 50688, ATT_SEL = 50944, ATT_X = 51968, ATT_OA = 93952;

struct Params { const float* in[16]; float* out; unsigned char* ws; };

__device__ __forceinline__ unsigned pk2(float lo, float hi) { f32x2_t v = {lo, hi}; bf16x2_t b = __builtin_convertvector(v, bf16x2_t); return __builtin_bit_cast(unsigned, b); }
__device__ __forceinline__ float bf2f(unsigned v16) { return __uint_as_float(v16 << 16); }
__device__ __forceinline__ float bflo(unsigned w) { return __uint_as_float(w << 16); }
__device__ __forceinline__ float bfhi(unsigned w) { return __uint_as_float(w & 0xffff0000u); }
__device__ __forceinline__ float wave_sum(float v) { v += __shfl_xor(v, 1); v += __shfl_xor(v, 2); v += __shfl_xor(v, 4); v += __shfl_xor(v, 8); v += __shfl_xor(v, 16); v += __shfl_xor(v, 32); return v; }
__device__ __forceinline__ float wave_max(float v) { v = fmaxf(v, __shfl_xor(v, 1)); v = fmaxf(v, __shfl_xor(v, 2)); v = fmaxf(v, __shfl_xor(v, 4)); v = fmaxf(v, __shfl_xor(v, 8)); v = fmaxf(v, __shfl_xor(v, 16)); v = fmaxf(v, __shfl_xor(v, 32)); return v; }
__device__ __forceinline__ float sigmoidf_(float x) { return __builtin_amdgcn_rcpf(1.0f + __expf(-x)); }
__device__ __forceinline__ float ex2(float x) { return __builtin_amdgcn_exp2f(x); }
__device__ __forceinline__ float lg2(float x) { return __builtin_amdgcn_logf(x); }

template <int MAP> __device__ __forceinline__ int mapcol(int p) {
    const int pn = p >> 8, q = p & 255, bj = q >> 7, wc = (q >> 5) & 3, n = (q >> 4) & 1, fq = (q >> 2) & 3, e = q & 3;
    const int lc = 64 * wc + 32 * bj + 8 * fq + 4 * n + e;
    if (MAP == 3) return p;
    if (MAP == 0) return 256 * pn + lc;
    if (MAP == 1) { if (pn <= 10) return 256 * pn + lc; if (pn == 11) return lc < 24 ? 2816 + lc : -1; return 2840 + 256 * (pn - 12) + lc; }
    const int j = 128 * pn + 32 * wc + 8 * fq + 4 * n + e; return bj ? DFF + j : j;
}

struct EpiRes {
    static constexpr bool PERM = false, AFTER_DRAIN = false;
    const float* res; float* out;
    __device__ __forceinline__ void operator()(const f32x4 (&acc)[2][2][4][2], const pg8::Unit& u, int wr, int wc, int fr_, int fq_) const {
        int fr = fr_, fq = fq_; asm volatile("" : "+v"(fr), "+v"(fq));
#pragma unroll
        for (int ai = 0; ai < 2; ++ai)
#pragma unroll
            for (int m = 0; m < 4; ++m) { const unsigned row = (unsigned)(u.pm * 256 + 128 * ai + 64 * wr + 16 * m + fr);
#pragma unroll
                for (int bj = 0; bj < 2; ++bj)
#pragma unroll
                    for (int n = 0; n < 2; ++n) { const unsigned o = row * 1024u + (unsigned)(u.pn * 256 + 64 * wc + 32 * bj + 8 * fq + 4 * n);
                        const f32x4 r = *(const f32x4*)(res + o); *(f32x4*)(out + o) = r + acc[ai][bj][m][n]; }
                __builtin_amdgcn_sched_barrier(0); }
    }
};
struct EpiSwiglu {
    static constexpr bool PERM = false, AFTER_DRAIN = false;
    bf16_t* act;
    __device__ __forceinline__ void operator()(const f32x4 (&acc)[2][2][4][2], const pg8::Unit& u, int wr, int wc, int fr_, int fq_) const {
        int fr = fr_, fq = fq_; asm volatile("" : "+v"(fr), "+v"(fq));
#pragma unroll
        for (int ai = 0; ai < 2; ++ai)
#pragma unroll
            for (int m = 0; m < 4; ++m) { const unsigned row = (unsigned)(u.pm * 256 + 128 * ai + 64 * wr + 16 * m + fr);
                float v[8];
#pragma unroll
                for (int n = 0; n < 2; ++n)
#pragma unroll
                    for (int e = 0; e < 4; ++e) { const float g = acc[ai][0][m][n][e], up = acc[ai][1][m][n][e]; v[4 * n + e] = g * sigmoidf_(g) * up; }
                u32x4 w; w.x = pk2(v[0], v[1]); w.y = pk2(v[2], v[3]); w.z = pk2(v[4], v[5]); w.w = pk2(v[6], v[7]);
                *(u32x4*)(act + (row * 2816u + (unsigned)(u.pn * 128 + 32 * wc + 8 * fq))) = w; }
    }
};
template <int MODE> struct EpiBranch {
    static constexpr bool PERM = false, AFTER_DRAIN = false;
    const bf16_t* brg; bf16_t* mix; int s;
    __device__ __forceinline__ void operator()(const f32x4 (&acc)[2][2][4][2], const pg8::Unit& u, int wr, int wc, int fr_, int fq_) const {
        int fr = fr_, fq = fq_; asm volatile("" : "+v"(fr), "+v"(fq));
#pragma unroll
        for (int ai = 0; ai < 2; ++ai)
#pragma unroll
            for (int m = 0; m < 4; ++m) { const unsigned row = (unsigned)(u.pm * 256 + 128 * ai + 64 * wr + 16 * m + fr);
#pragma unroll
                for (int bj = 0; bj < 2; ++bj)
#pragma unroll
                    for (int n = 0; n < 2; ++n) { const unsigned c = (unsigned)(u.pn * 256 + 64 * wc + 32 * bj + 8 * fq + 4 * n);
                        const u32x2 g = *(const u32x2*)(brg + (row * 3072u + 1024u * (unsigned)s + c));
                        u32x2 o = {0u, 0u}; if (MODE) o = *(const u32x2*)(mix + (row * 1024u + c));
                        const f32x4 a = acc[ai][bj][m][n];
                        u32x2 w;
                        w.x = pk2(bflo(o.x) + bflo(g.x) * a[0], bfhi(o.x) + bfhi(g.x) * a[1]);
                        w.y = pk2(bflo(o.y) + bflo(g.y) * a[2], bfhi(o.y) + bfhi(g.y) * a[3]);
                        *(u32x2*)(mix + (row * 1024u + c)) = w; }
                __builtin_amdgcn_sched_barrier(0); }
    }
};
struct EpiCmp1 {
    static constexpr bool PERM = false, AFTER_DRAIN = false;
    const float* bias; float* hid;
    __device__ __forceinline__ void operator()(const f32x4 (&acc)[2][2][4][2], const pg8::Unit& u, int wr, int wc, int fr_, int fq_) const {
        int fr = fr_, fq = fq_; asm volatile("" : "+v"(fr), "+v"(fq));
#pragma unroll
        for (int ai = 0; ai < 2; ++ai)
#pragma unroll
            for (int m = 0; m < 4; ++m) { const unsigned row = (unsigned)(u.pm * 256 + 128 * ai + 64 * wr + 16 * m + fr);
#pragma unroll
                for (int bj = 0; bj < 2; ++bj)
#pragma unroll
                    for (int n = 0; n < 2; ++n) { const int c = 64 * wc + 32 * bj + 8 * fq + 4 * n;
                        const f32x4 b = *(const f32x4*)(bias + c); f32x4 x = acc[ai][bj][m][n] + b, y;
#pragma unroll
                        for (int e = 0; e < 4; ++e) { const float t = x[e], z = 0.7978845608028654f * (t + 0.044715f * t * t * t);
                            const float th = 1.0f - 2.0f * __builtin_amdgcn_rcpf(1.0f + __expf(2.0f * z)); y[e] = 0.5f * t * (1.0f + th); }
                        *(f32x4*)(hid + (row * 256u + (unsigned)c)) = y; } }
    }
};
struct EpiStoreF32 {
    static constexpr bool PERM = false, AFTER_DRAIN = false;
    float* hid;
    __device__ __forceinline__ void operator()(const f32x4 (&acc)[2][2][4][2], const pg8::Unit& u, int wr, int wc, int fr_, int fq_) const {
        int fr = fr_, fq = fq_; asm volatile("" : "+v"(fr), "+v"(fq));
#pragma unroll
        for (int ai = 0; ai < 2; ++ai)
#pragma unroll
            for (int m = 0; m < 4; ++m) { const unsigned row = (unsigned)(u.pm * 256 + 128 * ai + 64 * wr + 16 * m + fr);
#pragma unroll
                for (int bj = 0; bj < 2; ++bj)
#pragma unroll
                    for (int n = 0; n < 2; ++n) *(f32x4*)(hid + (row * 256u + (unsigned)(64 * wc + 32 * bj + 8 * fq + 4 * n))) = acc[ai][bj][m][n]; }
    }
};
struct EpiInproj {
    static constexpr bool PERM = false, AFTER_DRAIN = false;
    unsigned char* wsb; const float* nwb;
    __device__ __forceinline__ void operator()(const f32x4 (&acc)[2][2][4][2], const pg8::Unit& u, int wr, int wc, int fr_, int fq_) const {
        int fr = fr_, fq = fq_; asm volatile("" : "+v"(fr), "+v"(fq));
        const int t = u.pn; unsigned char* hb = wsb + WS_B; float* nsg = (float*)(wsb + WS_NSG); bf16_t* brg = (bf16_t*)(wsb + WS_A);
        const float* mqn = nwb; const float* mkn = nwb + 64; const float* nqn = nwb + 128; const float* nkn = nwb + 192;
        if (t <= 10) {
            const int hd = 4 * t + wc;
            const int grp = hd < 24 ? (hd >> 2) : (hd < 32 ? 6 : 7 + ((hd - 32) >> 1));
            const int hh = hd < 24 ? (hd & 3) : (hd < 32 ? hd - 24 : (hd & 1));
            const int H = grp < 6 ? 4 : (grp == 6 ? 8 : 2);
            bf16_t* base = (bf16_t*)(hb + (grp <= 6 ? (size_t)16 * grp : (size_t)(128 + 8 * (grp - 7))) * MiB);
            const bool trans = (grp == 2) | (grp == 5) | (grp == 10) | (grp == 12);
            const bool norm = (grp == 3) | (grp == 4) | (grp == 6) | (grp == 9) | (grp == 11);
            const float qs = ((grp == 0) | (grp == 3) | (grp == 6)) ? 0.125f * L2E : 1.0f;
            const float* nw = grp == 3 ? mqn : (grp == 4 ? mkn : (grp == 6 ? nqn : (grp == 9 ? nkn + 64 : nkn + 128)));
#pragma unroll
            for (int ai = 0; ai < 2; ++ai)
#pragma unroll
                for (int m = 0; m < 4; ++m) { const int row = u.pm * 256 + 128 * ai + 64 * wr + 16 * m + fr; const int b = row >> 13, s = row & 8191;
                    float v[2][8];
#pragma unroll
                    for (int bj = 0; bj < 2; ++bj)
#pragma unroll
                        for (int n = 0; n < 2; ++n)
#pragma unroll
                            for (int e = 0; e < 4; ++e) v[bj][4 * n + e] = acc[ai][bj][m][n][e];
                    float sc = qs;
                    if (norm) { float ss = 0.f;
#pragma unroll
                        for (int bj = 0; bj < 2; ++bj)
#pragma unroll
                            for (int j = 0; j < 8; ++j) ss += v[bj][j] * v[bj][j];
                        ss += __shfl_xor(ss, 16); ss += __shfl_xor(ss, 32);
                        sc = qs * __builtin_amdgcn_rsqf(ss * (1.0f / 64.0f) + 1e-6f);
#pragma unroll
                        for (int bj = 0; bj < 2; ++bj) { const f32x4 w0 = *(const f32x4*)(nw + 32 * bj + 8 * fq), w1 = *(const f32x4*)(nw + 32 * bj + 8 * fq + 4);
#pragma unroll
                            for (int e = 0; e < 4; ++e) { v[bj][e] *= w0[e]; v[bj][4 + e] *= w1[e]; } } }
                    if (!trans) {
#pragma unroll
                        for (int bj = 0; bj < 2; ++bj) { u32x4 w; w.x = pk2(v[bj][0] * sc, v[bj][1] * sc); w.y = pk2(v[bj][2] * sc, v[bj][3] * sc); w.z = pk2(v[bj][4] * sc, v[bj][5] * sc); w.w = pk2(v[bj][6] * sc, v[bj][7] * sc);
                            *(u32x4*)(base + (unsigned)(((b * H + hh) * SEQ + s) * 64 + 32 * bj + 8 * fq)) = w; }
                    } else {
#pragma unroll
                        for (int bj = 0; bj < 2; ++bj)
#pragma unroll
                            for (int j = 0; j < 8; j += 2) { const unsigned w = pk2(v[bj][j], v[bj][j + 1]); bf16_t* d = base + (unsigned)(((b * H + hh) * 64 + 32 * bj + 8 * fq + j) * SEQ + s);
                                d[0] = (bf16_t)(w & 0xffffu); d[SEQ] = (bf16_t)(w >> 16); }
                    } }
        } else if (t == 11) {
            if (wc == 0 && fq < 3) {
#pragma unroll
                for (int ai = 0; ai < 2; ++ai)
#pragma unroll
                    for (int m = 0; m < 4; ++m) { const unsigned row = (unsigned)(u.pm * 256 + 128 * ai + 64 * wr + 16 * m + fr);
#pragma unroll
                        for (int n = 0; n < 2; ++n) { f32x4 y;
#pragma unroll
                            for (int e = 0; e < 4; ++e) y[e] = sigmoidf_(acc[ai][0][m][n][e]);
                            *(f32x4*)(nsg + (row * 24u + (unsigned)(8 * fq + 4 * n))) = y; } }
            }
        } else {
#pragma unroll
            for (int ai = 0; ai < 2; ++ai)
#pragma unroll
                for (int m = 0; m < 4; ++m) { const unsigned row = (unsigned)(u.pm * 256 + 128 * ai + 64 * wr + 16 * m + fr);
#pragma unroll
                    for (int bj = 0; bj < 2; ++bj) { const f32x4 a0 = acc[ai][bj][m][0], a1 = acc[ai][bj][m][1]; u32x4 w;
                        w.x = pk2(sigmoidf_(a0[0]), sigmoidf_(a0[1])); w.y = pk2(sigmoidf_(a0[2]), sigmoidf_(a0[3]));
                        w.z = pk2(sigmoidf_(a1[0]), sigmoidf_(a1[1])); w.w = pk2(sigmoidf_(a1[2]), sigmoidf_(a1[3]));
                        *(u32x4*)(brg + (row * 3072u + (unsigned)((t - 12) * 256 + 64 * wc + 32 * bj + 8 * fq))) = w; } }
        }
    }
};

template <int MAP> __device__ __forceinline__ void prep_w(const float* __restrict__ W, int K, int ldw, bf16_t* __restrict__ Bt, int Np, int ldb, LAS unsigned char* lds, int tid, int bx, int G) {
    const int ntp = Np >> 6, ntiles = ntp * (K >> 6), w = tid >> 6, lane = tid & 63;
    float v[8];
    int tile = bx;
    if (tile < ntiles) { const int tk = tile / ntp, tp = tile - tk * ntp; const int col = mapcol<MAP>(tp * 64 + lane); const float* s = W + (size_t)(tk * 64 + 8 * w) * ldw + (col < 0 ? 0 : col);
#pragma unroll
        for (int i = 0; i < 8; ++i) v[i] = col >= 0 ? s[(size_t)i * ldw] : 0.f; }
    for (; tile < ntiles; tile += G) {
        const int tk = tile / ntp, tp = tile - tk * ntp;
        u32x4 pw; pw.x = pk2(v[0], v[1]); pw.y = pk2(v[2], v[3]); pw.z = pk2(v[4], v[5]); pw.w = pk2(v[6], v[7]);
        *(LAS u32x4*)(lds + lane * 144 + w * 16) = pw;
        __syncthreads();
        const int nx = tile + G;
        if (nx < ntiles) { const int tk2 = nx / ntp, tp2 = nx - tk2 * ntp; const int col = mapcol<MAP>(tp2 * 64 + lane); const float* s = W + (size_t)(tk2 * 64 + 8 * w) * ldw + (col < 0 ? 0 : col);
#pragma unroll
            for (int i = 0; i < 8; ++i) v[i] = col >= 0 ? s[(size_t)i * ldw] : 0.f; }
        { const int p = tid >> 3, pc = tid & 7; const u32x4 o = *(LAS const u32x4*)(lds + p * 144 + pc * 16);
            *(u32x4*)(Bt + (size_t)(tp * 64 + p) * ldb + tk * 64 + pc * 8) = o; }
        __syncthreads();
    }
}
__device__ __forceinline__ void rmsnorm_rows(const float* __restrict__ x, const float* __restrict__ g, bf16_t* __restrict__ h, int gwave, int nwaves, int lane) {
    for (int row = gwave; row < MTOK; row += nwaves) {
        const f32x4* xr = (const f32x4*)(x + (size_t)row * DM); f32x4 v[4]; float ss = 0.f;
#pragma unroll
        for (int i = 0; i < 4; ++i) { v[i] = xr[lane + 64 * i]; ss += v[i][0] * v[i][0] + v[i][1] * v[i][1] + v[i][2] * v[i][2] + v[i][3] * v[i][3]; }
        ss = wave_sum(ss); const float rs = __builtin_amdgcn_rsqf(ss * (1.0f / DM) + 1e-6f);
#pragma unroll
        for (int i = 0; i < 4; ++i) { const f32x4 gv = ((const f32x4*)g)[lane + 64 * i]; u32x2 w; w.x = pk2(v[i][0] * rs * gv[0], v[i][1] * rs * gv[1]); w.y = pk2(v[i][2] * rs * gv[2], v[i][3] * rs * gv[3]);
            *(u32x2*)(h + (size_t)row * DM + (lane + 64 * i) * 4) = w; }
    }
}

#define MFMA32(a, b, c) __builtin_amdgcn_mfma_f32_32x32x16_bf16((a), (b), (c), 0, 0, 0)
__device__ __forceinline__ void stage_ld(const bf16_t* K, const bf16_t* Vt, int ldvt, int key0, int tid, u32x4& rk, u32x4& rv) {
    const int row = tid >> 3, pc = tid & 7;
    rk = *(const u32x4*)(K + (size_t)(key0 + row) * 64 + pc * 8);
    rv = *(const u32x4*)(Vt + (size_t)row * ldvt + key0 + pc * 8);
}
__device__ __forceinline__ void stage_st(LAS unsigned char* lds, int buf, int tid, const u32x4& rk, const u32x4& rv) {
    const int row = tid >> 3, pc = tid & 7; LAS unsigned char* p = lds + buf * 18432 + row * 144 + pc * 16;
    *(LAS u32x4*)p = rk; *(LAS u32x4*)(p + 9216) = rv;
}
__device__ __forceinline__ void load_q(const bf16_t* qrow, int h, bf16x8 (&qf)[4]) {
#pragma unroll
    for (int kk = 0; kk < 4; ++kk) qf[kk] = *(const bf16x8*)(qrow + 16 * kk + 8 * h);
}
__device__ __forceinline__ f32x16 qk_sub(LAS const unsigned char* ks, int sub, const bf16x8 (&qf)[4], int r, int h, float init = 0.f) {
    const int pr = (r & 0x13) | ((r & 4) << 1) | ((r & 8) >> 1);
    LAS const unsigned char* p = ks + (32 * sub + pr) * 144 + h * 16;
    f32x16 st;
#pragma unroll
    for (int i = 0; i < 16; ++i) st[i] = init;
#pragma unroll
    for (int kk = 0; kk < 4; ++kk) { const bf16x8 kf = *(LAS const bf16x8*)(p + kk * 32); st = MFMA32(kf, qf[kk], st); }
    return st;
}
__device__ __forceinline__ void pv_sub(LAS const unsigned char* vs, int sub, const f32x16& p, f32x16 (&ot)[2], int r, int h) {
#pragma unroll
    for (int j = 0; j < 2; ++j) {
        u32x4 w; w.x = pk2(p[8 * j], p[8 * j + 1]); w.y = pk2(p[8 * j + 2], p[8 * j + 3]); w.z = pk2(p[8 * j + 4], p[8 * j + 5]); w.w = pk2(p[8 * j + 6], p[8 * j + 7]);
        const bf16x8 pf = __builtin_bit_cast(bf16x8, w);
#pragma unroll
        for (int mt = 0; mt < 2; ++mt) { const bf16x8 vf = *(LAS const bf16x8*)(vs + (32 * mt + r) * 144 + (32 * sub + 16 * j + 8 * h) * 2); ot[mt] = MFMA32(vf, pf, ot[mt]); }
    }
}
constexpr int BT_N = 288, BT_FAR = 64 + 223;
template <int MODE> __device__ __forceinline__ void soft_sub(f32x16& st, float& lsum, bool lane_valid, int dist0, int dmax, LAS const float* bt) {
    if (MODE == 0) {
#pragma unroll
        for (int i = 0; i < 16; ++i) { const float p = ex2(st[i]); lsum += p; st[i] = p; }
    } else if (MODE == 2) {
        const float cf = lane_valid ? bt[BT_FAR] : -3.0e38f;
#pragma unroll
        for (int i = 0; i < 16; ++i) { const int dist = dist0 - (16 * (i >> 3) + (i & 7)); const float b = dist < dmax ? cf : -3.0e38f;
            const float p = ex2(st[i] + b); lsum += p; st[i] = p; }
    } else if (MODE == 1) {
        float bb[16];
#pragma unroll
        for (int j = 0; j < 2; ++j) { int db = dist0 - 16 * j; db = db < -57 ? -57 : (db > 223 ? 223 : db); if (!lane_valid) db = -57;
            LAS const float* p = bt + (db + 64);
#pragma unroll
            for (int k = 0; k < 8; ++k) bb[8 * j + k] = p[-k]; }
#pragma unroll
        for (int i = 0; i < 16; ++i) { const float p = ex2(st[i] + bb[i]); lsum += p; st[i] = p; }
    } else {
        float bb[16];
#pragma unroll
        for (int i = 0; i < 16; ++i) { int d = dist0 - 16 * (16 * (i >> 3) + (i & 7)); d = d < -64 ? -64 : (d > 223 ? 223 : d); bb[i] = bt[d + 64]; }
#pragma unroll
        for (int i = 0; i < 16; ++i) { const float p = ex2(st[i] + bb[i]); lsum += p; st[i] = p; }
    }
}
template <int MODE> __device__ __forceinline__ void tile_soft(LAS const unsigned char* ks, LAS const unsigned char* vs, const bf16x8 (&qf)[4], f32x16 (&ot)[2], float& lsum,
                                                              bool lane_valid, int dist00, int dmax, LAS const float* bt, int r, int h) {
    const float init = MODE == 0 ? (lane_valid ? bt[BT_FAR] : -3.0e38f) : 0.f;
    f32x16 s0 = qk_sub(ks, 0, qf, r, h, init); f32x16 s1 = qk_sub(ks, 1, qf, r, h, init);
    soft_sub<MODE>(s0, lsum, lane_valid, dist00, dmax, bt); pv_sub(vs, 0, s0, ot, r, h);
    soft_sub<MODE>(s1, lsum, lane_valid, dist00 - (MODE == 3 ? 512 : 32), dmax, bt); pv_sub(vs, 1, s1, ot, r, h);
}
__device__ __forceinline__ void zero_ot(f32x16 (&ot)[2]) {
#pragma unroll
    for (int i = 0; i < 16; ++i) { ot[0][i] = 0.f; ot[1][i] = 0.f; }
}
__device__ __forceinline__ void store_ot(bf16_t* orow, const f32x16 (&ot)[2], int h) {
#pragma unroll
    for (int mt = 0; mt < 2; ++mt)
#pragma unroll
        for (int g = 0; g < 4; ++g) { u32x2 w; w.x = pk2(ot[mt][4 * g], ot[mt][4 * g + 1]); w.y = pk2(ot[mt][4 * g + 2], ot[mt][4 * g + 3]);
            *(u32x2*)(orow + 32 * mt + 8 * g + 4 * h) = w; }
}

#define TILE_LOOP(KP, VP, LDV, KEY_FIRST, NT, BODY) do { \
    int key0 = (KEY_FIRST); const int nt_ = (NT); u32x4 rkA_, rvA_, rkB_, rvB_; \
    __syncthreads(); \
    stage_ld((KP), (VP), (LDV), key0, tid, rkA_, rvA_); stage_st(lds, 0, tid, rkA_, rvA_); \
    if (nt_ > 1) stage_ld((KP), (VP), (LDV), key0 + 64, tid, rkA_, rvA_); \
    __syncthreads(); \
    for (int it_ = 0; it_ < nt_; ++it_) { const int buf_ = it_ & 1; \
        if (it_ + 2 < nt_) stage_ld((KP), (VP), (LDV), key0 + 128, tid, rkB_, rvB_); \
        { LAS const unsigned char* ks = lds + buf_ * 18432; LAS const unsigned char* vs = ks + 9216; BODY } \
        if (it_ + 1 < nt_) stage_st(lds, buf_ ^ 1, tid, rkA_, rvA_); \
        __syncthreads(); key0 += 64; rkA_ = rkB_; rvA_ = rvB_; } } while (0)

__device__ __forceinline__ void sb_sub(LAS const unsigned char* vs, int sb, f32x16& st, f32x16 (&ot)[2], float& C, int key0, int t, int r, int h) {
    float ls[16]; float Rlo = 0.f, Rhi = 0.f;
#pragma unroll
    for (int i = 0; i < 16; ++i) { const int s = key0 + 32 * sb + 16 * (i >> 3) + 8 * h + (i & 7); const bool causal = s < t;
        const float u = st[i]; const float sp = fmaxf(u, 0.f) + lg2(1.0f + ex2(-fabsf(u)));
        ls[i] = causal ? -sp : 0.f; st[i] = causal ? (u - sp) : -3.0e38f;
        if (i < 8) Rlo += ls[i]; else Rhi += ls[i]; }
    const float Plo = __shfl_xor(Rlo, 32), Phi = __shfl_xor(Rhi, 32);
    float la = C + (h == 0 ? Phi : 0.f);
#pragma unroll
    for (int i = 15; i >= 8; --i) { const float a = ex2(st[i] + la); la += ls[i]; st[i] = a; }
    la = C + Rhi + Phi + (h == 0 ? Plo : 0.f);
#pragma unroll
    for (int i = 7; i >= 0; --i) { const float a = ex2(st[i] + la); la += ls[i]; st[i] = a; }
    C += (Rlo + Rhi) + (Plo + Phi);
    pv_sub(vs, sb, st, ot, r, h);
}
__device__ __forceinline__ void sb_unit(LAS unsigned char* lds, const unsigned char* hb, bf16_t* omix, int b, int hd, int qblk, int tid) {
    const int lane = tid & 63, w = tid >> 6, r = lane & 31, h = lane >> 5;
    const int bh = b * 4 + hd, q0 = qblk * 256, t = q0 + 32 * w + r;
    const bf16_t* Q = (const bf16_t*)(hb + HB_SBQ * MiB) + ((size_t)bh * SEQ + t) * 64;
    const bf16_t* K = (const bf16_t*)(hb + HB_SBK * MiB) + (size_t)bh * SEQ * 64;
    const bf16_t* Vt = (const bf16_t*)(hb + HB_SBVT * MiB) + (size_t)bh * 64 * SEQ;
    bf16x8 qf[4]; load_q(Q, h, qf);
    f32x16 ot[2]; zero_ot(ot);
    float C = 0.f;
    int key0 = q0 + 192; u32x4 rkA_, rvA_, rkB_, rvB_;
    __syncthreads();
    stage_ld(K, Vt, SEQ, key0, tid, rkA_, rvA_); stage_st(lds, 0, tid, rkA_, rvA_);
    if (key0 >= 64) stage_ld(K, Vt, SEQ, key0 - 64, tid, rkA_, rvA_);
    __syncthreads();
    int buf = 0;
    for (;;) {
        const bool has_next = key0 >= 64;
        if (key0 >= 128) stage_ld(K, Vt, SEQ, key0 - 128, tid, rkB_, rvB_);
        if (key0 <= q0 + 32 * w + 31) {
            LAS const unsigned char* ks = lds + buf * 18432; LAS const unsigned char* vs = ks + 9216;
            f32x16 s1 = qk_sub(ks, 1, qf, r, h); f32x16 s0 = qk_sub(ks, 0, qf, r, h);
            if (key0 + 32 <= q0 + 32 * w + 31) sb_sub(vs, 1, s1, ot, C, key0, t, r, h);
            sb_sub(vs, 0, s0, ot, C, key0, t, r, h);
        }
        const int alive = __syncthreads_or(C > -150.0f ? 1 : 0);
        if (!(has_next && alive)) break;
        stage_st(lds, buf ^ 1, tid, rkA_, rvA_);
        __syncthreads(); buf ^= 1; key0 -= 64; rkA_ = rkB_; rvA_ = rvB_;
    }
    store_ot(omix + ((size_t)b * SEQ + t) * DM + hd * 64, ot, h);
}

__device__ __forceinline__ void moba_unit(LAS unsigned char* lds, const unsigned char* hb, const float* kmean, bf16_t* omix, int b, int hd, int blk, int tid) {
    const int lane = tid & 63, w = tid >> 6, r = lane & 31, h = lane >> 5;
    const int bh = b * 4 + hd, q0 = blk * 256, t = q0 + 32 * w + r;
    const bf16_t* Qb = (const bf16_t*)(hb + HB_MBQ * MiB) + ((size_t)bh * SEQ + q0) * 64;
    const bf16_t* K = (const bf16_t*)(hb + HB_MBK * MiB) + (size_t)bh * SEQ * 64;
    const bf16_t* Vt = (const bf16_t*)(hb + HB_MBVT * MiB) + (size_t)bh * 64 * SEQ;
    LAS unsigned* misc = (LAS unsigned*)(lds + ATT_MISC); LAS unsigned* selm = (LAS unsigned*)(lds + ATT_SEL);
    LAS float* km = (LAS float*)(lds + ATT_X); LAS float* sc = km + 32 * 64;
    LAS const float* bt = (LAS const float*)(lds + ATT_BT) + hd * BT_N;
    __syncthreads();
    if (tid == 0) misc[1] = 0u;
    if (blk > 3) {
        for (int i = tid; i < blk * 64; i += 512) km[i] = kmean[(size_t)bh * 32 * 64 + i];
        __syncthreads();
        { const int qi = tid & 255, part = tid >> 8; float q[64];
            const u32x4* qp = (const u32x4*)(Qb + (size_t)qi * 64);
#pragma unroll
            for (int c = 0; c < 8; ++c) { const u32x4 v = qp[c]; q[8 * c] = bflo(v.x); q[8 * c + 1] = bfhi(v.x); q[8 * c + 2] = bflo(v.y); q[8 * c + 3] = bfhi(v.y); q[8 * c + 4] = bflo(v.z); q[8 * c + 5] = bfhi(v.z); q[8 * c + 6] = bflo(v.w); q[8 * c + 7] = bfhi(v.w); }
            for (int n = part; n < blk; n += 2) { float a = 0.f;
#pragma unroll
                for (int d = 0; d < 64; ++d) a = fmaf(q[d], km[n * 64 + d], a);
                sc[qi * 33 + n] = a; } }
        __syncthreads();
        if (tid < 256) { unsigned m = 0u;
#pragma unroll 1
            for (int k = 0; k < 3; ++k) { float best = -3.0e38f; int bi = 0;
                for (int n = 0; n < blk; ++n) { const float v = sc[tid * 33 + n]; if (!((m >> n) & 1u) && v > best) { best = v; bi = n; } }
                m |= 1u << bi; }
            selm[tid] = m; atomicOr((unsigned*)&misc[1], m); }
    } else {
        const unsigned m = (1u << blk) - 1u; if (tid < 256) selm[tid] = m; if (tid == 0) misc[1] = m;
    }
    __syncthreads();
    const unsigned uni = misc[1], sel = selm[32 * w + r];
    bf16x8 qf[4]; load_q(Qb + (size_t)(32 * w + r) * 64, h, qf);
    f32x16 ot[2]; zero_ot(ot); float lsum = 0.f;
    const int kend = q0 + 256;
#define MOBA_NEXT(k_, out_) do { int kk_ = (k_) + 64; while (kk_ < q0 && !((uni >> (kk_ >> 8)) & 1u)) kk_ = (kk_ | 255) + 1; (out_) = kk_; } while (0)
    int key0, knext, knext2; MOBA_NEXT(-64, key0); MOBA_NEXT(key0, knext);
    u32x4 rkA_, rvA_, rkB_, rvB_;
    stage_ld(K, Vt, SEQ, key0, tid, rkA_, rvA_); stage_st(lds, 0, tid, rkA_, rvA_);
    if (knext < kend) stage_ld(K, Vt, SEQ, knext, tid, rkA_, rvA_);
    __syncthreads();
    int buf = 0;
    while (key0 < kend) {
        MOBA_NEXT(knext, knext2);
        if (knext < kend && knext2 < kend) stage_ld(K, Vt, SEQ, knext2, tid, rkB_, rvB_);
        {
            LAS const unsigned char* ks = lds + buf * 18432; LAS const unsigned char* vs = ks + 9216;
            const int n = key0 >> 8; const bool own = (n == blk);
            const bool lane_valid = own ? true : (((sel >> n) & 1u) != 0u);
            const bool skip = own ? (key0 > q0 + 32 * w + 31) : (__ballot(lane_valid) == 0ull);
            if (!skip) {
                const bool near = (q0 + 32 * w) - (key0 + 63) < 128;
                const int dist00 = t - (key0 + 8 * h);
                if (near) tile_soft<1>(ks, vs, qf, ot, lsum, lane_valid, dist00, 0, bt, r, h);
                else tile_soft<0>(ks, vs, qf, ot, lsum, lane_valid, dist00, 0, bt, r, h);
            }
        }
        if (knext < kend) stage_st(lds, buf ^ 1, tid, rkA_, rvA_);
        __syncthreads(); buf ^= 1; key0 = knext; knext = knext2; rkA_ = rkB_; rvA_ = rvB_;
    }
#undef MOBA_NEXT
    const float l = lsum + __shfl_xor(lsum, 32); const float inv = 1.0f / fmaxf(l, 1e-30f);
#pragma unroll
    for (int i = 0; i < 16; ++i) { ot[0][i] *= inv; ot[1][i] *= inv; }
    store_ot(omix + ((size_t)b * SEQ + t) * DM + 256 + hd * 64, ot, h);
}

__device__ __forceinline__ void imp_sub(f32x16& st, float invc, int nbase, LAS float* improw, int r) {
#pragma unroll
    for (int j = 0; j < 2; ++j) { const int a = (nbase + 16 * j) >> 3;
        float s0 = ((st[8 * j] + st[8 * j + 1]) + (st[8 * j + 2] + st[8 * j + 3])) * invc;
        float s1 = ((st[8 * j + 3] + st[8 * j + 4]) + (st[8 * j + 5] + st[8 * j + 6]) + st[8 * j + 7]) * invc;
        float s2 = st[8 * j + 7] * invc;
        s0 += __shfl_xor(s0, 8); s0 += __shfl_xor(s0, 16); s1 += __shfl_xor(s1, 8); s1 += __shfl_xor(s1, 16); s2 += __shfl_xor(s2, 8); s2 += __shfl_xor(s2, 16);
        if (r < 8) { LAS float* ip = improw + 2 * a; ip[0] += s0; ip[1] += s1; if (2 * a + 2 < 128) ip[2] += s2; } }
}
__device__ __forceinline__ void nsa_unit(LAS unsigned char* lds, const unsigned char* hb, const bf16_t* kc, const bf16_t* vct, const float* nsg, bf16_t* omix, int b, int g, int c, int tid) {
    const int lane = tid & 63, w = tid >> 6, r = lane & 31, h = lane >> 5;
    const int bg = b * 2 + g, q0 = c * 64, ql = 8 * w + (r & 7), t = q0 + ql, hq = 4 * g + (r >> 3);
    const bf16_t* Q = (const bf16_t*)(hb + HB_NSQ * MiB) + ((size_t)(b * 8 + hq) * SEQ + t) * 64;
    LAS unsigned* selm = (LAS unsigned*)(lds + ATT_SEL); LAS float* imp = (LAS float*)(lds + ATT_X);
    LAS const float* bt = (LAS const float*)(lds + ATT_BT) + (4 + hq) * BT_N;
    const float* gate = nsg + ((size_t)b * SEQ + t) * 24 + hq;
    bf16x8 qf[4]; load_q(Q, h, qf);
    f32x16 ot[2]; zero_ot(ot);
    LAS unsigned* oal = (LAS unsigned*)(lds + ATT_OA) + (w * 16) * 64 + lane;
    const bf16_t* Kc = kc + (size_t)bg * 512 * 64; const bf16_t* Vc = vct + (size_t)bg * 64 * 512;
    const int ntc = (4 * c + 3 + 63) >> 6;
    float lsum = 0.f;
    TILE_LOOP(Kc, Vc, 512, 0, ntc, {
        tile_soft<3>(ks, vs, qf, ot, lsum, true, t - 31 - 16 * (key0 + 8 * h), 0, bt, r, h); });
    const float lc = lsum + __shfl_xor(lsum, 32); const float invc = 1.0f / fmaxf(lc, 1e-30f);
    { const float gc = gate[0] * invc;
#pragma unroll
        for (int i = 0; i < 8; ++i) { oal[i * 64] = pk2(ot[0][2 * i] * gc, ot[0][2 * i + 1] * gc); oal[(8 + i) * 64] = pk2(ot[1][2 * i] * gc, ot[1][2 * i + 1] * gc); } }
    for (int i = tid; i < 64 * 129; i += 512) imp[i] = 0.f;
    if (tid < 256) selm[tid] = 0u;
    TILE_LOOP(Kc, Vc, 512, 0, ntc, {
        f32x16 s0 = qk_sub(ks, 0, qf, r, h); f32x16 s1 = qk_sub(ks, 1, qf, r, h); float dummy = 0.f;
        const int dist00 = t - 31 - 16 * (key0 + 8 * h);
        soft_sub<3>(s0, dummy, true, dist00, 0, bt); imp_sub(s0, invc, key0 + 8 * h, imp + ql * 129, r);
        soft_sub<3>(s1, dummy, true, dist00 - 512, 0, bt); imp_sub(s1, invc, key0 + 32 + 8 * h, imp + ql * 129, r); });
    { const int qi = tid >> 3, sub = tid & 7;
        if (c >= 16) {
            for (int m = 1 + sub; m <= c - 2; m += 8) { const float v = imp[qi * 129 + m]; int cnt = 0;
                for (int m2 = 1; m2 <= c - 2; ++m2) { const float v2 = imp[qi * 129 + m2]; cnt += ((v2 > v) || (v2 == v && m2 < m)) ? 1 : 0; }
                if (cnt < 13) atomicOr((unsigned*)&selm[qi * 4 + (m >> 5)], 1u << (m & 31)); }
            if (sub == 0) { atomicOr((unsigned*)&selm[qi * 4], 1u); atomicOr((unsigned*)&selm[qi * 4 + ((c - 1) >> 5)], 1u << ((c - 1) & 31)); atomicOr((unsigned*)&selm[qi * 4 + (c >> 5)], 1u << (c & 31)); }
        } else if (sub == 0) selm[qi * 4] = (1u << (c + 1)) - 1u;
    }
    __syncthreads();
    const unsigned sel0 = selm[ql * 4], sel1 = selm[ql * 4 + 1], sel2 = selm[ql * 4 + 2], sel3 = selm[ql * 4 + 3];
    { const bf16_t* Ks = (const bf16_t*)(hb + HB_KS * MiB) + (size_t)bg * SEQ * 64; const bf16_t* Vs = (const bf16_t*)(hb + HB_VST * MiB) + (size_t)bg * 64 * SEQ;
        zero_ot(ot); lsum = 0.f;
        TILE_LOOP(Ks, Vs, SEQ, 0, c + 1, {
            const int m = key0 >> 6; const unsigned sw = m < 32 ? sel0 : (m < 64 ? sel1 : (m < 96 ? sel2 : sel3));
            const bool lane_valid = ((sw >> (m & 31)) & 1u) != 0u;
            if (__ballot(lane_valid) != 0ull) { const int dist00 = t - (key0 + 8 * h);
                if ((c - m) < 3) tile_soft<1>(ks, vs, qf, ot, lsum, lane_valid, dist00, 0, bt, r, h);
                else tile_soft<0>(ks, vs, qf, ot, lsum, lane_valid, dist00, 0, bt, r, h); } });
        const float l = lsum + __shfl_xor(lsum, 32); const float gs = gate[8] / fmaxf(l, 1e-30f);
#pragma unroll
        for (int i = 0; i < 8; ++i) { const unsigned a0 = oal[i * 64], a1 = oal[(8 + i) * 64];
            oal[i * 64] = pk2(bflo(a0) + ot[0][2 * i] * gs, bfhi(a0) + ot[0][2 * i + 1] * gs); oal[(8 + i) * 64] = pk2(bflo(a1) + ot[1][2 * i] * gs, bfhi(a1) + ot[1][2 * i + 1] * gs); } }
    { const bf16_t* Kw = (const bf16_t*)(hb + HB_KW * MiB) + (size_t)bg * SEQ * 64; const bf16_t* Vw = (const bf16_t*)(hb + HB_VWT * MiB) + (size_t)bg * 64 * SEQ;
        zero_ot(ot); lsum = 0.f;
        const int kfirst = q0 >= 512 ? q0 - 512 : 0; const int ntw = ((q0 - kfirst) >> 6) + 1;
        TILE_LOOP(Kw, Vw, SEQ, kfirst, ntw, {
            const int dist00 = t - (key0 + 8 * h);
            if (key0 >= q0 - 128) tile_soft<1>(ks, vs, qf, ot, lsum, true, dist00, 0, bt, r, h);
            else if (key0 == q0 - 512) tile_soft<2>(ks, vs, qf, ot, lsum, true, dist00, 512, bt, r, h);
            else tile_soft<0>(ks, vs, qf, ot, lsum, true, dist00, 0, bt, r, h); });
        const float l = lsum + __shfl_xor(lsum, 32); const float gw = gate[16] / fmaxf(l, 1e-30f);
#pragma unroll
        for (int i = 0; i < 8; ++i) { const unsigned a0 = oal[i * 64], a1 = oal[(8 + i) * 64];
            ot[0][2 * i] = bflo(a0) + ot[0][2 * i] * gw; ot[0][2 * i + 1] = bfhi(a0) + ot[0][2 * i + 1] * gw; ot[1][2 * i] = bflo(a1) + ot[1][2 * i] * gw; ot[1][2 * i + 1] = bfhi(a1) + ot[1][2 * i + 1] * gw; } }
    store_ot(omix + ((size_t)b * SEQ + t) * DM + 512 + hq * 64, ot, h);
}

constexpr int FG_STAGE = 55296, FG_B = 36864, FG_PATCH = 110592;
__device__ __forceinline__ u32x4 gld16(const void* p) { u32x4 v; asm volatile("global_load_dwordx4 %0, %1, off" : "=v"(v) : "v"(p) : "memory"); return v; }
__device__ __forceinline__ void fg_ld(const bf16_t* A, const bf16_t* Bt, int kt, int tid, u32x4 (&ra)[4], u32x4 (&rb)[2]) {
#pragma unroll
    for (int i = 0; i < 4; ++i) { const unsigned p = (unsigned)(tid + 512 * i); ra[i] = gld16(A + 64 * kt + ((p >> 3) * 1024u + 8u * (p & 7u))); }
#pragma unroll
    for (int i = 0; i < 2; ++i) { const unsigned p = (unsigned)(tid + 512 * i); rb[i] = gld16(Bt + 64 * kt + ((p >> 3) * 1024u + 8u * (p & 7u))); }
}
__device__ __forceinline__ void fg_st(LAS unsigned char* st, int tid, const u32x4 (&ra)[4], const u32x4 (&rb)[2]) {
#pragma unroll
    for (int i = 0; i < 4; ++i) { const int p = tid + 512 * i; *(LAS u32x4*)(st + (p >> 3) * 144 + (p & 7) * 16) = ra[i]; }
#pragma unroll
    for (int i = 0; i < 2; ++i) { const int p = tid + 512 * i; *(LAS u32x4*)(st + FG_B + (p >> 3) * 144 + (p & 7) * 16) = rb[i]; }
}
__device__ __forceinline__ void branch_tile(LAS unsigned char* lds, const bf16_t* omix, const bf16_t* wbr, const bf16_t* brg, bf16_t* mix, int pm, int pn, int tid) {
    const int lane = tid & 63, w = tid >> 6, r = lane & 31, h = lane >> 5, wr = w >> 1, wc = w & 1;
    const bf16_t* A = omix + (size_t)pm * 256 * DM; const bf16_t* Bt = wbr + (size_t)pn * 128 * DM;
    LAS unsigned char* patch = lds + FG_PATCH + w * 2560;
    f32x16 seg[2][2]; unsigned tot[2][2][8];
#pragma unroll
    for (int a = 0; a < 2; ++a)
#pragma unroll
        for (int c = 0; c < 2; ++c)
#pragma unroll
            for (int i = 0; i < 16; ++i) { seg[a][c][i] = 0.f; tot[a][c][i >> 1] = 0u; }
    u32x4 ra0[4], rb0[2], ra1[4], rb1[2];
    __syncthreads();
    fg_ld(A, Bt, 0, tid, ra0, rb0); asm volatile("s_waitcnt vmcnt(0)" ::: "memory"); fg_st(lds, tid, ra0, rb0);
    fg_ld(A, Bt, 1, tid, ra1, rb1);
    __syncthreads();
#define FG_COMPUTE(BUF) { LAS const unsigned char* sa = lds + (BUF) * FG_STAGE + (64 * wr + r) * 144 + h * 16; LAS const unsigned char* sb = lds + (BUF) * FG_STAGE + FG_B + (64 * wc + r) * 144 + h * 16; \
        _Pragma("unroll") for (int kk = 0; kk < 4; ++kk) { const bf16x8 a0 = *(LAS const bf16x8*)(sa + kk * 32), a1 = *(LAS const bf16x8*)(sa + 32 * 144 + kk * 32); \
            const bf16x8 b0 = *(LAS const bf16x8*)(sb + kk * 32), b1 = *(LAS const bf16x8*)(sb + 32 * 144 + kk * 32); \
            seg[0][0] = MFMA32(a0, b0, seg[0][0]); seg[0][1] = MFMA32(a0, b1, seg[0][1]); seg[1][0] = MFMA32(a1, b0, seg[1][0]); seg[1][1] = MFMA32(a1, b1, seg[1][1]); } }
#define FG_BAR() do { asm volatile("s_waitcnt lgkmcnt(0)" ::: "memory"); __builtin_amdgcn_s_barrier(); asm volatile("" ::: "memory"); } while (0)
#pragma unroll 1
    for (int kt = 0; kt < 16; kt += 2) {
        fg_ld(A, Bt, (kt + 2 < 16 ? kt + 2 : 15), tid, ra0, rb0);
        FG_COMPUTE(0);
        asm volatile("s_waitcnt vmcnt(6)" ::: "memory");
        fg_st(lds + FG_STAGE, tid, ra1, rb1);
        FG_BAR();
        fg_ld(A, Bt, (kt + 3 < 16 ? kt + 3 : 15), tid, ra1, rb1);
        const bool segend = (kt == 2) || (kt == 6) || (kt == 14);
        const int s = kt == 2 ? 0 : (kt == 6 ? 1 : 2);
        u32x4 g0[2], g1[2];
#define FG_GLD(dst, rt_, ct_) { _Pragma("unroll") for (int j = 0; j < 2; ++j) { const int p = lane + 64 * j; dst[j] = *(const u32x4*)(brg + ((unsigned)(pm * 256 + 64 * wr + 32 * (rt_) + (p >> 2)) * 3072u + (unsigned)(1024 * s + pn * 128 + 64 * wc + 32 * (ct_) + 8 * (p & 3)))); } }
#define FG_GATE(src, rt_, ct_) { _Pragma("unroll") for (int j = 0; j < 2; ++j) { const int p = lane + 64 * j; *(LAS u32x4*)(patch + (p >> 2) * 80 + (p & 3) * 16) = src[j]; } }
#define FG_ACC(rt_, ct_) { _Pragma("unroll") for (int p2 = 0; p2 < 8; ++p2) { const int tr = 8 * (p2 >> 1) + 4 * h + 2 * (p2 & 1); \
            const float ga = bf2f(*(LAS const unsigned short*)(patch + tr * 80 + r * 2)), gb = bf2f(*(LAS const unsigned short*)(patch + (tr + 1) * 80 + r * 2)); const unsigned tv = tot[rt_][ct_][p2]; \
            tot[rt_][ct_][p2] = pk2(fmaf(ga, seg[rt_][ct_][2 * p2], bflo(tv)), fmaf(gb, seg[rt_][ct_][2 * p2 + 1], bfhi(tv))); seg[rt_][ct_][2 * p2] = 0.f; seg[rt_][ct_][2 * p2 + 1] = 0.f; } }
        if (segend) { FG_GLD(g0, 0, 0); FG_GLD(g1, 0, 1); }
        FG_COMPUTE(1);
        if (segend) {
            FG_GATE(g0, 0, 0); FG_GLD(g0, 1, 0); FG_ACC(0, 0);
            FG_GATE(g1, 0, 1); FG_GLD(g1, 1, 1); FG_ACC(0, 1);
            FG_GATE(g0, 1, 0); FG_ACC(1, 0);
            FG_GATE(g1, 1, 1); FG_ACC(1, 1);
        }
#undef FG_GLD
#undef FG_GATE
#undef FG_ACC
        asm volatile("s_waitcnt vmcnt(6)" ::: "memory");
        fg_st(lds, tid, ra0, rb0);
        FG_BAR();
    }
    asm volatile("s_waitcnt vmcnt(0)" :: "v"(ra0[0]), "v"(ra0[1]), "v"(ra0[2]), "v"(ra0[3]), "v"(rb0[0]), "v"(rb0[1]), "v"(ra1[0]), "v"(ra1[1]), "v"(ra1[2]), "v"(ra1[3]), "v"(rb1[0]), "v"(rb1[1]) : "memory");
#undef FG_COMPUTE
#undef FG_BAR
#pragma unroll
    for (int rt = 0; rt < 2; ++rt)
#pragma unroll
        for (int ct = 0; ct < 2; ++ct) { const int tok0 = pm * 256 + 64 * wr + 32 * rt, n0 = pn * 128 + 64 * wc + 32 * ct;
#pragma unroll
            for (int p2 = 0; p2 < 8; ++p2) { const int tr = 8 * (p2 >> 1) + 4 * h + 2 * (p2 & 1); const unsigned tv = tot[rt][ct][p2];
                *(LAS unsigned short*)(patch + tr * 80 + r * 2) = (unsigned short)(tv & 0xffffu); *(LAS unsigned short*)(patch + (tr + 1) * 80 + r * 2) = (unsigned short)(tv >> 16); }
#pragma unroll
            for (int j = 0; j < 2; ++j) { const int p = lane + 64 * j; const u32x4 ov = *(LAS const u32x4*)(patch + (p >> 2) * 80 + (p & 3) * 16);
                *(u32x4*)(mix + ((unsigned)(tok0 + (p >> 2)) * 1024u + (unsigned)(n0 + 8 * (p & 3)))) = ov; } }
}

#define LAUNDER_S(x) asm volatile("" : "+s"(x))
#define GAS __attribute__((address_space(1)))
#define INP(k) ({ int k_ = (k); LAUNDER_S(k_); (const float*)(const GAS float*)P.in[k_]; })
#define POUT ((float*)(GAS float*)P.out)
#define PHASE_BEGIN int L = layer; LAUNDER_S(L); GAS unsigned char* wsg_ = (GAS unsigned char*)P.ws; LAUNDER_S(wsg_); unsigned char* ws = (unsigned char*)wsg_; int G = gridDim.x, bx = blockIdx.x; LAUNDER_S(G); LAUNDER_S(bx); int tid = threadIdx.x; asm volatile("" : "+v"(tid)); const int lane = tid & 63, wave = __builtin_amdgcn_readfirstlane(tid >> 6); (void)lane; (void)wave; (void)G; (void)bx; (void)L; (void)ws;
__global__ void __launch_bounds__(512, 2) hybrid_fwd(Params P) {
    extern __shared__ __attribute__((aligned(16))) unsigned char lds_raw[];
    LAS unsigned char* lds = (LAS unsigned char*)lds_raw;
    cg::grid_group grid = cg::this_grid();
#pragma unroll 1
    for (int layer = 0; layer < 2; ++layer) {
#ifndef REP_A
#define REP_A 1
#endif
#ifndef REP_CD
#define REP_CD 1
#endif
        for (int repa_ = 0; repa_ < REP_A; ++repa_)
        { PHASE_BEGIN
            const int gtid = bx * 512 + tid, gthreads = G * 512, gwave = bx * 8 + wave, nwaves = G * 8;
            prep_w<1>(INP(3) + (size_t)L * DM * NIN, DM, NIN, (bf16_t*)(ws + WS_WIN), NINP, DM, lds, tid, bx, G);
            prep_w<3>(INP(11) + (size_t)L * DM * DM, DM, DM, (bf16_t*)(ws + WS_WBR), DM, DM, lds, tid, bx, G);
            prep_w<0>(INP(12) + (size_t)L * DM * DM, DM, DM, (bf16_t*)(ws + WS_WOUT), DM, DM, lds, tid, bx, G);
            prep_w<2>(INP(14) + (size_t)L * DM * 2 * DFF, DM, 2 * DFF, (bf16_t*)(ws + WS_WGU), 2 * DFF, DM, lds, tid, bx, G);
            prep_w<0>(INP(15) + (size_t)L * DFF * DM, DFF, DM, (bf16_t*)(ws + WS_WDN), DM, DFF, lds, tid, bx, G);
            const float* cw1 = INP(9) + (size_t)L * 2 * 2048 * 256;
            prep_w<0>(cw1, 2048, 256, (bf16_t*)(ws + WS_WC1), 256, 2048, lds, tid, bx, G);
            prep_w<0>(cw1 + 2048 * 256, 2048, 256, (bf16_t*)(ws + WS_WC1) + 256 * 2048, 256, 2048, lds, tid, bx, G);
            rmsnorm_rows(L == 0 ? INP(0) : (const float*)POUT, INP(2) + L * DM, (bf16_t*)(ws + WS_H), gwave, nwaves, lane);
            if (gwave < 512) { const int kv = gwave >> 8, j = gwave & 255; const float* pp = INP(8) + (size_t)L * 2 * 2048 + kv * 2048; const float* ww = cw1 + (size_t)kv * 2048 * 256 + j; float a = 0.f;
#pragma unroll 8
                for (int i = lane; i < 2048; i += 64) a = fmaf(pp[i], ww[(size_t)i * 256], a);
                a = wave_sum(a);
                if (lane == 0) ((float*)(ws + WS_SMALL))[kv * 256 + j] = a; }
            if (bx == 1 && tid < 384) { float* nw = (float*)(ws + WS_SMALL + 2048); const float v = tid < 64 ? (INP(4) + L * 64)[tid] : (tid < 128 ? (INP(5) + L * 64)[tid - 64] : (tid < 192 ? (INP(6) + L * 64)[tid - 128] : (INP(7) + L * 192)[tid - 192])); nw[tid] = v; }
        }
        grid.sync();

        { PHASE_BEGIN
            pg8::Gemm g{(const bf16_t*)(ws + WS_H), (const bf16_t*)(ws + WS_WIN), MTOK, NINP, DM, DM, DM}; pg8::StaticOrder S; S.init(MTOK, NINP, G, bx);
            EpiInproj E{ws, (const float*)(ws + WS_SMALL + 2048)};
#ifndef SKIP_B
            pg8::gemm_phase<EpiInproj, pg8::StaticOrder, true, true>(lds, g, S, E, tid);
#endif
        }
        grid.sync();

        for (int repcd_ = 0; repcd_ < REP_CD; ++repcd_) {
        { PHASE_BEGIN
            if (bx < 128) { const int kv = bx >> 6, ks = (bx >> 4) & 3;
                pg8::Gemm g{(const bf16_t*)(ws + WS_B + (kv ? HB_VCR : HB_KCR) * MiB) + ks * 512, (const bf16_t*)(ws + WS_WC1) + (size_t)kv * 256 * 2048 + ks * 512, 4096, 256, 512, 1024, 2048};
                pg8::StaticOrder S; S.init(4096, 256, G, bx & 15);
                EpiStoreF32 E{(float*)(ws + WS_H) + (size_t)(kv * 4 + ks) * 4096 * 256};
#ifndef SKIP_C
                pg8::gemm_phase<EpiStoreF32, pg8::StaticOrder, true, true>(lds, g, S, E, tid);
#endif
            } else {
                const bf16_t* mbk = (const bf16_t*)(ws + WS_B + HB_MBK * MiB); float* KMEAN = (float*)(ws + WS_SMALL + 4096);
                for (int item = (bx - 128) * 8 + wave; item < 512; item += (G - 128) * 8) { const int bh = item >> 5, n = item & 31;
                    const bf16_t* kp = mbk + ((size_t)bh * SEQ + 256 * n) * 64 + lane; float a = 0.f;
#pragma unroll 8
                    for (int j = 0; j < 256; ++j) a += bf2f(kp[(size_t)j * 64]);
                    KMEAN[(size_t)item * 64 + lane] = a * (1.0f / 256.0f); }
            }
        }
        grid.sync();

        { PHASE_BEGIN
            const int gwave = bx * 8 + wave, nwaves = G * 8;
            const float* cw2 = INP(10) + (size_t)L * 2 * 256 * 64; const float* nkn = INP(7) + L * 192;
            bf16_t* KC = (bf16_t*)(ws + WS_KC); bf16_t* VCT = (bf16_t*)(ws + WS_VCT);
            for (int row = gwave; row < 8192; row += nwaves) { const int kv = row >> 12, rr = row & 4095, bg = rr >> 9, n = rr & 511;
                f32x4 hv = *(const f32x4*)((const float*)(ws + WS_SMALL) + kv * 256 + 4 * lane);
                { const float* pp = (const float*)(ws + WS_H) + ((size_t)(kv * 4) * 4096 + rr) * 256 + 4 * lane;
#pragma unroll
                    for (int ks = 0; ks < 4; ++ks) hv += *(const f32x4*)(pp + (size_t)ks * 4096 * 256);
#pragma unroll
                    for (int e = 0; e < 4; ++e) { const float t = hv[e], z = 0.7978845608028654f * (t + 0.044715f * t * t * t);
                        const float th = 1.0f - 2.0f * __builtin_amdgcn_rcpf(1.0f + __expf(2.0f * z)); hv[e] = 0.5f * t * (1.0f + th); } }
                const float* wp = cw2 + (size_t)kv * 256 * 64 + lane; float a = 0.f;
#pragma unroll
                for (int k = 0; k < 256; ++k) { const float hk = __uint_as_float(__builtin_amdgcn_readlane(__float_as_uint(hv[k & 3]), k >> 2)); a = fmaf(hk, wp[k * 64], a); }
                if (kv == 0) { const float ss = wave_sum(a * a); float y = a * __builtin_amdgcn_rsqf(ss * (1.0f / 64.0f) + 1e-6f) * nkn[lane]; if (n == 511) y = 0.f;
                    KC[((size_t)bg * 512 + n) * 64 + lane] = (bf16_t)(pk2(y, 0.f) & 0xffffu); }
                else { if (n == 511) a = 0.f; VCT[((size_t)bg * 64 + lane) * 512 + n] = (bf16_t)(pk2(a, 0.f) & 0xffffu); } }
        }
        grid.sync();

        }
        { PHASE_BEGIN
            LAS unsigned* misc = (LAS unsigned*)(lds + ATT_MISC); LAS float* btab = (LAS float*)(lds + ATT_BT);
            const float* rel_bias = INP(1);
            __syncthreads();
            if (wave == 0) { const float* mqn = INP(4) + L * 64; const float* mkn = INP(5) + L * 64; const float* nqn = INP(6) + L * 64; const float* nkn = INP(7) + L * 192;
                float gq = fmaxf(fabsf(mqn[lane]), fabsf(nqn[lane])); float gk = fmaxf(fmaxf(fabsf(mkn[lane]), fabsf(nkn[lane])), fmaxf(fabsf(nkn[64 + lane]), fabsf(nkn[128 + lane])));
                float bm = 0.f;
#pragma unroll
                for (int i = 0; i < 6; ++i) bm = fmaxf(bm, fabsf(rel_bias[lane + 64 * i]));
                gq = wave_max(gq); gk = wave_max(gk); bm = wave_max(bm);
                if (lane == 0) ((LAS float*)misc)[2] = 8.0f * gq * gk + bm; }
            __syncthreads();
            const float shift = ((LAS float*)misc)[2];
            for (int i = tid; i < 12 * BT_N; i += 512) { const int hd = i / BT_N, jx = i - hd * BT_N; const int d = jx - 64;
                float v = -3.0e38f;
                if (d >= 0) { int bk; if (d < 16) bk = d; else if (d >= 128) bk = 31; else { bk = 16 + (int)(__log2f((float)d * (1.0f / 16.0f)) * (16.0f / 3.0f)); bk = bk > 31 ? 31 : bk; }
                    v = (rel_bias[bk * 12 + hd] - shift) * L2E; }
                btab[i] = v; }
            __syncthreads();
#ifndef REP_E
#define REP_E 1
#endif
            for (int rep_ = 0; rep_ < REP_E; ++rep_) {
            unsigned* ctl = (unsigned*)(ws + WS_CTL) + L + 2 * rep_;
            unsigned char* HBUF = ws + WS_B; bf16_t* OMIX = (bf16_t*)(ws + WS_H);
            for (;;) {
                __syncthreads();
                if (tid == 0) misc[0] = atomicAdd(ctl, 1u);
                __syncthreads();
                const int u = (int)misc[0];
                if (u >= 2048) break;
                int tidu = tid; asm volatile("" : "+v"(tidu));
                if (u < 1024) { const int c = 127 - (u >> 3), bg = u & 7;
#ifndef SKIP_NSA
                    nsa_unit(lds, HBUF, (const bf16_t*)(ws + WS_KC), (const bf16_t*)(ws + WS_VCT), (const float*)(ws + WS_NSG), OMIX, bg >> 1, bg & 1, c, tidu);
#endif
                }
                else if (u < 1536) { const int v = u - 1024;
#ifndef SKIP_MOBA
                    moba_unit(lds, HBUF, (const float*)(ws + WS_SMALL + 4096), OMIX, (v & 15) >> 2, v & 3, 31 - (v >> 4), tidu);
#endif
                }
                else { const int v = u - 1536;
#ifndef SKIP_SB
                    sb_unit(lds, HBUF, OMIX, (v & 15) >> 2, v & 3, 31 - (v >> 4), tidu);
#endif
                }
            }
            }
        }
        grid.sync();

        { PHASE_BEGIN
            for (int tl = bx; tl < 1024; tl += G) { int tidu = tid; asm volatile("" : "+v"(tidu));
                branch_tile(lds, (const bf16_t*)(ws + WS_H), (const bf16_t*)(ws + WS_WBR), (const bf16_t*)(ws + WS_A), (bf16_t*)(ws + WS_B), tl >> 3, tl & 7, tidu); }
        }
        grid.sync();

        { PHASE_BEGIN
            pg8::Gemm g{(const bf16_t*)(ws + WS_B), (const bf16_t*)(ws + WS_WOUT), MTOK, DM, DM, DM, DM}; pg8::StaticOrder S; S.init(MTOK, DM, G, bx);
            EpiRes E{L == 0 ? INP(0) : (const float*)POUT, POUT};
#ifndef SKIP_GJ
            pg8::gemm_phase<EpiRes, pg8::StaticOrder, true, true>(lds, g, S, E, tid);
#endif
        }
        grid.sync();

        { PHASE_BEGIN
            rmsnorm_rows(POUT, INP(13) + L * DM, (bf16_t*)(ws + WS_H), bx * 8 + wave, G * 8, lane); }
        grid.sync();

        { PHASE_BEGIN
            pg8::Gemm g{(const bf16_t*)(ws + WS_H), (const bf16_t*)(ws + WS_WGU), MTOK, 2 * DFF, DM, DM, DM}; pg8::StaticOrder S; S.init(MTOK, 2 * DFF, G, bx); EpiSwiglu E{(bf16_t*)(ws + WS_A)};
#ifndef SKIP_I
            pg8::gemm_phase<EpiSwiglu, pg8::StaticOrder, true, true>(lds, g, S, E, tid);
#endif
        }
        grid.sync();

        { PHASE_BEGIN
            pg8::Gemm g{(const bf16_t*)(ws + WS_A), (const bf16_t*)(ws + WS_WDN), MTOK, DM, DFF, DFF, DFF}; pg8::StaticOrder S; S.init(MTOK, DM, G, bx); EpiRes E{POUT, POUT};
#ifndef SKIP_GJ
            pg8::gemm_phase<EpiRes, pg8::StaticOrder, true, true>(lds, g, S, E, tid);
#endif
        }
        if (layer == 0) grid.sync();
    }
}

extern "C" void kernel_launch(void* const* d_in, const int* in_sizes, int n_in, void* d_out, int out_size, void* d_ws, size_t ws_size, hipStream_t stream) {
    static int grid = 0;
    if (grid == 0) {
        if (n_in != 16 || out_size != MTOK * DM || ws_size < WS_END) { fprintf(stderr, "kernel_launch: unexpected shapes (n_in %d out %d ws %zu, need ws >= %zu)\n", n_in, out_size, ws_size, (size_t)WS_END); grid = -1; return; }
        int dev = 0, cus = 0, per_cu = 0;
        hipGetDevice(&dev); hipDeviceGetAttribute(&cus, hipDeviceAttributeMultiprocessorCount, dev);
        if (hipFuncSetAttribute((const void*)hybrid_fwd, hipFuncAttributeMaxDynamicSharedMemorySize, LDS_BYTES) != hipSuccess) { fprintf(stderr, "kernel_launch: hipFuncSetAttribute failed\n"); grid = -1; return; }
        if (hipOccupancyMaxActiveBlocksPerMultiprocessor(&per_cu, (const void*)hybrid_fwd, 512, LDS_BYTES) != hipSuccess || per_cu < 1) { fprintf(stderr, "kernel_launch: occupancy query gave %d\n", per_cu); per_cu = 1; }
        (void)hipGetLastError();
        grid = cus * 1;
    }
    if (grid < 0) return;
    hipMemsetAsync((char*)d_ws + WS_CTL, 0, 4096, stream);
    Params p{};
    for (int i = 0; i < 16; ++i) p.in[i] = (const float*)d_in[i];
    p.out = (float*)d_out; p.ws = (unsigned char*)d_ws;
    void* args[] = {&p};
    hipError_t e = hipLaunchCooperativeKernel((const void*)hybrid_fwd, dim3(grid), dim3(512), args, LDS_BYTES, stream);
    if (e != hipSuccess) fprintf(stderr, "cooperative launch failed: %s (grid %d)\n", hipGetErrorString(e), grid);
}
```

```cpp
#include <hip/hip_runtime.h>
#include <hip/hip_cooperative_groups.h>
#include <cstdio>
#include <cstdint>
namespace cg = cooperative_groups;
namespace pg8 {
#define PG8_LAS __attribute__((address_space(3)))
typedef unsigned short bf16_t;
typedef short bf16x8 __attribute__((ext_vector_type(8)));
typedef float f32x4 __attribute__((ext_vector_type(4)));
typedef unsigned u32x4 __attribute__((ext_vector_type(4)));
constexpr int BM = 256, BK = 64, HALF = 128, HTB = HALF * BK * 2  , STAGE_BYTES = 8 * HTB, NXCD = 8, WGM = 8;

__host__ __device__ __forceinline__ int lds_byte(int r, int c) { const int st = (r >> 4) * 2 + (c >> 5), rr = r & 15, cc = c & 31, ob = rr * 64 + cc * 2; return st * 1024 + (ob ^ (((ob >> 9) & 1) << 5)); }
__host__ __device__ __forceinline__ void stage_rc(int b, int& R, int& C) { const int st = b / 1024, sb = b % 1024, swz = sb ^ (((sb >> 9) & 1) << 5); R = (st >> 1) * 16 + swz / 64; C = (st & 1) * 32 + (swz % 64) / 2; }
__host__ __device__ __forceinline__ int perm32(int rho) { const int n = rho >> 4, i = rho & 15; return 8 * (i >> 2) + 4 * n + (i & 3); }

struct Unit { int pm, pn; };
struct Gemm { const bf16_t* A; const bf16_t* Bt; int M, N, K, lda, ldb; };

struct StaticOrder {
    int nM, nN, nwg, G, c;
    __host__ __device__ void init(int M, int N, int G_, int c_) { nM = M / BM; nN = N / BM; nwg = nM * nN; G = G_; c = c_; }
    __host__ __device__ bool next(int i, Unit& u) const {
        const long L = (long)i * G + c; if (L >= nwg) return false;
        int wgid = (int)L; { const int q = nwg / NXCD, r = nwg % NXCD, xcd = wgid % NXCD, off = wgid / NXCD; wgid = (xcd < r ? xcd * (q + 1) : r * (q + 1) + (xcd - r) * q) + off; }
        const int nig = WGM * nN, gid = wgid / nig, fm = gid * WGM, gsz = (nM - fm) < WGM ? (nM - fm) : WGM;
        u.pm = fm + ((wgid % nig) % gsz); u.pn = (wgid % nig) / gsz; return true;
    }
    __device__ __forceinline__ void a_ready(const Unit&) const {}
    __device__ __forceinline__ void done(const Unit&) const {}
};
template <class Epi, class Sched, bool ALIGN_EPI = false, bool SP2 = false>
__device__ __forceinline__ void gemm_phase(PG8_LAS unsigned char* lds, const Gemm g, const Sched& S, const Epi& E, int tid_in) {
    const int tid = tid_in, wid = __builtin_amdgcn_readfirstlane(tid >> 6), lane = tid & 63, wr = wid >> 2, wc = wid & 3, fr = lane & 15, fq = lane >> 4;
    const int K = g.K, nt = K / BK;
    unsigned voffA[2], voffB[2];
#pragma unroll
    for (int i = 0; i < 2; ++i) { int R, C; stage_rc(tid * 16 + i * 8192, R, C); const int Rb = Epi::PERM ? ((R & ~31) + perm32(R & 31)) : R;
        voffA[i] = (unsigned)(R * g.lda + C) * 2u; voffB[i] = (unsigned)(Rb * g.ldb + C) * 2u; }
    const size_t kstep = (size_t)(BK * 2);
    const size_t hstepA = (size_t)HALF * g.lda * 2, hstepB = (size_t)HALF * g.ldb * 2;
    const size_t tstepA = 2 * hstepA, tstepB = 2 * hstepB;
    const unsigned ldsw = (unsigned)wid * 1024u;
    const int aoff = lds_byte(wr * 64 + fr, fq * 8), boff = lds_byte(wc * 32 + fr, fq * 8);
#define PG8_SA(b, h) (((b) * 2 + (h)) * HTB)
#define PG8_SB(b, h) ((4 + (b) * 2 + (h)) * HTB)
#define PG8_STAGE(bufoff, gbase, voff) do { _Pragma("unroll") for (int _i = 0; _i < 2; ++_i) \
        __builtin_amdgcn_global_load_lds((const unsigned*)((const char*)(gbase) + (voff)[_i]), (PG8_LAS unsigned*)(lds + (bufoff) + ldsw + _i * 8192), 16, 0, 0); } while (0)
#define PG8_LDA(dst, b, h) do { _Pragma("unroll") for (int m = 0; m < 4; ++m) _Pragma("unroll") for (int k = 0; k < 2; ++k) dst[m][k] = *(const PG8_LAS bf16x8*)(lds + PG8_SA(b, h) + aoff + m * 2048 + k * 1024); } while (0)
#define PG8_LDB(dst, b, h) do { _Pragma("unroll") for (int n = 0; n < 2; ++n) _Pragma("unroll") for (int k = 0; k < 2; ++k) dst[n][k] = *(const PG8_LAS bf16x8*)(lds + PG8_SB(b, h) + boff + n * 2048 + k * 1024); } while (0)
#define PG8_MMA(ai, bj, At, Bt) do { __builtin_amdgcn_s_setprio(1); _Pragma("unroll") for (int m = 0; m < 4; ++m) _Pragma("unroll") for (int n = 0; n < 2; ++n) _Pragma("unroll") for (int k = 0; k < 2; ++k) \
        acc[ai][bj][m][n] = __builtin_amdgcn_mfma_f32_16x16x32_bf16(Bt[n][k], At[m][k], acc[ai][bj][m][n], 0, 0, 0); __builtin_amdgcn_s_setprio(0); } while (0)
#define PG8_WAIT_V(n) asm volatile("s_waitcnt vmcnt(" #n ")" ::: "memory")
#define PG8_WAIT_L(n) asm volatile("s_waitcnt lgkmcnt(" #n ")" ::: "memory")
#define PG8_BAR __builtin_amdgcn_s_barrier()
#define PG8_SCHED __builtin_amdgcn_sched_barrier(0)
    Unit cur, nxt; int ui = 0;
    if (!S.next(0, cur)) return;
    f32x4 acc[2][2][4][2];
#pragma unroll
    for (int a = 0; a < 2; ++a)
#pragma unroll
        for (int b = 0; b < 2; ++b)
#pragma unroll
            for (int m = 0; m < 4; ++m)
#pragma unroll
                for (int n = 0; n < 2; ++n) acc[a][b][m][n] = (f32x4){0.f, 0.f, 0.f, 0.f};
    bf16x8 At[4][2], B0[2][2], B1[2][2];
    const char* cA = (const char*)g.A + (size_t)cur.pm * tstepA; const char* cB = (const char*)g.Bt + (size_t)cur.pn * tstepB;
    S.a_ready(cur);
    if constexpr (SP2) {
        PG8_STAGE(PG8_SB(0, 0), cB, voffB); PG8_STAGE(PG8_SB(0, 1), cB + hstepB, voffB); PG8_STAGE(PG8_SA(0, 0), cA, voffA); PG8_STAGE(PG8_SA(0, 1), cA + hstepA, voffA);
        if (wr == 1) PG8_BAR;
        PG8_WAIT_V(2); PG8_BAR;
        PG8_STAGE(PG8_SB(1, 0), cB + kstep, voffB); PG8_STAGE(PG8_SA(1, 0), cA + kstep, voffA); PG8_STAGE(PG8_SB(1, 1), cB + hstepB + kstep, voffB);
        PG8_WAIT_V(6); PG8_BAR;
    } else {
        PG8_STAGE(PG8_SB(0, 0), cB, voffB); PG8_STAGE(PG8_SA(0, 0), cA, voffA); PG8_STAGE(PG8_SB(0, 1), cB + hstepB, voffB); PG8_STAGE(PG8_SA(0, 1), cA + hstepA, voffA);
        if (wr == 1) PG8_BAR;
        PG8_WAIT_V(4); PG8_BAR;
        PG8_STAGE(PG8_SB(1, 0), cB + kstep, voffB); PG8_STAGE(PG8_SA(1, 0), cA + kstep, voffA); PG8_STAGE(PG8_SB(1, 1), cB + hstepB + kstep, voffB);
        PG8_WAIT_V(6); PG8_BAR;
    }
    for (;;) {
        const bool has_next = S.next(ui + 1, nxt);
        const char* nA = has_next ? (const char*)g.A + (size_t)nxt.pm * tstepA : cA; const char* nB = has_next ? (const char*)g.Bt + (size_t)nxt.pn * tstepB : cB;
#pragma unroll 1
        for (int t = 0; t < nt; t += 2) {
            const bool last = (t == nt - 2);
            const char* a1 = cA + (size_t)(t + 1) * kstep;
            const char* a2 = last ? nA : cA + (size_t)(t + 2) * kstep; const char* b2 = last ? nB : cB + (size_t)(t + 2) * kstep;
            const char* a3 = a2 + kstep; const char* b3 = b2 + kstep;
            if (last && has_next) S.a_ready(nxt);
            if constexpr (SP2) {
            PG8_LDB(B0, 0, 0); PG8_LDB(B1, 0, 1); PG8_SCHED; PG8_LDA(At, 0, 0); PG8_STAGE(PG8_SA(1, 1), a1 + hstepA, voffA);
            PG8_WAIT_V(8); PG8_WAIT_L(0); PG8_BAR; PG8_MMA(0, 0, At, B0); PG8_MMA(0, 1, At, B1); PG8_BAR; PG8_SCHED;
            PG8_LDA(At, 0, 1); PG8_STAGE(PG8_SB(0, 0), b2, voffB); PG8_STAGE(PG8_SB(0, 1), b2 + hstepB, voffB); PG8_STAGE(PG8_SA(0, 0), a2, voffA);
            PG8_WAIT_V(8); PG8_WAIT_L(0); PG8_BAR; PG8_MMA(1, 0, At, B0); PG8_MMA(1, 1, At, B1); PG8_BAR; PG8_SCHED;
            PG8_LDB(B0, 1, 0); PG8_LDB(B1, 1, 1); PG8_SCHED; PG8_LDA(At, 1, 0); PG8_STAGE(PG8_SA(0, 1), a2 + hstepA, voffA);
            PG8_WAIT_V(8); PG8_WAIT_L(0); PG8_BAR; PG8_MMA(0, 0, At, B0); PG8_MMA(0, 1, At, B1); PG8_BAR; PG8_SCHED;
            PG8_LDA(At, 1, 1); PG8_STAGE(PG8_SB(1, 0), b3, voffB); PG8_STAGE(PG8_SB(1, 1), b3 + hstepB, voffB); PG8_STAGE(PG8_SA(1, 0), a3, voffA);
            PG8_WAIT_V(8); PG8_WAIT_L(0); PG8_BAR; PG8_MMA(1, 0, At, B0); PG8_MMA(1, 1, At, B1); PG8_BAR; PG8_SCHED;
            } else {
            PG8_LDB(B0, 0, 0); PG8_SCHED; PG8_LDA(At, 0, 0); PG8_STAGE(PG8_SA(1, 1), a1 + hstepA, voffA);
            PG8_WAIT_L(8); PG8_BAR; PG8_WAIT_L(0); PG8_MMA(0, 0, At, B0); PG8_BAR; PG8_SCHED;
            PG8_LDB(B1, 0, 1); PG8_STAGE(PG8_SB(0, 0), b2, voffB);
            PG8_BAR; PG8_WAIT_L(0); PG8_MMA(0, 1, At, B1); PG8_BAR;
            PG8_LDA(At, 0, 1); PG8_STAGE(PG8_SA(0, 0), a2, voffA);
            PG8_BAR; PG8_WAIT_L(0); PG8_MMA(1, 0, At, B0); PG8_BAR; PG8_SCHED;
            PG8_STAGE(PG8_SB(0, 1), b2 + hstepB, voffB);
            PG8_WAIT_V(6); PG8_BAR; PG8_MMA(1, 1, At, B1); PG8_BAR;
            PG8_LDB(B0, 1, 0); PG8_SCHED; PG8_LDA(At, 1, 0); PG8_STAGE(PG8_SA(0, 1), a2 + hstepA, voffA);
            PG8_WAIT_L(8); PG8_BAR; PG8_WAIT_L(0); PG8_MMA(0, 0, At, B0); PG8_BAR; PG8_SCHED;
            PG8_LDB(B1, 1, 1); PG8_STAGE(PG8_SB(1, 0), b3, voffB);
            PG8_BAR; PG8_WAIT_L(0); PG8_MMA(0, 1, At, B1); PG8_BAR;
            PG8_LDA(At, 1, 1); PG8_STAGE(PG8_SA(1, 0), a3, voffA);
            PG8_BAR; PG8_WAIT_L(0); PG8_MMA(1, 0, At, B0); PG8_BAR; PG8_SCHED;
            PG8_STAGE(PG8_SB(1, 1), b3 + hstepB, voffB);
            PG8_WAIT_V(6); PG8_BAR; PG8_MMA(1, 1, At, B1); PG8_BAR;
            }
        }
        if constexpr (ALIGN_EPI) { if (wr == 0) PG8_BAR; }
        if constexpr (!Epi::AFTER_DRAIN) { E(acc, cur, wr, wc, fr, fq); S.done(cur); }
        if (!has_next) break;
#pragma unroll
        for (int a = 0; a < 2; ++a)
#pragma unroll
            for (int b = 0; b < 2; ++b)
#pragma unroll
                for (int m = 0; m < 4; ++m)
#pragma unroll
                    for (int n = 0; n < 2; ++n) acc[a][b][m][n] = (f32x4){0.f, 0.f, 0.f, 0.f};
        cur = nxt; cA = nA; cB = nB; ++ui;
        if constexpr (ALIGN_EPI) { if (wr == 1) PG8_BAR; }
    }
    PG8_WAIT_V(0);
    if constexpr (!ALIGN_EPI) { if (wr == 0) PG8_BAR; }
    PG8_BAR;
    if constexpr (Epi::AFTER_DRAIN) { E.fused(acc, cur, wr, wc, fr, fq, lds, wid, lane); S.done(cur); }
#undef PG8_SA
#undef PG8_SB
#undef PG8_STAGE
#undef PG8_LDA
#undef PG8_LDB
#undef PG8_MMA
#undef PG8_WAIT_V
#undef PG8_WAIT_L
#undef PG8_BAR
#undef PG8_SCHED
}
}

#define LAS __attribute__((address_space(3)))
typedef unsigned short bf16_t;
typedef short bf16x8 __attribute__((ext_vector_type(8)));
typedef float f32x4 __attribute__((ext_vector_type(4)));
typedef float f32x16 __attribute__((ext_vector_type(16)));
typedef unsigned u32x4 __attribute__((ext_vector_type(4)));
typedef unsigned u32x2 __attribute__((ext_vector_type(2)));
typedef float f32x2_t __attribute__((ext_vector_type(2)));
typedef __bf16 bf16x2_t __attribute__((ext_vector_type(2)));

constexpr int MTOK = 32768, DM = 1024, SEQ = 8192;
constexpr int NIN = 5912, NINP = 6144, DFF = 2816;
constexpr float L2E = 1.4426950408889634f;
constexpr size_t MiB = 1048576;
constexpr size_t WS_CTL = 0, WS_WIN = 1 * MiB, WS_WBR = 13 * MiB, WS_WOUT = 15 * MiB, WS_WGU = 17 * MiB, WS_WDN = 28 * MiB, WS_WC1 = 34 * MiB,
                 WS_SMALL = 36 * MiB, WS_CMPH = 37 * MiB, WS_KC = 45 * MiB, WS_VCT = 45 * MiB + 512 * 1024, WS_NSG = 46 * MiB,
                 WS_H = 49 * MiB  , WS_A = 113 * MiB  ,
                 WS_B = 305 * MiB  , WS_END = 481 * MiB;
constexpr size_t HB_SBQ = 0, HB_SBK = 16, HB_SBVT = 32, HB_MBQ = 48, HB_MBK = 64, HB_MBVT = 80, HB_NSQ = 96, HB_KCR = 128, HB_VCR = 136,
                 HB_KS = 144, HB_VST = 152, HB_KW = 160, HB_VWT = 168;
constexpr int LDS_BYTES = 147456;
constexpr int ATT_BT = 36864, ATT_MISC = 50688, ATT_SEL = 50944, ATT_X = 51968, ATT_OA = 93952;

struct Params { const float* in[16]; float* out; unsigned char* ws; };

__device__ __forceinline__ unsigned pk2(float lo, float hi) { f32x2_t v = {lo, hi}; bf16x2_t b = __builtin_convertvector(v, bf16x2_t); return __builtin_bit_cast(unsigned, b); }
__device__ __forceinline__ float bf2f(unsigned v16) { return __uint_as_float(v16 << 16); }
__device__ __forceinline__ float bflo(unsigned w) { return __uint_as_float(w << 16); }
__device__ __forceinline__ float bfhi(unsigned w) { return __uint_as_float(w & 0xffff0000u); }
__device__ __forceinline__ float wave_sum(float v) { v += __shfl_xor(v, 1); v += __shfl_xor(v, 2); v += __shfl_xor(v, 4); v += __shfl_xor(v, 8); v += __shfl_xor(v, 16); v += __shfl_xor(v, 32); return v; }
__device__ __forceinline__ float wave_max(float v) { v = fmaxf(v, __shfl_xor(v, 1)); v = fmaxf(v, __shfl_xor(v, 2)); v = fmaxf(v, __shfl_xor(v, 4)); v = fmaxf(v, __shfl_xor(v, 8)); v = fmaxf(v, __shfl_xor(v, 16)); v = fmaxf(v, __shfl_xor(v, 32)); return v; }
__device__ __forceinline__ float sigmoidf_(float x) { return __builtin_amdgcn_rcpf(1.0f + __expf(-x)); }
__device__ __forceinline__ float ex2(float x) { return __builtin_amdgcn_exp2f(x); }
__device__ __forceinline__ float lg2(float x) { return __builtin_amdgcn_logf(x); }

template <int MAP> __device__ __forceinline__ int mapcol(int p) {
    const int pn = p >> 8, q = p & 255, bj = q >> 7, wc = (q >> 5) & 3, n = (q >> 4) & 1, fq = (q >> 2) & 3, e = q & 3;
    const int lc = 64 * wc + 32 * bj + 8 * fq + 4 * n + e;
    if (MAP == 3) return p;
    if (MAP == 0) return 256 * pn + lc;
    if (MAP == 1) { if (pn <= 10) return 256 * pn + lc; if (pn == 11) return lc < 24 ? 2816 + lc : -1; return 2840 + 256 * (pn - 12) + lc; }
    const int j = 128 * pn + 32 * wc + 8 * fq + 4 * n + e; return bj ? DFF + j : j;
}

struct EpiRes {
    static constexpr bool PERM = false, AFTER_DRAIN = false;
    const float* res; float* out;
    __device__ __forceinline__ void operator()(const f32x4 (&acc)[2][2][4][2], const pg8::Unit& u, int wr, int wc, int fr_, int fq_) const {
        int fr = fr_, fq = fq_; asm volatile("" : "+v"(fr), "+v"(fq));
#pragma unroll
        for (int ai = 0; ai < 2; ++ai)
#pragma unroll
            for (int m = 0; m < 4; ++m) { const unsigned row = (unsigned)(u.pm * 256 + 128 * ai + 64 * wr + 16 * m + fr);
#pragma unroll
                for (int bj = 0; bj < 2; ++bj)
#pragma unroll
                    for (int n = 0; n < 2; ++n) { const unsigned o = row * 1024u + (unsigned)(u.pn * 256 + 64 * wc + 32 * bj + 8 * fq + 4 * n);
                        const f32x4 r = *(const f32x4*)(res + o); *(f32x4*)(out + o) = r + acc[ai][bj][m][n]; }
                __builtin_amdgcn_sched_barrier(0); }
    }
};
struct EpiSwiglu {
    static constexpr bool PERM = false, AFTER_DRAIN = false;
    bf16_t* act;
    __device__ __forceinline__ void operator()(const f32x4 (&acc)[2][2][4][2], const pg8::Unit& u, int wr, int wc, int fr_, int fq_) const {
        int fr = fr_, fq = fq_; asm volatile("" : "+v"(fr), "+v"(fq));
#pragma unroll
        for (int ai = 0; ai < 2; ++ai)
#pragma unroll
            for (int m = 0; m < 4; ++m) { const unsigned row = (unsigned)(u.pm * 256 + 128 * ai + 64 * wr + 16 * m + fr);
                float v[8];
#pragma unroll
                for (int n = 0; n < 2; ++n)
#pragma unroll
                    for (int e = 0; e < 4; ++e) { const float g = acc[ai][0][m][n][e], up = acc[ai][1][m][n][e]; v[4 * n + e] = g * sigmoidf_(g) * up; }
                u32x4 w; w.x = pk2(v[0], v[1]); w.y = pk2(v[2], v[3]); w.z = pk2(v[4], v[5]); w.w = pk2(v[6], v[7]);
                *(u32x4*)(act + (row * 2816u + (unsigned)(u.pn * 128 + 32 * wc + 8 * fq))) = w; }
    }
};
template <int MODE> struct EpiBranch {
    static constexpr bool PERM = false, AFTER_DRAIN = false;
    const bf16_t* brg; bf16_t* mix; int s;
    __device__ __forceinline__ void operator()(const f32x4 (&acc)[2][2][4][2], const pg8::Unit& u, int wr, int wc, int fr_, int fq_) const {
        int fr = fr_, fq = fq_; asm volatile("" : "+v"(fr), "+v"(fq));
#pragma unroll
        for (int ai = 0; ai < 2; ++ai)
#pragma unroll
            for (int m = 0; m < 4; ++m) { const unsigned row = (unsigned)(u.pm * 256 + 128 * ai + 64 * wr + 16 * m + fr);
#pragma unroll
                for (int bj = 0; bj < 2; ++bj)
#pragma unroll
                    for (int n = 0; n < 2; ++n) { const unsigned c = (unsigned)(u.pn * 256 + 64 * wc + 32 * bj + 8 * fq + 4 * n);
                        const u32x2 g = *(const u32x2*)(brg + (row * 3072u + 1024u * (unsigned)s + c));
                        u32x2 o = {0u, 0u}; if (MODE) o = *(const u32x2*)(mix + (row * 1024u + c));
                        const f32x4 a = acc[ai][bj][m][n];
                        u32x2 w;
                        w.x = pk2(bflo(o.x) + bflo(g.x) * a[0], bfhi(o.x) + bfhi(g.x) * a[1]);
                        w.y = pk2(bflo(o.y) + bflo(g.y) * a[2], bfhi(o.y) + bfhi(g.y) * a[3]);
                        *(u32x2*)(mix + (row * 1024u + c)) = w; }
                __builtin_amdgcn_sched_barrier(0); }
    }
};
struct EpiCmp1 {
    static constexpr bool PERM = false, AFTER_DRAIN = false;
    const float* bias; float* hid;
    __device__ __forceinline__ void operator()(const f32x4 (&acc)[2][2][4][2], const pg8::Unit& u, int wr, int wc, int fr_, int fq_) const {
        int fr = fr_, fq = fq_; asm volatile("" : "+v"(fr), "+v"(fq));
#pragma unroll
        for (int ai = 0; ai < 2; ++ai)
#pragma unroll
            for (int m = 0; m < 4; ++m) { const unsigned row = (unsigned)(u.pm * 256 + 128 * ai + 64 * wr + 16 * m + fr);
#pragma unroll
                for (int bj = 0; bj < 2; ++bj)
#pragma unroll
                    for (int n = 0; n < 2; ++n) { const int c = 64 * wc + 32 * bj + 8 * fq + 4 * n;
                        const f32x4 b = *(const f32x4*)(bias + c); f32x4 x = acc[ai][bj][m][n] + b, y;
#pragma unroll
                        for (int e = 0; e < 4; ++e) { const float t = x[e], z = 0.7978845608028654f * (t + 0.044715f * t * t * t);
                            const float th = 1.0f - 2.0f * __builtin_amdgcn_rcpf(1.0f + __expf(2.0f * z)); y[e] = 0.5f * t * (1.0f + th); }
                        *(f32x4*)(hid + (row * 256u + (unsigned)c)) = y; } }
    }
};
struct EpiStoreF32 {
    static constexpr bool PERM = false, AFTER_DRAIN = false;
    float* hid;
    __device__ __forceinline__ void operator()(const f32x4 (&acc)[2][2][4][2], const pg8::Unit& u, int wr, int wc, int fr_, int fq_) const {
        int fr = fr_, fq = fq_; asm volatile("" : "+v"(fr), "+v"(fq));
#pragma unroll
        for (int ai = 0; ai < 2; ++ai)
#pragma unroll
            for (int m = 0; m < 4; ++m) { const unsigned row = (unsigned)(u.pm * 256 + 128 * ai + 64 * wr + 16 * m + fr);
#pragma unroll
                for (int bj = 0; bj < 2; ++bj)
#pragma unroll
                    for (int n = 0; n < 2; ++n) *(f32x4*)(hid + (row * 256u + (unsigned)(64 * wc + 32 * bj + 8 * fq + 4 * n))) = acc[ai][bj][m][n]; }
    }
};
struct EpiInproj {
    static constexpr bool PERM = false, AFTER_DRAIN = false;
    unsigned char* wsb; const float* nwb;
    __device__ __forceinline__ void operator()(const f32x4 (&acc)[2][2][4][2], const pg8::Unit& u, int wr, int wc, int fr_, int fq_) const {
        int fr = fr_, fq = fq_; asm volatile("" : "+v"(fr), "+v"(fq));
        const int t = u.pn; unsigned char* hb = wsb + WS_B; float* nsg = (float*)(wsb + WS_NSG); bf16_t* brg = (bf16_t*)(wsb + WS_A);
        const float* mqn = nwb; const float* mkn = nwb + 64; const float* nqn = nwb + 128; const float* nkn = nwb + 192;
        if (t <= 10) {
            const int hd = 4 * t + wc;
            const int grp = hd < 24 ? (hd >> 2) : (hd < 32 ? 6 : 7 + ((hd - 32) >> 1));
            const int hh = hd < 24 ? (hd & 3) : (hd < 32 ? hd - 24 : (hd & 1));
            const int H = grp < 6 ? 4 : (grp == 6 ? 8 : 2);
            bf16_t* base = (bf16_t*)(hb + (grp <= 6 ? (size_t)16 * grp : (size_t)(128 + 8 * (grp - 7))) * MiB);
            const bool trans = (grp == 2) | (grp == 5) | (grp == 10) | (grp == 12);
            const bool norm = (grp == 3) | (grp == 4) | (grp == 6) | (grp == 9) | (grp == 11);
            const float qs = ((grp == 0) | (grp == 3) | (grp == 6)) ? 0.125f * L2E : 1.0f;
            const float* nw = grp == 3 ? mqn : (grp == 4 ? mkn : (grp == 6 ? nqn : (grp == 9 ? nkn + 64 : nkn + 128)));
#pragma unroll
            for (int ai = 0; ai < 2; ++ai)
#pragma unroll
                for (int m = 0; m < 4; ++m) { const int row = u.pm * 256 + 128 * ai + 64 * wr + 16 * m + fr; const int b = row >> 13, s = row & 8191;
                    float v[2][8];
#pragma unroll
                    for (int bj = 0; bj < 2; ++bj)
#pragma unroll
                        for (int n = 0; n < 2; ++n)
#pragma unroll
                            for (int e = 0; e < 4; ++e) v[bj][4 * n + e] = acc[ai][bj][m][n][e];
                    float sc = qs;
                    if (norm) { float ss = 0.f;
#pragma unroll
                        for (int bj = 0; bj < 2; ++bj)
#pragma unroll
                            for (int j = 0; j < 8; ++j) ss += v[bj][j] * v[bj][j];
                        ss += __shfl_xor(ss, 16); ss += __shfl_xor(ss, 32);
                        sc = qs * __builtin_amdgcn_rsqf(ss * (1.0f / 64.0f) + 1e-6f);
#pragma unroll
                        for (int bj = 0; bj < 2; ++bj) { const f32x4 w0 = *(const f32x4*)(nw + 32 * bj + 8 * fq), w1 = *(const f32x4*)(nw + 32 * bj + 8 * fq + 4);
#pragma unroll
                            for (int e = 0; e < 4; ++e) { v[bj][e] *= w0[e]; v[bj][4 + e] *= w1[e]; } } }
                    if (!trans) {
#pragma unroll
                        for (int bj = 0; bj < 2; ++bj) { u32x4 w; w.x = pk2(v[bj][0] * sc, v[bj][1] * sc); w.y = pk2(v[bj][2] * sc, v[bj][3] * sc); w.z = pk2(v[bj][4] * sc, v[bj][5] * sc); w.w = pk2(v[bj][6] * sc, v[bj][7] * sc);
                            *(u32x4*)(base + (unsigned)(((b * H + hh) * SEQ + s) * 64 + 32 * bj + 8 * fq)) = w; }
                    } else {
#pragma unroll
                        for (int bj = 0; bj < 2; ++bj)
#pragma unroll
                            for (int j = 0; j < 8; j += 2) { const unsigned w = pk2(v[bj][j], v[bj][j + 1]); bf16_t* d = base + (unsigned)(((b * H + hh) * 64 + 32 * bj + 8 * fq + j) * SEQ + s);
                                d[0] = (bf16_t)(w & 0xffffu); d[SEQ] = (bf16_t)(w >> 16); }
                    } }
        } else if (t == 11) {
            if (wc == 0 && fq < 3) {
#pragma unroll
                for (int ai = 0; ai < 2; ++ai)
#pragma unroll
                    for (int m = 0; m < 4; ++m) { const unsigned row = (unsigned)(u.pm * 256 + 128 * ai + 64 * wr + 16 * m + fr);
#pragma unroll
                        for (int n = 0; n < 2; ++n) { f32x4 y;
#pragma unroll
                            for (int e = 0; e < 4; ++e) y[e] = sigmoidf_(acc[ai][0][m][n][e]);
                            *(f32x4*)(nsg + (row * 24u + (unsigned)(8 * fq + 4 * n))) = y; } }
            }
        } else {
#pragma unroll
            for (int ai = 0; ai < 2; ++ai)
#pragma unroll
                for (int m = 0; m < 4; ++m) { const unsigned row = (unsigned)(u.pm * 256 + 128 * ai + 64 * wr + 16 * m + fr);
#pragma unroll
                    for (int bj = 0; bj < 2; ++bj) { const f32x4 a0 = acc[ai][bj][m][0], a1 = acc[ai][bj][m][1]; u32x4 w;
                        w.x = pk2(sigmoidf_(a0[0]), sigmoidf_(a0[1])); w.y = pk2(sigmoidf_(a0[2]), sigmoidf_(a0[3]));
                        w.z = pk2(sigmoidf_(a1[0]), sigmoidf_(a1[1])); w.w = pk2(sigmoidf_(a1[2]), sigmoidf_(a1[3]));
                        *(u32x4*)(brg + (row * 3072u + (unsigned)((t - 12) * 256 + 64 * wc + 32 * bj + 8 * fq))) = w; } }
        }
    }
};

template <int MAP> __device__ __forceinline__ void prep_w(const float* __restrict__ W, int K, int ldw, bf16_t* __restrict__ Bt, int Np, int ldb, LAS unsigned char* lds, int tid, int bx, int G) {
    const int ntp = Np >> 6, ntiles = ntp * (K >> 6), w = tid >> 6, lane = tid & 63;
    float v[8];
    int tile = bx;
    if (tile < ntiles) { const int tk = tile / ntp, tp = tile - tk * ntp; const int col = mapcol<MAP>(tp * 64 + lane); const float* s = W + (size_t)(tk * 64 + 8 * w) * ldw + (col < 0 ? 0 : col);
#pragma unroll
        for (int i = 0; i < 8; ++i) v[i] = col >= 0 ? s[(size_t)i * ldw] : 0.f; }
    for (; tile < ntiles; tile += G) {
        const int tk = tile / ntp, tp = tile - tk * ntp;
        u32x4 pw; pw.x = pk2(v[0], v[1]); pw.y = pk2(v[2], v[3]); pw.z = pk2(v[4], v[5]); pw.w = pk2(v[6], v[7]);
        *(LAS u32x4*)(lds + lane * 144 + w * 16) = pw;
        __syncthreads();
        const int nx = tile + G;
        if (nx < ntiles) { const int tk2 = nx / ntp, tp2 = nx - tk2 * ntp; const int col = mapcol<MAP>(tp2 * 64 + lane); const float* s = W + (size_t)(tk2 * 64 + 8 * w) * ldw + (col < 0 ? 0 : col);
#pragma unroll
            for (int i = 0; i < 8; ++i) v[i] = col >= 0 ? s[(size_t)i * ldw] : 0.f; }
        { const int p = tid >> 3, pc = tid & 7; const u32x4 o = *(LAS const u32x4*)(lds + p * 144 + pc * 16);
            *(u32x4*)(Bt + (size_t)(tp * 64 + p) * ldb + tk * 64 + pc * 8) = o; }
        __syncthreads();
    }
}
__device__ __forceinline__ void rmsnorm_rows(const float* __restrict__ x, const float* __restrict__ g, bf16_t* __restrict__ h, int gwave, int nwaves, int lane) {
    for (int row = gwave; row < MTOK; row += nwaves) {
        const f32x4* xr = (const f32x4*)(x + (size_t)row * DM); f32x4 v[4]; float ss = 0.f;
#pragma unroll
        for (int i = 0; i < 4; ++i) { v[i] = xr[lane + 64 * i]; ss += v[i][0] * v[i][0] + v[i][1] * v[i][1] + v[i][2] * v[i][2] + v[i][3] * v[i][3]; }
        ss = wave_sum(ss); const float rs = __builtin_amdgcn_rsqf(ss * (1.0f / DM) + 1e-6f);
#pragma unroll
        for (int i = 0; i < 4; ++i) { const f32x4 gv = ((const f32x4*)g)[lane + 64 * i]; u32x2 w; w.x = pk2(v[i][0] * rs * gv[0], v[i][1] * rs * gv[1]); w.y = pk2(v[i][2] * rs * gv[2], v[i][3] * rs * gv[3]);
            *(u32x2*)(h + (size_t)row * DM + (lane + 64 * i) * 4) = w; }
    }
}

#define MFMA32(a, b, c) __builtin_amdgcn_mfma_f32_32x32x16_bf16((a), (b), (c), 0, 0, 0)
__device__ __forceinline__ void stage_ld(const bf16_t* K, const bf16_t* Vt, int ldvt, int key0, int tid, u32x4& rk, u32x4& rv) {
    const int row = tid >> 3, pc = tid & 7;
    rk = *(const u32x4*)(K + (size_t)(key0 + row) * 64 + pc * 8);
    rv = *(const u32x4*)(Vt + (size_t)row * ldvt + key0 + pc * 8);
}
__device__ __forceinline__ void stage_st(LAS unsigned char* lds, int buf, int tid, const u32x4& rk, const u32x4& rv) {
    const int row = tid >> 3, pc = tid & 7; LAS unsigned char* p = lds + buf * 18432 + row * 144 + pc * 16;
    *(LAS u32x4*)p = rk; *(LAS u32x4*)(p + 9216) = rv;
}
__device__ __forceinline__ void load_q(const bf16_t* qrow, int h, bf16x8 (&qf)[4]) {
#pragma unroll
    for (int kk = 0; kk < 4; ++kk) qf[kk] = *(const bf16x8*)(qrow + 16 * kk + 8 * h);
}
__device__ __forceinline__ f32x16 qk_sub(LAS const unsigned char* ks, int sub, const bf16x8 (&qf)[4], int r, int h, float init = 0.f) {
    const int pr = (r & 0x13) | ((r & 4) << 1) | ((r & 8) >> 1);
    LAS const unsigned char* p = ks + (32 * sub + pr) * 144 + h * 16;
    f32x16 st;
#pragma unroll
    for (int i = 0; i < 16; ++i) st[i] = init;
#pragma unroll
    for (int kk = 0; kk < 4; ++kk) { const bf16x8 kf = *(LAS const bf16x8*)(p + kk * 32); st = MFMA32(kf, qf[kk], st); }
    return st;
}
__device__ __forceinline__ void pv_sub(LAS const unsigned char* vs, int sub, const f32x16& p, f32x16 (&ot)[2], int r, int h) {
#pragma unroll
    for (int j = 0; j < 2; ++j) {
        u32x4 w; w.x = pk2(p[8 * j], p[8 * j + 1]); w.y = pk2(p[8 * j + 2], p[8 * j + 3]); w.z = pk2(p[8 * j + 4], p[8 * j + 5]); w.w = pk2(p[8 * j + 6], p[8 * j + 7]);
        const bf16x8 pf = __builtin_bit_cast(bf16x8, w);
#pragma unroll
        for (int mt = 0; mt < 2; ++mt) { const bf16x8 vf = *(LAS const bf16x8*)(vs + (32 * mt + r) * 144 + (32 * sub + 16 * j + 8 * h) * 2); ot[mt] = MFMA32(vf, pf, ot[mt]); }
    }
}
constexpr int BT_N = 288, BT_FAR = 64 + 223;
template <int MODE> __device__ __forceinline__ void soft_sub(f32x16& st, float& lsum, bool lane_valid, int dist0, int dmax, LAS const float* bt) {
    if (MODE == 0) {
#pragma unroll
        for (int i = 0; i < 16; ++i) { const float p = ex2(st[i]); lsum += p; st[i] = p; }
    } else if (MODE == 2) {
        const float cf = lane_valid ? bt[BT_FAR] : -3.0e38f;
#pragma unroll
        for (int i = 0; i < 16; ++i) { const int dist = dist0 - (16 * (i >> 3) + (i & 7)); const float b = dist < dmax ? cf : -3.0e38f;
            const float p = ex2(st[i] + b); lsum += p; st[i] = p; }
    } else if (MODE == 1) {
        float bb[16];
#pragma unroll
        for (int j = 0; j < 2; ++j) { int db = dist0 - 16 * j; db = db < -57 ? -57 : (db > 223 ? 223 : db); if (!lane_valid) db = -57;
            LAS const float* p = bt + (db + 64);
#pragma unroll
            for (int k = 0; k < 8; ++k) bb[8 * j + k] = p[-k]; }
#pragma unroll
        for (int i = 0; i < 16; ++i) { const float p = ex2(st[i] + bb[i]); lsum += p; st[i] = p; }
    } else {
        float bb[16];
#pragma unroll
        for (int i = 0; i < 16; ++i) { int d = dist0 - 16 * (16 * (i >> 3) + (i & 7)); d = d < -64 ? -64 : (d > 223 ? 223 : d); bb[i] = bt[d + 64]; }
#pragma unroll
        for (int i = 0; i < 16; ++i) { const float p = ex2(st[i] + bb[i]); lsum += p; st[i] = p; }
    }
}
template <int MODE> __device__ __forceinline__ void tile_soft(LAS const unsigned char* ks, LAS const unsigned char* vs, const bf16x8 (&qf)[4], f32x16 (&ot)[2], float& lsum,
                                                              bool lane_valid, int dist00, int dmax, LAS const float* bt, int r, int h) {
    const float init = MODE == 0 ? (lane_valid ? bt[BT_FAR] : -3.0e38f) : 0.f;
    f32x16 s0 = qk_sub(ks, 0, qf, r, h, init); f32x16 s1 = qk_sub(ks, 1, qf, r, h, init);
    soft_sub<MODE>(s0, lsum, lane_valid, dist00, dmax, bt); pv_sub(vs, 0, s0, ot, r, h);
    soft_sub<MODE>(s1, lsum, lane_valid, dist00 - (MODE == 3 ? 512 : 32), dmax, bt); pv_sub(vs, 1, s1, ot, r, h);
}
__device__ __forceinline__ void zero_ot(f32x16 (&ot)[2]) {
#pragma unroll
    for (int i = 0; i < 16; ++i) { ot[0][i] = 0.f; ot[1][i] = 0.f; }
}
__device__ __forceinline__ void store_ot(bf16_t* orow, const f32x16 (&ot)[2], int h) {
#pragma unroll
    for (int mt = 0; mt < 2; ++mt)
#pragma unroll
        for (int g = 0; g < 4; ++g) { u32x2 w; w.x = pk2(ot[mt][4 * g], ot[mt][4 * g + 1]); w.y = pk2(ot[mt][4 * g + 2], ot[mt][4 * g + 3]);
            *(u32x2*)(orow + 32 * mt + 8 * g + 4 * h) = w; }
}

#define TILE_LOOP(KP, VP, LDV, KEY_FIRST, NT, BODY) do { \
    int key0 = (KEY_FIRST); const int nt_ = (NT); u32x4 rkA_, rvA_, rkB_, rvB_; \
    __syncthreads(); \
    stage_ld((KP), (VP), (LDV), key0, tid, rkA_, rvA_); stage_st(lds, 0, tid, rkA_, rvA_); \
    if (nt_ > 1) stage_ld((KP), (VP), (LDV), key0 + 64, tid, rkA_, rvA_); \
    __syncthreads(); \
    for (int it_ = 0; it_ < nt_; ++it_) { const int buf_ = it_ & 1; \
        if (it_ + 2 < nt_) stage_ld((KP), (VP), (LDV), key0 + 128, tid, rkB_, rvB_); \
        { LAS const unsigned char* ks = lds + buf_ * 18432; LAS const unsigned char* vs = ks + 9216; BODY } \
        if (it_ + 1 < nt_) stage_st(lds, buf_ ^ 1, tid, rkA_, rvA_); \
        __syncthreads(); key0 += 64; rkA_ = rkB_; rvA_ = rvB_; } } while (0)

__device__ __forceinline__ void sb_sub(LAS const unsigned char* vs, int sb, f32x16& st, f32x16 (&ot)[2], float& C, int key0, int t, int r, int h) {
    float ls[16]; float Rlo = 0.f, Rhi = 0.f;
#pragma unroll
    for (int i = 0; i < 16; ++i) { const int s = key0 + 32 * sb + 16 * (i >> 3) + 8 * h + (i & 7); const bool causal = s < t;
        const float u = st[i]; const float sp = fmaxf(u, 0.f) + lg2(1.0f + ex2(-fabsf(u)));
        ls[i] = causal ? -sp : 0.f; st[i] = causal ? (u - sp) : -3.0e38f;
        if (i < 8) Rlo += ls[i]; else Rhi += ls[i]; }
    const float Plo = __shfl_xor(Rlo, 32), Phi = __shfl_xor(Rhi, 32);
    float la = C + (h == 0 ? Phi : 0.f);
#pragma unroll
    for (int i = 15; i >= 8; --i) { const float a = ex2(st[i] + la); la += ls[i]; st[i] = a; }
    la = C + Rhi + Phi + (h == 0 ? Plo : 0.f);
#pragma unroll
    for (int i = 7; i >= 0; --i) { const float a = ex2(st[i] + la); la += ls[i]; st[i] = a; }
    C += (Rlo + Rhi) + (Plo + Phi);
    pv_sub(vs, sb, st, ot, r, h);
}
__device__ __forceinline__ void sb_unit(LAS unsigned char* lds, const unsigned char* hb, bf16_t* omix, int b, int hd, int qblk, int tid) {
    const int lane = tid & 63, w = tid >> 6, r = lane & 31, h = lane >> 5;
    const int bh = b * 4 + hd, q0 = qblk * 256, t = q0 + 32 * w + r;
    const bf16_t* Q = (const bf16_t*)(hb + HB_SBQ * MiB) + ((size_t)bh * SEQ + t) * 64;
    const bf16_t* K = (const bf16_t*)(hb + HB_SBK * MiB) + (size_t)bh * SEQ * 64;
    const bf16_t* Vt = (const bf16_t*)(hb + HB_SBVT * MiB) + (size_t)bh * 64 * SEQ;
    bf16x8 qf[4]; load_q(Q, h, qf);
    f32x16 ot[2]; zero_ot(ot);
    float C = 0.f;
    int key0 = q0 + 192; u32x4 rkA_, rvA_, rkB_, rvB_;
    __syncthreads();
    stage_ld(K, Vt, SEQ, key0, tid, rkA_, rvA_); stage_st(lds, 0, tid, rkA_, rvA_);
    if (key0 >= 64) stage_ld(K, Vt, SEQ, key0 - 64, tid, rkA_, rvA_);
    __syncthreads();
    int buf = 0;
    for (;;) {
        const bool has_next = key0 >= 64;
        if (key0 >= 128) stage_ld(K, Vt, SEQ, key0 - 128, tid, rkB_, rvB_);
        if (key0 <= q0 + 32 * w + 31) {
            LAS const unsigned char* ks = lds + buf * 18432; LAS const unsigned char* vs = ks + 9216;
            f32x16 s1 = qk_sub(ks, 1, qf, r, h); f32x16 s0 = qk_sub(ks, 0, qf, r, h);
            if (key0 + 32 <= q0 + 32 * w + 31) sb_sub(vs, 1, s1, ot, C, key0, t, r, h);
            sb_sub(vs, 0, s0, ot, C, key0, t, r, h);
        }
        const int alive = __syncthreads_or(C > -150.0f ? 1 : 0);
        if (!(has_next && alive)) break;
        stage_st(lds, buf ^ 1, tid, rkA_, rvA_);
        __syncthreads(); buf ^= 1; key0 -= 64; rkA_ = rkB_; rvA_ = rvB_;
    }
    store_ot(omix + ((size_t)b * SEQ + t) * DM + hd * 64, ot, h);
}

__device__ __forceinline__ void moba_unit(LAS unsigned char* lds, const unsigned char* hb, const float* kmean, bf16_t* omix, int b, int hd, int blk, int tid) {
    const int lane = tid & 63, w = tid >> 6, r = lane & 31, h = lane >> 5;
    const int bh = b * 4 + hd, q0 = blk * 256, t = q0 + 32 * w + r;
    const bf16_t* Qb = (const bf16_t*)(hb + HB_MBQ * MiB) + ((size_t)bh * SEQ + q0) * 64;
    const bf16_t* K = (const bf16_t*)(hb + HB_MBK * MiB) + (size_t)bh * SEQ * 64;
    const bf16_t* Vt = (const bf16_t*)(hb + HB_MBVT * MiB) + (size_t)bh * 64 * SEQ;
    LAS unsigned* misc = (LAS unsigned*)(lds + ATT_MISC); LAS unsigned* selm = (LAS unsigned*)(lds + ATT_SEL);
    LAS float* km = (LAS float*)(lds + ATT_X); LAS float* sc = km + 32 * 64;
    LAS const float* bt = (LAS const float*)(lds + ATT_BT) + hd * BT_N;
    __syncthreads();
    if (tid == 0) misc[1] = 0u;
    if (blk > 3) {
        for (int i = tid; i < blk * 64; i += 512) km[i] = kmean[(size_t)bh * 32 * 64 + i];
        __syncthreads();
        { const int qi = tid & 255, part = tid >> 8; float q[64];
            const u32x4* qp = (const u32x4*)(Qb + (size_t)qi * 64);
#pragma unroll
            for (int c = 0; c < 8; ++c) { const u32x4 v = qp[c]; q[8 * c] = bflo(v.x); q[8 * c + 1] = bfhi(v.x); q[8 * c + 2] = bflo(v.y); q[8 * c + 3] = bfhi(v.y); q[8 * c + 4] = bflo(v.z); q[8 * c + 5] = bfhi(v.z); q[8 * c + 6] = bflo(v.w); q[8 * c + 7] = bfhi(v.w); }
            for (int n = part; n < blk; n += 2) { float a = 0.f;
#pragma unroll
                for (int d = 0; d < 64; ++d) a = fmaf(q[d], km[n * 64 + d], a);
                sc[qi * 33 + n] = a; } }
        __syncthreads();
        if (tid < 256) { unsigned m = 0u;
#pragma unroll 1
            for (int k = 0; k < 3; ++k) { float best = -3.0e38f; int bi = 0;
                for (int n = 0; n < blk; ++n) { const float v = sc[tid * 33 + n]; if (!((m >> n) & 1u) && v > best) { best = v; bi = n; } }
                m |= 1u << bi; }
            selm[tid] = m; atomicOr((unsigned*)&misc[1], m); }
    } else {
        const unsigned m = (1u << blk) - 1u; if (tid < 256) selm[tid] = m; if (tid == 0) misc[1] = m;
    }
    __syncthreads();
    const unsigned uni = misc[1], sel = selm[32 * w + r];
    bf16x8 qf[4]; load_q(Qb + (size_t)(32 * w + r) * 64, h, qf);
    f32x16 ot[2]; zero_ot(ot); float lsum = 0.f;
    const int kend = q0 + 256;
#define MOBA_NEXT(k_, out_) do { int kk_ = (k_) + 64; while (kk_ < q0 && !((uni >> (kk_ >> 8)) & 1u)) kk_ = (kk_ | 255) + 1; (out_) = kk_; } while (0)
    int key0, knext, knext2; MOBA_NEXT(-64, key0); MOBA_NEXT(key0, knext);
    u32x4 rkA_, rvA_, rkB_, rvB_;
    stage_ld(K, Vt, SEQ, key0, tid, rkA_, rvA_); stage_st(lds, 0, tid, rkA_, rvA_);
    if (knext < kend) stage_ld(K, Vt, SEQ, knext, tid, rkA_, rvA_);
    __syncthreads();
    int buf = 0;
    while (key0 < kend) {
        MOBA_NEXT(knext, knext2);
        if (knext < kend && knext2 < kend) stage_ld(K, Vt, SEQ, knext2, tid, rkB_, rvB_);
        {
            LAS const unsigned char* ks = lds + buf * 18432; LAS const unsigned char* vs = ks + 9216;
            const int n = key0 >> 8; const bool own = (n == blk);
            const bool lane_valid = own ? true : (((sel >> n) & 1u) != 0u);
            const bool skip = own ? (key0 > q0 + 32 * w + 31) : (__ballot(lane_valid) == 0ull);
            if (!skip) {
                const bool near = (q0 + 32 * w) - (key0 + 63) < 128;
                const int dist00 = t - (key0 + 8 * h);
                if (near) tile_soft<1>(ks, vs, qf, ot, lsum, lane_valid, dist00, 0, bt, r, h);
                else tile_soft<0>(ks, vs, qf, ot, lsum, lane_valid, dist00, 0, bt, r, h);
            }
        }
        if (knext < kend) stage_st(lds, buf ^ 1, tid, rkA_, rvA_);
        __syncthreads(); buf ^= 1; key0 = knext; knext = knext2; rkA_ = rkB_; rvA_ = rvB_;
    }
#undef MOBA_NEXT
    const float l = lsum + __shfl_xor(lsum, 32); const float inv = 1.0f / fmaxf(l, 1e-30f);
#pragma unroll
    for (int i = 0; i < 16; ++i) { ot[0][i] *= inv; ot[1][i] *= inv; }
    store_ot(omix + ((size_t)b * SEQ + t) * DM + 256 + hd * 64, ot, h);
}

__device__ __forceinline__ void imp_sub(f32x16& st, float invc, int nbase, LAS float* improw, int r) {
#pragma unroll
    for (int j = 0; j < 2; ++j) { const int a = (nbase + 16 * j) >> 3;
        float s0 = ((st[8 * j] + st[8 * j + 1]) + (st[8 * j + 2] + st[8 * j + 3])) * invc;
        float s1 = ((st[8 * j + 3] + st[8 * j + 4]) + (st[8 * j + 5] + st[8 * j + 6]) + st[8 * j + 7]) * invc;
        float s2 = st[8 * j + 7] * invc;
        s0 += __shfl_xor(s0, 8); s0 += __shfl_xor(s0, 16); s1 += __shfl_xor(s1, 8); s1 += __shfl_xor(s1, 16); s2 += __shfl_xor(s2, 8); s2 += __shfl_xor(s2, 16);
        if (r < 8) { LAS float* ip = improw + 2 * a; ip[0] += s0; ip[1] += s1; if (2 * a + 2 < 128) ip[2] += s2; } }
}
__device__ __forceinline__ void nsa_unit(LAS unsigned char* lds, const unsigned char* hb, const bf16_t* kc, const bf16_t* vct, const float* nsg, bf16_t* omix, int b, int g, int c, int tid) {
    const int lane = tid & 63, w = tid >> 6, r = lane & 31, h = lane >> 5;
    const int bg = b * 2 + g, q0 = c * 64, ql = 8 * w + (r & 7), t = q0 + ql, hq = 4 * g + (r >> 3);
    const bf16_t* Q = (const bf16_t*)(hb + HB_NSQ * MiB) + ((size_t)(b * 8 + hq) * SEQ + t) * 64;
    LAS unsigned* selm = (LAS unsigned*)(lds + ATT_SEL); LAS float* imp = (LAS float*)(lds + ATT_X);
    LAS const float* bt = (LAS const float*)(lds + ATT_BT) + (4 + hq) * BT_N;
    const float* gate = nsg + ((size_t)b * SEQ + t) * 24 + hq;
    bf16x8 qf[4]; load_q(Q, h, qf);
    f32x16 ot[2]; zero_ot(ot);
    LAS unsigned* oal = (LAS unsigned*)(lds + ATT_OA) + (w * 16) * 64 + lane;
    const bf16_t* Kc = kc + (size_t)bg * 512 * 64; const bf16_t* Vc = vct + (size_t)bg * 64 * 512;
    const int ntc = (4 * c + 3 + 63) >> 6;
    float lsum = 0.f;
    TILE_LOOP(Kc, Vc, 512, 0, ntc, {
        tile_soft<3>(ks, vs, qf, ot, lsum, true, t - 31 - 16 * (key0 + 8 * h), 0, bt, r, h); });
    const float lc = lsum + __shfl_xor(lsum, 32); const float invc = 1.0f / fmaxf(lc, 1e-30f);
    { const float gc = gate[0] * invc;
#pragma unroll
        for (int i = 0; i < 8; ++i) { oal[i * 64] = pk2(ot[0][2 * i] * gc, ot[0][2 * i + 1] * gc); oal[(8 + i) * 64] = pk2(ot[1][2 * i] * gc, ot[1][2 * i + 1] * gc); } }
    for (int i = tid; i < 64 * 129; i += 512) imp[i] = 0.f;
    if (tid < 256) selm[tid] = 0u;
    TILE_LOOP(Kc, Vc, 512, 0, ntc, {
        f32x16 s0 = qk_sub(ks, 0, qf, r, h); f32x16 s1 = qk_sub(ks, 1, qf, r, h); float dummy = 0.f;
        const int dist00 = t - 31 - 16 * (key0 + 8 * h);
        soft_sub<3>(s0, dummy, true, dist00, 0, bt); imp_sub(s0, invc, key0 + 8 * h, imp + ql * 129, r);
        soft_sub<3>(s1, dummy, true, dist00 - 512, 0, bt); imp_sub(s1, invc, key0 + 32 + 8 * h, imp + ql * 129, r); });
    { const int qi = tid >> 3, sub = tid & 7;
        if (c >= 16) {
            for (int m = 1 + sub; m <= c - 2; m += 8) { const float v = imp[qi * 129 + m]; int cnt = 0;
                for (int m2 = 1; m2 <= c - 2; ++m2) { const float v2 = imp[qi * 129 + m2]; cnt += ((v2 > v) || (v2 == v && m2 < m)) ? 1 : 0; }
                if (cnt < 13) atomicOr((unsigned*)&selm[qi * 4 + (m >> 5)], 1u << (m & 31)); }
            if (sub == 0) { atomicOr((unsigned*)&selm[qi * 4], 1u); atomicOr((unsigned*)&selm[qi * 4 + ((c - 1) >> 5)], 1u << ((c - 1) & 31)); atomicOr((unsigned*)&selm[qi * 4 + (c >> 5)], 1u << (c & 31)); }
        } else if (sub == 0) selm[qi * 4] = (1u << (c + 1)) - 1u;
    }
    __syncthreads();
    const unsigned sel0 = selm[ql * 4], sel1 = selm[ql * 4 + 1], sel2 = selm[ql * 4 + 2], sel3 = selm[ql * 4 + 3];
    { const bf16_t* Ks = (const bf16_t*)(hb + HB_KS * MiB) + (size_t)bg * SEQ * 64; const bf16_t* Vs = (const bf16_t*)(hb + HB_VST * MiB) + (size_t)bg * 64 * SEQ;
        zero_ot(ot); lsum = 0.f;
        TILE_LOOP(Ks, Vs, SEQ, 0, c + 1, {
            const int m = key0 >> 6; const unsigned sw = m < 32 ? sel0 : (m < 64 ? sel1 : (m < 96 ? sel2 : sel3));
            const bool lane_valid = ((sw >> (m & 31)) & 1u) != 0u;
            if (__ballot(lane_valid) != 0ull) { const int dist00 = t - (key0 + 8 * h);
                if ((c - m) < 3) tile_soft<1>(ks, vs, qf, ot, lsum, lane_valid, dist00, 0, bt, r, h);
                else tile_soft<0>(ks, vs, qf, ot, lsum, lane_valid, dist00, 0, bt, r, h); } });
        const float l = lsum + __shfl_xor(lsum, 32); const float gs = gate[8] / fmaxf(l, 1e-30f);
#pragma unroll
        for (int i = 0; i < 8; ++i) { const unsigned a0 = oal[i * 64], a1 = oal[(8 + i) * 64];
            oal[i * 64] = pk2(bflo(a0) + ot[0][2 * i] * gs, bfhi(a0) + ot[0][2 * i + 1] * gs); oal[(8 + i) * 64] = pk2(bflo(a1) + ot[1][2 * i] * gs, bfhi(a1) + ot[1][2 * i + 1] * gs); } }
    { const bf16_t* Kw = (const bf16_t*)(hb + HB_KW * MiB) + (size_t)bg * SEQ * 64; const bf16_t* Vw = (const bf16_t*)(hb + HB_VWT * MiB) + (size_t)bg * 64 * SEQ;
        zero_ot(ot); lsum = 0.f;
        const int kfirst = q0 >= 512 ? q0 - 512 : 0; const int ntw = ((q0 - kfirst) >> 6) + 1;
        TILE_LOOP(Kw, Vw, SEQ, kfirst, ntw, {
            const int dist00 = t - (key0 + 8 * h);
            if (key0 >= q0 - 128) tile_soft<1>(ks, vs, qf, ot, lsum, true, dist00, 0, bt, r, h);
            else if (key0 == q0 - 512) tile_soft<2>(ks, vs, qf, ot, lsum, true, dist00, 512, bt, r, h);
            else tile_soft<0>(ks, vs, qf, ot, lsum, true, dist00, 0, bt, r, h); });
        const float l = lsum + __shfl_xor(lsum, 32); const float gw = gate[16] / fmaxf(l, 1e-30f);
#pragma unroll
        for (int i = 0; i < 8; ++i) { const unsigned a0 = oal[i * 64], a1 = oal[(8 + i) * 64];
            ot[0][2 * i] = bflo(a0) + ot[0][2 * i] * gw; ot[0][2 * i + 1] = bfhi(a0) + ot[0][2 * i + 1] * gw; ot[1][2 * i] = bflo(a1) + ot[1][2 * i] * gw; ot[1][2 * i + 1] = bfhi(a1) + ot[1][2 * i + 1] * gw; } }
    store_ot(omix + ((size_t)b * SEQ + t) * DM + 512 + hq * 64, ot, h);
}

constexpr int FG_STAGE = 55296, FG_B = 36864, FG_PATCH = 110592;
__device__ __forceinline__ void fg_ld(const bf16_t* A, const bf16_t* Bt, int kt, int tid, u32x4 (&ra)[4], u32x4 (&rb)[2]) {
#pragma unroll
    for (int i = 0; i < 4; ++i) { const unsigned p = (unsigned)(tid + 512 * i); ra[i] = *(const u32x4*)(A + 64 * kt + ((p >> 3) * 1024u + 8u * (p & 7u))); }
#pragma unroll
    for (int i = 0; i < 2; ++i) { const unsigned p = (unsigned)(tid + 512 * i); rb[i] = *(const u32x4*)(Bt + 64 * kt + ((p >> 3) * 1024u + 8u * (p & 7u))); }
}
__device__ __forceinline__ void fg_st(LAS unsigned char* st, int tid, const u32x4 (&ra)[4], const u32x4 (&rb)[2]) {
#pragma unroll
    for (int i = 0; i < 4; ++i) { const int p = tid + 512 * i; *(LAS u32x4*)(st + (p >> 3) * 144 + (p & 7) * 16) = ra[i]; }
#pragma unroll
    for (int i = 0; i < 2; ++i) { const int p = tid + 512 * i; *(LAS u32x4*)(st + FG_B + (p >> 3) * 144 + (p & 7) * 16) = rb[i]; }
}
__device__ __forceinline__ void branch_tile(LAS unsigned char* lds, const bf16_t* omix, const bf16_t* wbr, const bf16_t* brg, bf16_t* mix, int pm, int pn, int tid) {
    const int lane = tid & 63, w = tid >> 6, r = lane & 31, h = lane >> 5, wr = w >> 1, wc = w & 1;
    const bf16_t* A = omix + (size_t)pm * 256 * DM; const bf16_t* Bt = wbr + (size_t)pn * 128 * DM;
    LAS unsigned char* patch = lds + FG_PATCH + w * 2560;
    f32x16 seg[2][2]; unsigned tot[2][2][8];
#pragma unroll
    for (int a = 0; a < 2; ++a)
#pragma unroll
        for (int c = 0; c < 2; ++c)
#pragma unroll
            for (int i = 0; i < 16; ++i) { seg[a][c][i] = 0.f; tot[a][c][i >> 1] = 0u; }
    u32x4 ra0[4], rb0[2], ra1[4], rb1[2];
    __syncthreads();
    fg_ld(A, Bt, 0, tid, ra0, rb0); fg_st(lds, tid, ra0, rb0);
    fg_ld(A, Bt, 1, tid, ra1, rb1);
    __syncthreads();
#define FG_COMPUTE(BUF) { LAS const unsigned char* sa = lds + (BUF) * FG_STAGE + (64 * wr + r) * 144 + h * 16; LAS const unsigned char* sb = lds + (BUF) * FG_STAGE + FG_B + (64 * wc + r) * 144 + h * 16; \
        _Pragma("unroll") for (int kk = 0; kk < 4; ++kk) { const bf16x8 a0 = *(LAS const bf16x8*)(sa + kk * 32), a1 = *(LAS const bf16x8*)(sa + 32 * 144 + kk * 32); \
            const bf16x8 b0 = *(LAS const bf16x8*)(sb + kk * 32), b1 = *(LAS const bf16x8*)(sb + 32 * 144 + kk * 32); \
            seg[0][0] = MFMA32(a0, b0, seg[0][0]); seg[0][1] = MFMA32(a0, b1, seg[0][1]); seg[1][0] = MFMA32(a1, b0, seg[1][0]); seg[1][1] = MFMA32(a1, b1, seg[1][1]); } }
#define FG_BAR() do { asm volatile("s_waitcnt lgkmcnt(0)" ::: "memory"); __builtin_amdgcn_s_barrier(); asm volatile("" ::: "memory"); } while (0)
#pragma unroll 1
    for (int kt = 0; kt < 16; kt += 2) {
        fg_ld(A, Bt, (kt + 2 < 16 ? kt + 2 : 15), tid, ra0, rb0);
        FG_COMPUTE(0);
        fg_st(lds + FG_STAGE, tid, ra1, rb1);
        FG_BAR();
        fg_ld(A, Bt, (kt + 3 < 16 ? kt + 3 : 15), tid, ra1, rb1);
        const bool segend = (kt == 2) || (kt == 6) || (kt == 14);
        const int s = kt == 2 ? 0 : (kt == 6 ? 1 : 2);
        u32x4 g0[2], g1[2];
#define FG_GLD(dst, rt_, ct_) { _Pragma("unroll") for (int j = 0; j < 2; ++j) { const int p = lane + 64 * j; dst[j] = *(const u32x4*)(brg + ((unsigned)(pm * 256 + 64 * wr + 32 * (rt_) + (p >> 2)) * 3072u + (unsigned)(1024 * s + pn * 128 + 64 * wc + 32 * (ct_) + 8 * (p & 3)))); } }
#define FG_GATE(src, rt_, ct_) { _Pragma("unroll") for (int j = 0; j < 2; ++j) { const int p = lane + 64 * j; *(LAS u32x4*)(patch + (p >> 2) * 80 + (p & 3) * 16) = src[j]; } }
#define FG_ACC(rt_, ct_) { float gg[16]; \
            _Pragma("unroll") for (int i = 0; i < 16; ++i) { const int tr = 8 * (i >> 2) + 4 * h + (i & 3); gg[i] = bf2f(*(LAS const unsigned short*)(patch + tr * 80 + r * 2)); } \
            _Pragma("unroll") for (int p2 = 0; p2 < 8; ++p2) { const unsigned tv = tot[rt_][ct_][p2]; \
                tot[rt_][ct_][p2] = pk2(fmaf(gg[2 * p2], seg[rt_][ct_][2 * p2], bflo(tv)), fmaf(gg[2 * p2 + 1], seg[rt_][ct_][2 * p2 + 1], bfhi(tv))); seg[rt_][ct_][2 * p2] = 0.f; seg[rt_][ct_][2 * p2 + 1] = 0.f; } }
        if (segend) { FG_GLD(g0, 0, 0); FG_GLD(g1, 0, 1); }
        FG_COMPUTE(1);
        if (segend) {
            FG_GATE(g0, 0, 0); FG_GLD(g0, 1, 0); FG_ACC(0, 0);
            FG_GATE(g1, 0, 1); FG_GLD(g1, 1, 1); FG_ACC(0, 1);
            FG_GATE(g0, 1, 0); FG_ACC(1, 0);
            FG_GATE(g1, 1, 1); FG_ACC(1, 1);
        }
#undef FG_GLD
#undef FG_GATE
#undef FG_ACC
        fg_st(lds, tid, ra0, rb0);
        FG_BAR();
    }
#undef FG_COMPUTE
#undef FG_BAR
#pragma unroll
    for (int rt = 0; rt < 2; ++rt)
#pragma unroll
        for (int ct = 0; ct < 2; ++ct) { const int tok0 = pm * 256 + 64 * wr + 32 * rt, n0 = pn * 128 + 64 * wc + 32 * ct;
#pragma unroll
            for (int p2 = 0; p2 < 8; ++p2) { const int tr = 8 * (p2 >> 1) + 4 * h + 2 * (p2 & 1); const unsigned tv = tot[rt][ct][p2];
                *(LAS unsigned short*)(patch + tr * 80 + r * 2) = (unsigned short)(tv & 0xffffu); *(LAS unsigned short*)(patch + (tr + 1) * 80 + r * 2) = (unsigned short)(tv >> 16); }
#pragma unroll
            for (int j = 0; j < 2; ++j) { const int p = lane + 64 * j; const u32x4 ov = *(LAS const u32x4*)(patch + (p >> 2) * 80 + (p & 3) * 16);
                *(u32x4*)(mix + ((unsigned)(tok0 + (p >> 2)) * 1024u + (unsigned)(n0 + 8 * (p & 3)))) = ov; } }
}

#define LAUNDER_S(x) asm volatile("" : "+s"(x))
#define GAS __attribute__((address_space(1)))
#define INP(k) ({ int k_ = (k); LAUNDER_S(k_); (const float*)(const GAS float*)P.in[k_]; })
#define POUT ((float*)(GAS float*)P.out)
#define PHASE_BEGIN int L = layer; LAUNDER_S(L); GAS unsigned char* wsg_ = (GAS unsigned char*)P.ws; LAUNDER_S(wsg_); unsigned char* ws = (unsigned char*)wsg_; int G = gridDim.x, bx = blockIdx.x; LAUNDER_S(G); LAUNDER_S(bx); int tid = threadIdx.x; asm volatile("" : "+v"(tid)); const int lane = tid & 63, wave = __builtin_amdgcn_readfirstlane(tid >> 6); (void)lane; (void)wave; (void)G; (void)bx; (void)L; (void)ws;
__global__ void __launch_bounds__(512, 2) hybrid_fwd(Params P) {
    extern __shared__ __attribute__((aligned(16))) unsigned char lds_raw[];
    LAS unsigned char* lds = (LAS unsigned char*)lds_raw;
    cg::grid_group grid = cg::this_grid();
#pragma unroll 1
    for (int layer = 0; layer < 2; ++layer) {
#ifndef REP_A
#define REP_A 1
#endif
#ifndef REP_CD
#define REP_CD 1
#endif
        for (int repa_ = 0; repa_ < REP_A; ++repa_)
        { PHASE_BEGIN
            const int gtid = bx * 512 + tid, gthreads = G * 512, gwave = bx * 8 + wave, nwaves = G * 8;
            prep_w<1>(INP(3) + (size_t)L * DM * NIN, DM, NIN, (bf16_t*)(ws + WS_WIN), NINP, DM, lds, tid, bx, G);
            prep_w<3>(INP(11) + (size_t)L * DM * DM, DM, DM, (bf16_t*)(ws + WS_WBR), DM, DM, lds, tid, bx, G);
            prep_w<0>(INP(12) + (size_t)L * DM * DM, DM, DM, (bf16_t*)(ws + WS_WOUT), DM, DM, lds, tid, bx, G);
            prep_w<2>(INP(14) + (size_t)L * DM * 2 * DFF, DM, 2 * DFF, (bf16_t*)(ws + WS_WGU), 2 * DFF, DM, lds, tid, bx, G);
            prep_w<0>(INP(15) + (size_t)L * DFF * DM, DFF, DM, (bf16_t*)(ws + WS_WDN), DM, DFF, lds, tid, bx, G);
            const float* cw1 = INP(9) + (size_t)L * 2 * 2048 * 256;
            prep_w<0>(cw1, 2048, 256, (bf16_t*)(ws + WS_WC1), 256, 2048, lds, tid, bx, G);
            prep_w<0>(cw1 + 2048 * 256, 2048, 256, (bf16_t*)(ws + WS_WC1) + 256 * 2048, 256, 2048, lds, tid, bx, G);
            rmsnorm_rows(L == 0 ? INP(0) : (const float*)POUT, INP(2) + L * DM, (bf16_t*)(ws + WS_H), gwave, nwaves, lane);
            if (gwave < 512) { const int kv = gwave >> 8, j = gwave & 255; const float* pp = INP(8) + (size_t)L * 2 * 2048 + kv * 2048; const float* ww = cw1 + (size_t)kv * 2048 * 256 + j; float a = 0.f;
#pragma unroll 8
                for (int i = lane; i < 2048; i += 64) a = fmaf(pp[i], ww[(size_t)i * 256], a);
                a = wave_sum(a);
                if (lane == 0) ((float*)(ws + WS_SMALL))[kv * 256 + j] = a; }
            if (bx == 1 && tid < 384) { float* nw = (float*)(ws + WS_SMALL + 2048); const float v = tid < 64 ? (INP(4) + L * 64)[tid] : (tid < 128 ? (INP(5) + L * 64)[tid - 64] : (tid < 192 ? (INP(6) + L * 64)[tid - 128] : (INP(7) + L * 192)[tid - 192])); nw[tid] = v; }
        }
        grid.sync();

        { PHASE_BEGIN
            pg8::Gemm g{(const bf16_t*)(ws + WS_H), (const bf16_t*)(ws + WS_WIN), MTOK, NINP, DM, DM, DM}; pg8::StaticOrder S; S.init(MTOK, NINP, G, bx);
            EpiInproj E{ws, (const float*)(ws + WS_SMALL + 2048)};
#ifndef SKIP_B
            pg8::gemm_phase<EpiInproj, pg8::StaticOrder, true, true>(lds, g, S, E, tid);
#endif
        }
        grid.sync();

        for (int repcd_ = 0; repcd_ < REP_CD; ++repcd_) {
        { PHASE_BEGIN
            if (bx < 128) { const int kv = bx >> 6, ks = (bx >> 4) & 3;
                pg8::Gemm g{(const bf16_t*)(ws + WS_B + (kv ? HB_VCR : HB_KCR) * MiB) + ks * 512, (const bf16_t*)(ws + WS_WC1) + (size_t)kv * 256 * 2048 + ks * 512, 4096, 256, 512, 1024, 2048};
                pg8::StaticOrder S; S.init(4096, 256, G, bx & 15);
                EpiStoreF32 E{(float*)(ws + WS_H) + (size_t)(kv * 4 + ks) * 4096 * 256};
#ifndef SKIP_C
                pg8::gemm_phase<EpiStoreF32, pg8::StaticOrder, true, true>(lds, g, S, E, tid);
#endif
            } else {
                const bf16_t* mbk = (const bf16_t*)(ws + WS_B + HB_MBK * MiB); float* KMEAN = (float*)(ws + WS_SMALL + 4096);
                for (int item = (bx - 128) * 8 + wave; item < 512; item += (G - 128) * 8) { const int bh = item >> 5, n = item & 31;
                    const bf16_t* kp = mbk + ((size_t)bh * SEQ + 256 * n) * 64 + lane; float a = 0.f;
#pragma unroll 8
                    for (int j = 0; j < 256; ++j) a += bf2f(kp[(size_t)j * 64]);
                    KMEAN[(size_t)item * 64 + lane] = a * (1.0f / 256.0f); }
            }
        }
        grid.sync();

        { PHASE_BEGIN
            const int gwave = bx * 8 + wave, nwaves = G * 8;
            const float* cw2 = INP(10) + (size_t)L * 2 * 256 * 64; const float* nkn = INP(7) + L * 192;
            bf16_t* KC = (bf16_t*)(ws + WS_KC); bf16_t* VCT = (bf16_t*)(ws + WS_VCT);
            for (int row = gwave; row < 8192; row += nwaves) { const int kv = row >> 12, rr = row & 4095, bg = rr >> 9, n = rr & 511;
                f32x4 hv = *(const f32x4*)((const float*)(ws + WS_SMALL) + kv * 256 + 4 * lane);
                { const float* pp = (const float*)(ws + WS_H) + ((size_t)(kv * 4) * 4096 + rr) * 256 + 4 * lane;
#pragma unroll
                    for (int ks = 0; ks < 4; ++ks) hv += *(const f32x4*)(pp + (size_t)ks * 4096 * 256);
#pragma unroll
                    for (int e = 0; e < 4; ++e) { const float t = hv[e], z = 0.7978845608028654f * (t + 0.044715f * t * t * t);
                        const float th = 1.0f - 2.0f * __builtin_amdgcn_rcpf(1.0f + __expf(2.0f * z)); hv[e] = 0.5f * t * (1.0f + th); } }
                const float* wp = cw2 + (size_t)kv * 256 * 64 + lane; float a = 0.f;
#pragma unroll
                for (int k = 0; k < 256; ++k) { const float hk = __uint_as_float(__builtin_amdgcn_readlane(__float_as_uint(hv[k & 3]), k >> 2)); a = fmaf(hk, wp[k * 64], a); }
                if (kv == 0) { const float ss = wave_sum(a * a); float y = a * __builtin_amdgcn_rsqf(ss * (1.0f / 64.0f) + 1e-6f) * nkn[lane]; if (n == 511) y = 0.f;
                    KC[((size_t)bg * 512 + n) * 64 + lane] = (bf16_t)(pk2(y, 0.f) & 0xffffu); }
                else { if (n == 511) a = 0.f; VCT[((size_t)bg * 64 + lane) * 512 + n] = (bf16_t)(pk2(a, 0.f) & 0xffffu); } }
        }
        grid.sync();

        }
        { PHASE_BEGIN
            LAS unsigned* misc = (LAS unsigned*)(lds + ATT_MISC); LAS float* btab = (LAS float*)(lds + ATT_BT);
            const float* rel_bias = INP(1);
            __syncthreads();
            if (wave == 0) { const float* mqn = INP(4) + L * 64; const float* mkn = INP(5) + L * 64; const float* nqn = INP(6) + L * 64; const float* nkn = INP(7) + L * 192;
                float gq = fmaxf(fabsf(mqn[lane]), fabsf(nqn[lane])); float gk = fmaxf(fmaxf(fabsf(mkn[lane]), fabsf(nkn[lane])), fmaxf(fabsf(nkn[64 + lane]), fabsf(nkn[128 + lane])));
                float bm = 0.f;
#pragma unroll
                for (int i = 0; i < 6; ++i) bm = fmaxf(bm, fabsf(rel_bias[lane + 64 * i]));
                gq = wave_max(gq); gk = wave_max(gk); bm = wave_max(bm);
                if (lane == 0) ((LAS float*)misc)[2] = 8.0f * gq * gk + bm; }
            __syncthreads();
            const float shift = ((LAS float*)misc)[2];
            for (int i = tid; i < 12 * BT_N; i += 512) { const int hd = i / BT_N, jx = i - hd * BT_N; const int d = jx - 64;
                float v = -3.0e38f;
                if (d >= 0) { int bk; if (d < 16) bk = d; else if (d >= 128) bk = 31; else { bk = 16 + (int)(__log2f((float)d * (1.0f / 16.0f)) * (16.0f / 3.0f)); bk = bk > 31 ? 31 : bk; }
                    v = (rel_bias[bk * 12 + hd] - shift) * L2E; }
                btab[i] = v; }
            __syncthreads();
#ifndef REP_E
#define REP_E 1
#endif
            for (int rep_ = 0; rep_ < REP_E; ++rep_) {
            unsigned* ctl = (unsigned*)(ws + WS_CTL) + L + 2 * rep_;
            unsigned char* HBUF = ws + WS_B; bf16_t* OMIX = (bf16_t*)(ws + WS_H);
            for (;;) {
                __syncthreads();
                if (tid == 0) misc[0] = atomicAdd(ctl, 1u);
                __syncthreads();
                const int u = (int)misc[0];
                if (u >= 2048) break;
                int tidu = tid; asm volatile("" : "+v"(tidu));
                if (u < 1024) { const int c = 127 - (u >> 3), bg = u & 7;
#ifndef SKIP_NSA
                    nsa_unit(lds, HBUF, (const bf16_t*)(ws + WS_KC), (const bf16_t*)(ws + WS_VCT), (const float*)(ws + WS_NSG), OMIX, bg >> 1, bg & 1, c, tidu);
#endif
                }
                else if (u < 1536) { const int v = u - 1024;
#ifndef SKIP_MOBA
                    moba_unit(lds, HBUF, (const float*)(ws + WS_SMALL + 4096), OMIX, (v & 15) >> 2, v & 3, 31 - (v >> 4), tidu);
#endif
                }
                else { const int v = u - 1536;
#ifndef SKIP_SB
                    sb_unit(lds, HBUF, OMIX, (v & 15) >> 2, v & 3, 31 - (v >> 4), tidu);
#endif
                }
            }
            }
        }
        grid.sync();

        { PHASE_BEGIN
            for (int tl = bx; tl < 1024; tl += G) { int tidu = tid; asm volatile("" : "+v"(tidu));
                branch_tile(lds, (const bf16_t*)(ws + WS_H), (const bf16_t*)(ws + WS_WBR), (const bf16_t*)(ws + WS_A), (bf16_t*)(ws + WS_B), tl >> 3, tl & 7, tidu); }
        }
        grid.sync();

        { PHASE_BEGIN
            pg8::Gemm g{(const bf16_t*)(ws + WS_B), (const bf16_t*)(ws + WS_WOUT), MTOK, DM, DM, DM, DM}; pg8::StaticOrder S; S.init(MTOK, DM, G, bx);
            EpiRes E{L == 0 ? INP(0) : (const float*)POUT, POUT};
#ifndef SKIP_GJ
            pg8::gemm_phase<EpiRes, pg8::StaticOrder, true, true>(lds, g, S, E, tid);
#endif
        }
        grid.sync();

        { PHASE_BEGIN
            rmsnorm_rows(POUT, INP(13) + L * DM, (bf16_t*)(ws + WS_H), bx * 8 + wave, G * 8, lane); }
        grid.sync();

        { PHASE_BEGIN
            pg8::Gemm g{(const bf16_t*)(ws + WS_H), (const bf16_t*)(ws + WS_WGU), MTOK, 2 * DFF, DM, DM, DM}; pg8::StaticOrder S; S.init(MTOK, 2 * DFF, G, bx); EpiSwiglu E{(bf16_t*)(ws + WS_A)};
#ifndef SKIP_I
            pg8::gemm_phase<EpiSwiglu, pg8::StaticOrder, true, true>(lds, g, S, E, tid);
#endif
        }
        grid.sync();

        { PHASE_BEGIN
            pg8::Gemm g{(const bf16_t*)(ws + WS_A), (const bf16_t*)(ws + WS_WDN), MTOK, DM, DFF, DFF, DFF}; pg8::StaticOrder S; S.init(MTOK, DM, G, bx); EpiRes E{POUT, POUT};
#ifndef SKIP_GJ
            pg8::gemm_phase<EpiRes, pg8::StaticOrder, true, true>(lds, g, S, E, tid);
#endif
        }
        if (layer == 0) grid.sync();
    }
}

extern "C" void kernel_launch(void* const* d_in, const int* in_sizes, int n_in, void* d_out, int out_size, void* d_ws, size_t ws_size, hipStream_t stream) {
    static int grid = 0;
    if (grid == 0) {
        if (n_in != 16 || out_size != MTOK * DM || ws_size < WS_END) { fprintf(stderr, "kernel_launch: unexpected shapes (n_in %d out %d ws %zu, need ws >= %zu)\n", n_in, out_size, ws_size, (size_t)WS_END); grid = -1; return; }
        int dev = 0, cus = 0, per_cu = 0;
        hipGetDevice(&dev); hipDeviceGetAttribute(&cus, hipDeviceAttributeMultiprocessorCount, dev);
        if (hipFuncSetAttribute((const void*)hybrid_fwd, hipFuncAttributeMaxDynamicSharedMemorySize, LDS_BYTES) != hipSuccess) { fprintf(stderr, "kernel_launch: hipFuncSetAttribute failed\n"); grid = -1; return; }
        if (hipOccupancyMaxActiveBlocksPerMultiprocessor(&per_cu, (const void*)hybrid_fwd, 512, LDS_BYTES) != hipSuccess || per_cu < 1) { fprintf(stderr, "kernel_launch: occupancy query gave %d\n", per_cu); per_cu = 1; }
        (void)hipGetLastError();
        grid = cus * 1;
    }
    if (grid < 0) return;
    hipMemsetAsync((char*)d_ws + WS_CTL, 0, 4096, stream);
    Params p{};
    for (int i = 0; i < 16; ++i) p.in[i] = (const float*)d_in[i];
    p.out = (float*)d_out; p.ws = (unsigned char*)d_ws;
    void* args[] = {&p};
    hipError_t e = hipLaunchCooperativeKernel((const void*)hybrid_fwd, dim3(grid), dim3(512), args, LDS_BYTES, stream);
    if (e != hipSuccess) fprintf(stderr, "cooperative launch failed: %s (grid %d)\n", hipGetErrorString(e), grid);
}
```

```cpp
#include <hip/hip_runtime.h>
#include <hip/hip_cooperative_groups.h>
#include <cstdio>
#include <cstdint>
namespace cg = cooperative_groups;
namespace pg8 {
#define PG8_LAS __attribute__((address_space(3)))
typedef unsigned short bf16_t;
typedef short bf16x8 __attribute__((ext_vector_type(8)));
typedef float f32x4 __attribute__((ext_vector_type(4)));
typedef unsigned u32x4 __attribute__((ext_vector_type(4)));
constexpr int BM = 256, BK = 64, HALF = 128, HTB = HALF * BK * 2  , STAGE_BYTES = 8 * HTB, NXCD = 8, WGM = 8;

__host__ __device__ __forceinline__ int lds_byte(int r, int c) { const int st = (r >> 4) * 2 + (c >> 5), rr = r & 15, cc = c & 31, ob = rr * 64 + cc * 2; return st * 1024 + (ob ^ (((ob >> 9) & 1) << 5)); }
__host__ __device__ __forceinline__ void stage_rc(int b, int& R, int& C) { const int st = b / 1024, sb = b % 1024, swz = sb ^ (((sb >> 9) & 1) << 5); R = (st >> 1) * 16 + swz / 64; C = (st & 1) * 32 + (swz % 64) / 2; }
__host__ __device__ __forceinline__ int perm32(int rho) { const int n = rho >> 4, i = rho & 15; return 8 * (i >> 2) + 4 * n + (i & 3); }

struct Unit { int pm, pn; };
struct Gemm { const bf16_t* A; const bf16_t* Bt; int M, N, K, lda, ldb; };

struct StaticOrder {
    int nM, nN, nwg, G, c;
    __host__ __device__ void init(int M, int N, int G_, int c_) { nM = M / BM; nN = N / BM; nwg = nM * nN; G = G_; c = c_; }
    __host__ __device__ bool next(int i, Unit& u) const {
        const long L = (long)i * G + c; if (L >= nwg) return false;
        int wgid = (int)L; { const int q = nwg / NXCD, r = nwg % NXCD, xcd = wgid % NXCD, off = wgid / NXCD; wgid = (xcd < r ? xcd * (q + 1) : r * (q + 1) + (xcd - r) * q) + off; }
        const int nig = WGM * nN, gid = wgid / nig, fm = gid * WGM, gsz = (nM - fm) < WGM ? (nM - fm) : WGM;
        u.pm = fm + ((wgid % nig) % gsz); u.pn = (wgid % nig) / gsz; return true;
    }
    __device__ __forceinline__ void a_ready(const Unit&) const {}
    __device__ __forceinline__ void done(const Unit&) const {}
};
template <class Epi, class Sched, bool ALIGN_EPI = false, bool SP2 = false>
__device__ __forceinline__ void gemm_phase(PG8_LAS unsigned char* lds, const Gemm g, const Sched& S, const Epi& E, int tid_in) {
    const int tid = tid_in, wid = __builtin_amdgcn_readfirstlane(tid >> 6), lane = tid & 63, wr = wid >> 2, wc = wid & 3, fr = lane & 15, fq = lane >> 4;
    const int K = g.K, nt = K / BK;
    unsigned voffA[2], voffB[2];
#pragma unroll
    for (int i = 0; i < 2; ++i) { int R, C; stage_rc(tid * 16 + i * 8192, R, C); const int Rb = Epi::PERM ? ((R & ~31) + perm32(R & 31)) : R;
        voffA[i] = (unsigned)(R * g.lda + C) * 2u; voffB[i] = (unsigned)(Rb * g.ldb + C) * 2u; }
    const size_t kstep = (size_t)(BK * 2);
    const size_t hstepA = (size_t)HALF * g.lda * 2, hstepB = (size_t)HALF * g.ldb * 2;
    const size_t tstepA = 2 * hstepA, tstepB = 2 * hstepB;
    const unsigned ldsw = (unsigned)wid * 1024u;
    const int aoff = lds_byte(wr * 64 + fr, fq * 8), boff = lds_byte(wc * 32 + fr, fq * 8);
#define PG8_SA(b, h) (((b) * 2 + (h)) * HTB)
#define PG8_SB(b, h) ((4 + (b) * 2 + (h)) * HTB)
#define PG8_STAGE(bufoff, gbase, voff) do { _Pragma("unroll") for (int _i = 0; _i < 2; ++_i) \
        __builtin_amdgcn_global_load_lds((const unsigned*)((const char*)(gbase) + (voff)[_i]), (PG8_LAS unsigned*)(lds + (bufoff) + ldsw + _i * 8192), 16, 0, 0); } while (0)
#define PG8_LDA(dst, b, h) do { _Pragma("unroll") for (int m = 0; m < 4; ++m) _Pragma("unroll") for (int k = 0; k < 2; ++k) dst[m][k] = *(const PG8_LAS bf16x8*)(lds + PG8_SA(b, h) + aoff + m * 2048 + k * 1024); } while (0)
#define PG8_LDB(dst, b, h) do { _Pragma("unroll") for (int n = 0; n < 2; ++n) _Pragma("unroll") for (int k = 0; k < 2; ++k) dst[n][k] = *(const PG8_LAS bf16x8*)(lds + PG8_SB(b, h) + boff + n * 2048 + k * 1024); } while (0)
#define PG8_MMA(ai, bj, At, Bt) do { __builtin_amdgcn_s_setprio(1); _Pragma("unroll") for (int m = 0; m < 4; ++m) _Pragma("unroll") for (int n = 0; n < 2; ++n) _Pragma("unroll") for (int k = 0; k < 2; ++k) \
        acc[ai][bj][m][n] = __builtin_amdgcn_mfma_f32_16x16x32_bf16(Bt[n][k], At[m][k], acc[ai][bj][m][n], 0, 0, 0); __builtin_amdgcn_s_setprio(0); } while (0)
#define PG8_WAIT_V(n) asm volatile("s_waitcnt vmcnt(" #n ")" ::: "memory")
#define PG8_WAIT_L(n) asm volatile("s_waitcnt lgkmcnt(" #n ")" ::: "memory")
#define PG8_BAR __builtin_amdgcn_s_barrier()
#define PG8_SCHED __builtin_amdgcn_sched_barrier(0)
    Unit cur, nxt; int ui = 0;
    if (!S.next(0, cur)) return;
    f32x4 acc[2][2][4][2];
#pragma unroll
    for (int a = 0; a < 2; ++a)
#pragma unroll
        for (int b = 0; b < 2; ++b)
#pragma unroll
            for (int m = 0; m < 4; ++m)
#pragma unroll
                for (int n = 0; n < 2; ++n) acc[a][b][m][n] = (f32x4){0.f, 0.f, 0.f, 0.f};
    bf16x8 At[4][2], B0[2][2], B1[2][2];
    const char* cA = (const char*)g.A + (size_t)cur.pm * tstepA; const char* cB = (const char*)g.Bt + (size_t)cur.pn * tstepB;
    S.a_ready(cur);
    if constexpr (SP2) {
        PG8_STAGE(PG8_SB(0, 0), cB, voffB); PG8_STAGE(PG8_SB(0, 1), cB + hstepB, voffB); PG8_STAGE(PG8_SA(0, 0), cA, voffA); PG8_STAGE(PG8_SA(0, 1), cA + hstepA, voffA);
        if (wr == 1) PG8_BAR;
        PG8_WAIT_V(2); PG8_BAR;
        PG8_STAGE(PG8_SB(1, 0), cB + kstep, voffB); PG8_STAGE(PG8_SA(1, 0), cA + kstep, voffA); PG8_STAGE(PG8_SB(1, 1), cB + hstepB + kstep, voffB);
        PG8_WAIT_V(6); PG8_BAR;
    } else {
        PG8_STAGE(PG8_SB(0, 0), cB, voffB); PG8_STAGE(PG8_SA(0, 0), cA, voffA); PG8_STAGE(PG8_SB(0, 1), cB + hstepB, voffB); PG8_STAGE(PG8_SA(0, 1), cA + hstepA, voffA);
        if (wr == 1) PG8_BAR;
        PG8_WAIT_V(4); PG8_BAR;
        PG8_STAGE(PG8_SB(1, 0), cB + kstep, voffB); PG8_STAGE(PG8_SA(1, 0), cA + kstep, voffA); PG8_STAGE(PG8_SB(1, 1), cB + hstepB + kstep, voffB);
        PG8_WAIT_V(6); PG8_BAR;
    }
    for (;;) {
        const bool has_next = S.next(ui + 1, nxt);
        const char* nA = has_next ? (const char*)g.A + (size_t)nxt.pm * tstepA : cA; const char* nB = has_next ? (const char*)g.Bt + (size_t)nxt.pn * tstepB : cB;
#pragma unroll 1
        for (int t = 0; t < nt; t += 2) {
            const bool last = (t == nt - 2);
            const char* a1 = cA + (size_t)(t + 1) * kstep;
            const char* a2 = last ? nA : cA + (size_t)(t + 2) * kstep; const char* b2 = last ? nB : cB + (size_t)(t + 2) * kstep;
            const char* a3 = a2 + kstep; const char* b3 = b2 + kstep;
            if (last && has_next) S.a_ready(nxt);
            if constexpr (SP2) {
            PG8_LDB(B0, 0, 0); PG8_LDB(B1, 0, 1); PG8_SCHED; PG8_LDA(At, 0, 0); PG8_STAGE(PG8_SA(1, 1), a1 + hstepA, voffA);
            PG8_WAIT_V(8); PG8_WAIT_L(0); PG8_BAR; PG8_MMA(0, 0, At, B0); PG8_MMA(0, 1, At, B1); PG8_BAR; PG8_SCHED;
            PG8_LDA(At, 0, 1); PG8_STAGE(PG8_SB(0, 0), b2, voffB); PG8_STAGE(PG8_SB(0, 1), b2 + hstepB, voffB); PG8_STAGE(PG8_SA(0, 0), a2, voffA);
            PG8_WAIT_V(8); PG8_WAIT_L(0); PG8_BAR; PG8_MMA(1, 0, At, B0); PG8_MMA(1, 1, At, B1); PG8_BAR; PG8_SCHED;
            PG8_LDB(B0, 1, 0); PG8_LDB(B1, 1, 1); PG8_SCHED; PG8_LDA(At, 1, 0); PG8_STAGE(PG8_SA(0, 1), a2 + hstepA, voffA);
            PG8_WAIT_V(8); PG8_WAIT_L(0); PG8_BAR; PG8_MMA(0, 0, At, B0); PG8_MMA(0, 1, At, B1); PG8_BAR; PG8_SCHED;
            PG8_LDA(At, 1, 1); PG8_STAGE(PG8_SB(1, 0), b3, voffB); PG8_STAGE(PG8_SB(1, 1), b3 + hstepB, voffB); PG8_STAGE(PG8_SA(1, 0), a3, voffA);
            PG8_WAIT_V(8); PG8_WAIT_L(0); PG8_BAR; PG8_MMA(1, 0, At, B0); PG8_MMA(1, 1, At, B1); PG8_BAR; PG8_SCHED;
            } else {
            PG8_LDB(B0, 0, 0); PG8_SCHED; PG8_LDA(At, 0, 0); PG8_STAGE(PG8_SA(1, 1), a1 + hstepA, voffA);
            PG8_WAIT_L(8); PG8_BAR; PG8_WAIT_L(0); PG8_MMA(0, 0, At, B0); PG8_BAR; PG8_SCHED;
            PG8_LDB(B1, 0, 1); PG8_STAGE(PG8_SB(0, 0), b2, voffB);
            PG8_BAR; PG8_WAIT_L(0); PG8_MMA(0, 1, At, B1); PG8_BAR;
            PG8_LDA(At, 0, 1); PG8_STAGE(PG8_SA(0, 0), a2, voffA);
            PG8_BAR; PG8_WAIT_L(0); PG8_MMA(1, 0, At, B0); PG8_BAR; PG8_SCHED;
            PG8_STAGE(PG8_SB(0, 1), b2 + hstepB, voffB);
            PG8_WAIT_V(6); PG8_BAR; PG8_MMA(1, 1, At, B1); PG8_BAR;
            PG8_LDB(B0, 1, 0); PG8_SCHED; PG8_LDA(At, 1, 0); PG8_STAGE(PG8_SA(0, 1), a2 + hstepA, voffA);
            PG8_WAIT_L(8); PG8_BAR; PG8_WAIT_L(0); PG8_MMA(0, 0, At, B0); PG8_BAR; PG8_SCHED;
            PG8_LDB(B1, 1, 1); PG8_STAGE(PG8_SB(1, 0), b3, voffB);
            PG8_BAR; PG8_WAIT_L(0); PG8_MMA(0, 1, At, B1); PG8_BAR;
            PG8_LDA(At, 1, 1); PG8_STAGE(PG8_SA(1, 0), a3, voffA);
            PG8_BAR; PG8_WAIT_L(0); PG8_MMA(1, 0, At, B0); PG8_BAR; PG8_SCHED;
            PG8_STAGE(PG8_SB(1, 1), b3 + hstepB, voffB);
            PG8_WAIT_V(6); PG8_BAR; PG8_MMA(1, 1, At, B1); PG8_BAR;
            }
        }
        if constexpr (ALIGN_EPI) { if (wr == 0) PG8_BAR; }
        if constexpr (!Epi::AFTER_DRAIN) { E(acc, cur, wr, wc, fr, fq); S.done(cur); }
        if (!has_next) break;
#pragma unroll
        for (int a = 0; a < 2; ++a)
#pragma unroll
            for (int b = 0; b < 2; ++b)
#pragma unroll
                for (int m = 0; m < 4; ++m)
#pragma unroll
                    for (int n = 0; n < 2; ++n) acc[a][b][m][n] = (f32x4){0.f, 0.f, 0.f, 0.f};
        cur = nxt; cA = nA; cB = nB; ++ui;
        if constexpr (ALIGN_EPI) { if (wr == 1) PG8_BAR; }
    }
    PG8_WAIT_V(0);
    if constexpr (!ALIGN_EPI) { if (wr == 0) PG8_BAR; }
    PG8_BAR;
    if constexpr (Epi::AFTER_DRAIN) { E.fused(acc, cur, wr, wc, fr, fq, lds, wid, lane); S.done(cur); }
#undef PG8_SA
#undef PG8_SB
#undef PG8_STAGE
#undef PG8_LDA
#undef PG8_LDB
#undef PG8_MMA
#undef PG8_WAIT_V
#undef PG8_WAIT_L
#undef PG8_BAR
#undef PG8_SCHED
}
}

#define LAS __attribute__((address_space(3)))
typedef unsigned short bf16_t;
typedef short bf16x8 __attribute__((ext_vector_type(8)));
typedef float f32x4 __attribute__((ext_vector_type(4)));
typedef float f32x16 __attribute__((ext_vector_type(16)));
typedef unsigned u32x4 __attribute__((ext_vector_type(4)));
typedef unsigned u32x2 __attribute__((ext_vector_type(2)));
typedef float f32x2_t __attribute__((ext_vector_type(2)));
typedef __bf16 bf16x2_t __attribute__((ext_vector_type(2)));

constexpr int MTOK = 32768, DM = 1024, SEQ = 8192;
constexpr int NIN = 5912, NINP = 6144, DFF = 2816;
constexpr float L2E = 1.4426950408889634f;
constexpr size_t MiB = 1048576;
constexpr size_t WS_CTL = 0, WS_WIN = 1 * MiB, WS_WBR = 13 * MiB, WS_WOUT = 15 * MiB, WS_WGU = 17 * MiB, WS_WDN = 28 * MiB, WS_WC1 = 34 * MiB,
                 WS_SMALL = 36 * MiB, WS_CMPH = 37 * MiB, WS_KC = 45 * MiB, WS_VCT = 45 * MiB + 512 * 1024, WS_NSG = 46 * MiB,
                 WS_H = 49 * MiB  , WS_A = 113 * MiB  ,
                 WS_B = 305 * MiB  , WS_END = 481 * MiB;
constexpr size_t HB_SBQ = 0, HB_SBK = 16, HB_SBVT = 32, HB_MBQ = 48, HB_MBK = 64, HB_MBVT = 80, HB_NSQ = 96, HB_KCR = 128, HB_VCR = 136,
                 HB_KS = 144, HB_VST = 152, HB_KW = 160, HB_VWT = 168;
constexpr int LDS_BYTES = 147456;
constexpr int ATT_BT = 36864, ATT_MISC = 50688, ATT_SEL = 50944, ATT_X = 51968, ATT_OA = 93952;

struct Params { const float* in[16]; float* out; unsigned char* ws; };

__device__ __forceinline__ unsigned pk2(float lo, float hi) { f32x2_t v = {lo, hi}; bf16x2_t b = __builtin_convertvector(v, bf16x2_t); return __builtin_bit_cast(unsigned, b); }
__device__ __forceinline__ float bf2f(unsigned v16) { return __uint_as_float(v16 << 16); }
__device__ __forceinline__ float bflo(unsigned w) { return __uint_as_float(w << 16); }
__device__ __forceinline__ float bfhi(unsigned w) { return __uint_as_float(w & 0xffff0000u); }
__device__ __forceinline__ float wave_sum(float v) { v += __shfl_xor(v, 1); v += __shfl_xor(v, 2); v += __shfl_xor(v, 4); v += __shfl_xor(v, 8); v += __shfl_xor(v, 16); v += __shfl_xor(v, 32); return v; }
__device__ __forceinline__ float wave_max(float v) { v = fmaxf(v, __shfl_xor(v, 1)); v = fmaxf(v, __shfl_xor(v, 2)); v = fmaxf(v, __shfl_xor(v, 4)); v = fmaxf(v, __shfl_xor(v, 8)); v = fmaxf(v, __shfl_xor(v, 16)); v = fmaxf(v, __shfl_xor(v, 32)); return v; }
__device__ __forceinline__ float sigmoidf_(float x) { return __builtin_amdgcn_rcpf(1.0f + __expf(-x)); }
__device__ __forceinline__ float ex2(float x) { return __builtin_amdgcn_exp2f(x); }
__device__ __forceinline__ float lg2(float x) { return __builtin_amdgcn_logf(x); }

template <int MAP> __device__ __forceinline__ int mapcol(int p) {
    const int pn = p >> 8, q = p & 255, bj = q >> 7, wc = (q >> 5) & 3, n = (q >> 4) & 1, fq = (q >> 2) & 3, e = q & 3;
    const int lc = 64 * wc + 32 * bj + 8 * fq + 4 * n + e;
    if (MAP == 3) return p;
    if (MAP == 0) return 256 * pn + lc;
    if (MAP == 1) { if (pn <= 10) return 256 * pn + lc; if (pn == 11) return lc < 24 ? 2816 + lc : -1; return 2840 + 256 * (pn - 12) + lc; }
    const int j = 128 * pn + 32 * wc + 8 * fq + 4 * n + e; return bj ? DFF + j : j;
}

struct EpiRes {
    static constexpr bool PERM = false, AFTER_DRAIN = false;
    const float* res; float* out;
    __device__ __forceinline__ void operator()(const f32x4 (&acc)[2][2][4][2], const pg8::Unit& u, int wr, int wc, int fr_, int fq_) const {
        int fr = fr_, fq = fq_; asm volatile("" : "+v"(fr), "+v"(fq));
#pragma unroll
        for (int ai = 0; ai < 2; ++ai)
#pragma unroll
            for (int m = 0; m < 4; ++m) { const unsigned row = (unsigned)(u.pm * 256 + 128 * ai + 64 * wr + 16 * m + fr);
#pragma unroll
                for (int bj = 0; bj < 2; ++bj)
#pragma unroll
                    for (int n = 0; n < 2; ++n) { const unsigned o = row * 1024u + (unsigned)(u.pn * 256 + 64 * wc + 32 * bj + 8 * fq + 4 * n);
                        const f32x4 r = *(const f32x4*)(res + o); *(f32x4*)(out + o) = r + acc[ai][bj][m][n]; }
                __builtin_amdgcn_sched_barrier(0); }
    }
};
struct EpiSwiglu {
    static constexpr bool PERM = false, AFTER_DRAIN = false;
    bf16_t* act;
    __device__ __forceinline__ void operator()(const f32x4 (&acc)[2][2][4][2], const pg8::Unit& u, int wr, int wc, int fr_, int fq_) const {
        int fr = fr_, fq = fq_; asm volatile("" : "+v"(fr), "+v"(fq));
#pragma unroll
        for (int ai = 0; ai < 2; ++ai)
#pragma unroll
            for (int m = 0; m < 4; ++m) { const unsigned row = (unsigned)(u.pm * 256 + 128 * ai + 64 * wr + 16 * m + fr);
                float v[8];
#pragma unroll
                for (int n = 0; n < 2; ++n)
#pragma unroll
                    for (int e = 0; e < 4; ++e) { const float g = acc[ai][0][m][n][e], up = acc[ai][1][m][n][e]; v[4 * n + e] = g * sigmoidf_(g) * up; }
                u32x4 w; w.x = pk2(v[0], v[1]); w.y = pk2(v[2], v[3]); w.z = pk2(v[4], v[5]); w.w = pk2(v[6], v[7]);
                *(u32x4*)(act + (row * 2816u + (unsigned)(u.pn * 128 + 32 * wc + 8 * fq))) = w; }
    }
};
template <int MODE> struct EpiBranch {
    static constexpr bool PERM = false, AFTER_DRAIN = false;
    const bf16_t* brg; bf16_t* mix; int s;
    __device__ __forceinline__ void operator()(const f32x4 (&acc)[2][2][4][2], const pg8::Unit& u, int wr, int wc, int fr_, int fq_) const {
        int fr = fr_, fq = fq_; asm volatile("" : "+v"(fr), "+v"(fq));
#pragma unroll
        for (int ai = 0; ai < 2; ++ai)
#pragma unroll
            for (int m = 0; m < 4; ++m) { const unsigned row = (unsigned)(u.pm * 256 + 128 * ai + 64 * wr + 16 * m + fr);
#pragma unroll
                for (int bj = 0; bj < 2; ++bj)
#pragma unroll
                    for (int n = 0; n < 2; ++n) { const unsigned c = (unsigned)(u.pn * 256 + 64 * wc + 32 * bj + 8 * fq + 4 * n);
                        const u32x2 g = *(const u32x2*)(brg + (row * 3072u + 1024u * (unsigned)s + c));
                        u32x2 o = {0u, 0u}; if (MODE) o = *(const u32x2*)(mix + (row * 1024u + c));
                        const f32x4 a = acc[ai][bj][m][n];
                        u32x2 w;
                        w.x = pk2(bflo(o.x) + bflo(g.x) * a[0], bfhi(o.x) + bfhi(g.x) * a[1]);
                        w.y = pk2(bflo(o.y) + bflo(g.y) * a[2], bfhi(o.y) + bfhi(g.y) * a[3]);
                        *(u32x2*)(mix + (row * 1024u + c)) = w; }
                __builtin_amdgcn_sched_barrier(0); }
    }
};
struct EpiCmp1 {
    static constexpr bool PERM = false, AFTER_DRAIN = false;
    const float* bias; float* hid;
    __device__ __forceinline__ void operator()(const f32x4 (&acc)[2][2][4][2], const pg8::Unit& u, int wr, int wc, int fr_, int fq_) const {
        int fr = fr_, fq = fq_; asm volatile("" : "+v"(fr), "+v"(fq));
#pragma unroll
        for (int ai = 0; ai < 2; ++ai)
#pragma unroll
            for (int m = 0; m < 4; ++m) { const unsigned row = (unsigned)(u.pm * 256 + 128 * ai + 64 * wr + 16 * m + fr);
#pragma unroll
                for (int bj = 0; bj < 2; ++bj)
#pragma unroll
                    for (int n = 0; n < 2; ++n) { const int c = 64 * wc + 32 * bj + 8 * fq + 4 * n;
                        const f32x4 b = *(const f32x4*)(bias + c); f32x4 x = acc[ai][bj][m][n] + b, y;
#pragma unroll
                        for (int e = 0; e < 4; ++e) { const float t = x[e], z = 0.7978845608028654f * (t + 0.044715f * t * t * t);
                            const float th = 1.0f - 2.0f * __builtin_amdgcn_rcpf(1.0f + __expf(2.0f * z)); y[e] = 0.5f * t * (1.0f + th); }
                        *(f32x4*)(hid + (row * 256u + (unsigned)c)) = y; } }
    }
};
struct EpiStoreF32 {
    static constexpr bool PERM = false, AFTER_DRAIN = false;
    float* hid;
    __device__ __forceinline__ void operator()(const f32x4 (&acc)[2][2][4][2], const pg8::Unit& u, int wr, int wc, int fr_, int fq_) const {
        int fr = fr_, fq = fq_; asm volatile("" : "+v"(fr), "+v"(fq));
#pragma unroll
        for (int ai = 0; ai < 2; ++ai)
#pragma unroll
            for (int m = 0; m < 4; ++m) { const unsigned row = (unsigned)(u.pm * 256 + 128 * ai + 64 * wr + 16 * m + fr);
#pragma unroll
                for (int bj = 0; bj < 2; ++bj)
#pragma unroll
                    for (int n = 0; n < 2; ++n) *(f32x4*)(hid + (row * 256u + (unsigned)(64 * wc + 32 * bj + 8 * fq + 4 * n))) = acc[ai][bj][m][n]; }
    }
};
struct EpiInproj {
    static constexpr bool PERM = false, AFTER_DRAIN = false;
    unsigned char* wsb; const float* nwb;
    __device__ __forceinline__ void operator()(const f32x4 (&acc)[2][2][4][2], const pg8::Unit& u, int wr, int wc, int fr_, int fq_) const {
        int fr = fr_, fq = fq_; asm volatile("" : "+v"(fr), "+v"(fq));
        const int t = u.pn; unsigned char* hb = wsb + WS_B; float* nsg = (float*)(wsb + WS_NSG); bf16_t* brg = (bf16_t*)(wsb + WS_A);
        const float* mqn = nwb; const float* mkn = nwb + 64; const float* nqn = nwb + 128; const float* nkn = nwb + 192;
        if (t <= 10) {
            const int hd = 4 * t + wc;
            const int grp = hd < 24 ? (hd >> 2) : (hd < 32 ? 6 : 7 + ((hd - 32) >> 1));
            const int hh = hd < 24 ? (hd & 3) : (hd < 32 ? hd - 24 : (hd & 1));
            const int H = grp < 6 ? 4 : (grp == 6 ? 8 : 2);
            bf16_t* base = (bf16_t*)(hb + (grp <= 6 ? (size_t)16 * grp : (size_t)(128 + 8 * (grp - 7))) * MiB);
            const bool trans = (grp == 2) | (grp == 5) | (grp == 10) | (grp == 12);
            const bool norm = (grp == 3) | (grp == 4) | (grp == 6) | (grp == 9) | (grp == 11);
            const float qs = ((grp == 0) | (grp == 3) | (grp == 6)) ? 0.125f * L2E : 1.0f;
            const float* nw = grp == 3 ? mqn : (grp == 4 ? mkn : (grp == 6 ? nqn : (grp == 9 ? nkn + 64 : nkn + 128)));
#pragma unroll
            for (int ai = 0; ai < 2; ++ai)
#pragma unroll
                for (int m = 0; m < 4; ++m) { const int row = u.pm * 256 + 128 * ai + 64 * wr + 16 * m + fr; const int b = row >> 13, s = row & 8191;
                    float v[2][8];
#pragma unroll
                    for (int bj = 0; bj < 2; ++bj)
#pragma unroll
                        for (int n = 0; n < 2; ++n)
#pragma unroll
                            for (int e = 0; e < 4; ++e) v[bj][4 * n + e] = acc[ai][bj][m][n][e];
                    float sc = qs;
                    if (norm) { float ss = 0.f;
#pragma unroll
                        for (int bj = 0; bj < 2; ++bj)
#pragma unroll
                            for (int j = 0; j < 8; ++j) ss += v[bj][j] * v[bj][j];
                        ss += __shfl_xor(ss, 16); ss += __shfl_xor(ss, 32);
                        sc = qs * __builtin_amdgcn_rsqf(ss * (1.0f / 64.0f) + 1e-6f);
#pragma unroll
                        for (int bj = 0; bj < 2; ++bj) { const f32x4 w0 = *(const f32x4*)(nw + 32 * bj + 8 * fq), w1 = *(const f32x4*)(nw + 32 * bj + 8 * fq + 4);
#pragma unroll
                            for (int e = 0; e < 4; ++e) { v[bj][e] *= w0[e]; v[bj][4 + e] *= w1[e]; } } }
                    if (!trans) {
#pragma unroll
                        for (int bj = 0; bj < 2; ++bj) { u32x4 w; w.x = pk2(v[bj][0] * sc, v[bj][1] * sc); w.y = pk2(v[bj][2] * sc, v[bj][3] * sc); w.z = pk2(v[bj][4] * sc, v[bj][5] * sc); w.w = pk2(v[bj][6] * sc, v[bj][7] * sc);
                            *(u32x4*)(base + (unsigned)(((b * H + hh) * SEQ + s) * 64 + 32 * bj + 8 * fq)) = w; }
                    } else {
#pragma unroll
                        for (int bj = 0; bj < 2; ++bj)
#pragma unroll
                            for (int j = 0; j < 8; j += 2) { const unsigned w = pk2(v[bj][j], v[bj][j + 1]); bf16_t* d = base + (unsigned)(((b * H + hh) * 64 + 32 * bj + 8 * fq + j) * SEQ + s);
                                d[0] = (bf16_t)(w & 0xffffu); d[SEQ] = (bf16_t)(w >> 16); }
                    } }
        } else if (t == 11) {
            if (wc == 0 && fq < 3) {
#pragma unroll
                for (int ai = 0; ai < 2; ++ai)
#pragma unroll
                    for (int m = 0; m < 4; ++m) { const unsigned row = (unsigned)(u.pm * 256 + 128 * ai + 64 * wr + 16 * m + fr);
#pragma unroll
                        for (int n = 0; n < 2; ++n) { f32x4 y;
#pragma unroll
                            for (int e = 0; e < 4; ++e) y[e] = sigmoidf_(acc[ai][0][m][n][e]);
                            *(f32x4*)(nsg + (row * 24u + (unsigned)(8 * fq + 4 * n))) = y; } }
            }
        } else {
#pragma unroll
            for (int ai = 0; ai < 2; ++ai)
#pragma unroll
                for (int m = 0; m < 4; ++m) { const unsigned row = (unsigned)(u.pm * 256 + 128 * ai + 64 * wr + 16 * m + fr);
#pragma unroll
                    for (int bj = 0; bj < 2; ++bj) { const f32x4 a0 = acc[ai][bj][m][0], a1 = acc[ai][bj][m][1]; u32x4 w;
                        w.x = pk2(sigmoidf_(a0[0]), sigmoidf_(a0[1])); w.y = pk2(sigmoidf_(a0[2]), sigmoidf_(a0[3]));
                        w.z = pk2(sigmoidf_(a1[0]), sigmoidf_(a1[1])); w.w = pk2(sigmoidf_(a1[2]), sigmoidf_(a1[3]));
                        *(u32x4*)(brg + (row * 3072u + (unsigned)((t - 12) * 256 + 64 * wc + 32 * bj + 8 * fq))) = w; } }
        }
    }
};

template <int MAP> __device__ __forceinline__ void prep_w(const float* __restrict__ W, int K, int ldw, bf16_t* __restrict__ Bt, int Np, int ldb, LAS unsigned char* lds, int tid, int bx, int G) {
    const int ntp = Np >> 6, ntiles = ntp * (K >> 6), w = tid >> 6, lane = tid & 63;
    float v[8];
    int tile = bx;
    if (tile < ntiles) { const int tk = tile / ntp, tp = tile - tk * ntp; const int col = mapcol<MAP>(tp * 64 + lane); const float* s = W + (size_t)(tk * 64 + 8 * w) * ldw + (col < 0 ? 0 : col);
#pragma unroll
        for (int i = 0; i < 8; ++i) v[i] = col >= 0 ? s[(size_t)i * ldw] : 0.f; }
    for (; tile < ntiles; tile += G) {
        const int tk = tile / ntp, tp = tile - tk * ntp;
        u32x4 pw; pw.x = pk2(v[0], v[1]); pw.y = pk2(v[2], v[3]); pw.z = pk2(v[4], v[5]); pw.w = pk2(v[6], v[7]);
        *(LAS u32x4*)(lds + lane * 144 + w * 16) = pw;
        __syncthreads();
        const int nx = tile + G;
        if (nx < ntiles) { const int tk2 = nx / ntp, tp2 = nx - tk2 * ntp; const int col = mapcol<MAP>(tp2 * 64 + lane); const float* s = W + (size_t)(tk2 * 64 + 8 * w) * ldw + (col < 0 ? 0 : col);
#pragma unroll
            for (int i = 0; i < 8; ++i) v[i] = col >= 0 ? s[(size_t)i * ldw] : 0.f; }
        { const int p = tid >> 3, pc = tid & 7; const u32x4 o = *(LAS const u32x4*)(lds + p * 144 + pc * 16);
            *(u32x4*)(Bt + (size_t)(tp * 64 + p) * ldb + tk * 64 + pc * 8) = o; }
        __syncthreads();
    }
}
__device__ __forceinline__ void rmsnorm_rows(const float* __restrict__ x, const float* __restrict__ g, bf16_t* __restrict__ h, int gwave, int nwaves, int lane) {
    for (int row = gwave; row < MTOK; row += nwaves) {
        const f32x4* xr = (const f32x4*)(x + (size_t)row * DM); f32x4 v[4]; float ss = 0.f;
#pragma unroll
        for (int i = 0; i < 4; ++i) { v[i] = xr[lane + 64 * i]; ss += v[i][0] * v[i][0] + v[i][1] * v[i][1] + v[i][2] * v[i][2] + v[i][3] * v[i][3]; }
        ss = wave_sum(ss); const float rs = __builtin_amdgcn_rsqf(ss * (1.0f / DM) + 1e-6f);
#pragma unroll
        for (int i = 0; i < 4; ++i) { const f32x4 gv = ((const f32x4*)g)[lane + 64 * i]; u32x2 w; w.x = pk2(v[i][0] * rs * gv[0], v[i][1] * rs * gv[1]); w.y = pk2(v[i][2] * rs * gv[2], v[i][3] * rs * gv[3]);
            *(u32x2*)(h + (size_t)row * DM + (lane + 64 * i) * 4) = w; }
    }
}

#define MFMA32(a, b, c) __builtin_amdgcn_mfma_f32_32x32x16_bf16((a), (b), (c), 0, 0, 0)
__device__ __forceinline__ void stage_ld(const bf16_t* K, const bf16_t* Vt, int ldvt, int key0, int tid, u32x4& rk, u32x4& rv) {
    const int row = tid >> 3, pc = tid & 7;
    rk = *(const u32x4*)(K + (size_t)(key0 + row) * 64 + pc * 8);
    rv = *(const u32x4*)(Vt + (size_t)row * ldvt + key0 + pc * 8);
}
__device__ __forceinline__ void stage_st(LAS unsigned char* lds, int buf, int tid, const u32x4& rk, const u32x4& rv) {
    const int row = tid >> 3, pc = tid & 7; LAS unsigned char* p = lds + buf * 18432 + row * 144 + pc * 16;
    *(LAS u32x4*)p = rk; *(LAS u32x4*)(p + 9216) = rv;
}
__device__ __forceinline__ void load_q(const bf16_t* qrow, int h, bf16x8 (&qf)[4]) {
#pragma unroll
    for (int kk = 0; kk < 4; ++kk) qf[kk] = *(const bf16x8*)(qrow + 16 * kk + 8 * h);
}
__device__ __forceinline__ f32x16 qk_sub(LAS const unsigned char* ks, int sub, const bf16x8 (&qf)[4], int r, int h, float init = 0.f) {
    const int pr = (r & 0x13) | ((r & 4) << 1) | ((r & 8) >> 1);
    LAS const unsigned char* p = ks + (32 * sub + pr) * 144 + h * 16;
    f32x16 st;
#pragma unroll
    for (int i = 0; i < 16; ++i) st[i] = init;
#pragma unroll
    for (int kk = 0; kk < 4; ++kk) { const bf16x8 kf = *(LAS const bf16x8*)(p + kk * 32); st = MFMA32(kf, qf[kk], st); }
    return st;
}
__device__ __forceinline__ void pv_sub(LAS const unsigned char* vs, int sub, const f32x16& p, f32x16 (&ot)[2], int r, int h) {
#pragma unroll
    for (int j = 0; j < 2; ++j) {
        u32x4 w; w.x = pk2(p[8 * j], p[8 * j + 1]); w.y = pk2(p[8 * j + 2], p[8 * j + 3]); w.z = pk2(p[8 * j + 4], p[8 * j + 5]); w.w = pk2(p[8 * j + 6], p[8 * j + 7]);
        const bf16x8 pf = __builtin_bit_cast(bf16x8, w);
#pragma unroll
        for (int mt = 0; mt < 2; ++mt) { const bf16x8 vf = *(LAS const bf16x8*)(vs + (32 * mt + r) * 144 + (32 * sub + 16 * j + 8 * h) * 2); ot[mt] = MFMA32(vf, pf, ot[mt]); }
    }
}
constexpr int BT_N = 288, BT_FAR = 64 + 223;
template <int MODE> __device__ __forceinline__ void soft_sub(f32x16& st, float& lsum, bool lane_valid, int dist0, int dmax, LAS const float* bt) {
    if (MODE == 0) {
#pragma unroll
        for (int i = 0; i < 16; ++i) { const float p = ex2(st[i]); lsum += p; st[i] = p; }
    } else if (MODE == 2) {
        const float cf = lane_valid ? bt[BT_FAR] : -3.0e38f;
#pragma unroll
        for (int i = 0; i < 16; ++i) { const int dist = dist0 - (16 * (i >> 3) + (i & 7)); const float b = dist < dmax ? cf : -3.0e38f;
            const float p = ex2(st[i] + b); lsum += p; st[i] = p; }
    } else if (MODE == 1) {
        float bb[16];
#pragma unroll
        for (int j = 0; j < 2; ++j) { int db = dist0 - 16 * j; db = db < -57 ? -57 : (db > 223 ? 223 : db); if (!lane_valid) db = -57;
            LAS const float* p = bt + (db + 64);
#pragma unroll
            for (int k = 0; k < 8; ++k) bb[8 * j + k] = p[-k]; }
#pragma unroll
        for (int i = 0; i < 16; ++i) { const float p = ex2(st[i] + bb[i]); lsum += p; st[i] = p; }
    } else {
        float bb[16];
#pragma unroll
        for (int i = 0; i < 16; ++i) { int d = dist0 - 16 * (16 * (i >> 3) + (i & 7)); d = d < -64 ? -64 : (d > 223 ? 223 : d); bb[i] = bt[d + 64]; }
#pragma unroll
        for (int i = 0; i < 16; ++i) { const float p = ex2(st[i] + bb[i]); lsum += p; st[i] = p; }
    }
}
template <int MODE> __device__ __forceinline__ void tile_soft(LAS const unsigned char* ks, LAS const unsigned char* vs, const bf16x8 (&qf)[4], f32x16 (&ot)[2], float& lsum,
                                                              bool lane_valid, int dist00, int dmax, LAS const float* bt, int r, int h) {
    const float init = MODE == 0 ? (lane_valid ? bt[BT_FAR] : -3.0e38f) : 0.f;
    f32x16 s0 = qk_sub(ks, 0, qf, r, h, init); f32x16 s1 = qk_sub(ks, 1, qf, r, h, init);
    soft_sub<MODE>(s0, lsum, lane_valid, dist00, dmax, bt); pv_sub(vs, 0, s0, ot, r, h);
    soft_sub<MODE>(s1, lsum, lane_valid, dist00 - (MODE == 3 ? 512 : 32), dmax, bt); pv_sub(vs, 1, s1, ot, r, h);
}
__device__ __forceinline__ void zero_ot(f32x16 (&ot)[2]) {
#pragma unroll
    for (int i = 0; i < 16; ++i) { ot[0][i] = 0.f; ot[1][i] = 0.f; }
}
__device__ __forceinline__ void store_ot(bf16_t* orow, const f32x16 (&ot)[2], int h) {
#pragma unroll
    for (int mt = 0; mt < 2; ++mt)
#pragma unroll
        for (int g = 0; g < 4; ++g) { u32x2 w; w.x = pk2(ot[mt][4 * g], ot[mt][4 * g + 1]); w.y = pk2(ot[mt][4 * g + 2], ot[mt][4 * g + 3]);
            *(u32x2*)(orow + 32 * mt + 8 * g + 4 * h) = w; }
}

#define TILE_LOOP(KP, VP, LDV, KEY_FIRST, NT, BODY) do { \
    int key0 = (KEY_FIRST); const int nt_ = (NT); u32x4 rkA_, rvA_, rkB_, rvB_; \
    __syncthreads(); \
    stage_ld((KP), (VP), (LDV), key0, tid, rkA_, rvA_); stage_st(lds, 0, tid, rkA_, rvA_); \
    if (nt_ > 1) stage_ld((KP), (VP), (LDV), key0 + 64, tid, rkA_, rvA_); \
    __syncthreads(); \
    for (int it_ = 0; it_ < nt_; ++it_) { const int buf_ = it_ & 1; \
        if (it_ + 2 < nt_) stage_ld((KP), (VP), (LDV), key0 + 128, tid, rkB_, rvB_); \
        { LAS const unsigned char* ks = lds + buf_ * 18432; LAS const unsigned char* vs = ks + 9216; BODY } \
        if (it_ + 1 < nt_) stage_st(lds, buf_ ^ 1, tid, rkA_, rvA_); \
        __syncthreads(); key0 += 64; rkA_ = rkB_; rvA_ = rvB_; } } while (0)

__device__ __forceinline__ void sb_sub(LAS const unsigned char* vs, int sb, f32x16& st, f32x16 (&ot)[2], float& C, int key0, int t, int r, int h) {
    float ls[16]; float Rlo = 0.f, Rhi = 0.f;
#pragma unroll
    for (int i = 0; i < 16; ++i) { const int s = key0 + 32 * sb + 16 * (i >> 3) + 8 * h + (i & 7); const bool causal = s < t;
        const float u = st[i]; const float sp = fmaxf(u, 0.f) + lg2(1.0f + ex2(-fabsf(u)));
        ls[i] = causal ? -sp : 0.f; st[i] = causal ? (u - sp) : -3.0e38f;
        if (i < 8) Rlo += ls[i]; else Rhi += ls[i]; }
    const float Plo = __shfl_xor(Rlo, 32), Phi = __shfl_xor(Rhi, 32);
    float la = C + (h == 0 ? Phi : 0.f);
#pragma unroll
    for (int i = 15; i >= 8; --i) { const float a = ex2(st[i] + la); la += ls[i]; st[i] = a; }
    la = C + Rhi + Phi + (h == 0 ? Plo : 0.f);
#pragma unroll
    for (int i = 7; i >= 0; --i) { const float a = ex2(st[i] + la); la += ls[i]; st[i] = a; }
    C += (Rlo + Rhi) + (Plo + Phi);
    pv_sub(vs, sb, st, ot, r, h);
}
__device__ __forceinline__ void sb_unit(LAS unsigned char* lds, const unsigned char* hb, bf16_t* omix, int b, int hd, int qblk, int tid) {
    const int lane = tid & 63, w = tid >> 6, r = lane & 31, h = lane >> 5;
    const int bh = b * 4 + hd, q0 = qblk * 256, t = q0 + 32 * w + r;
    const bf16_t* Q = (const bf16_t*)(hb + HB_SBQ * MiB) + ((size_t)bh * SEQ + t) * 64;
    const bf16_t* K = (const bf16_t*)(hb + HB_SBK * MiB) + (size_t)bh * SEQ * 64;
    const bf16_t* Vt = (const bf16_t*)(hb + HB_SBVT * MiB) + (size_t)bh * 64 * SEQ;
    bf16x8 qf[4]; load_q(Q, h, qf);
    f32x16 ot[2]; zero_ot(ot);
    float C = 0.f;
    int key0 = q0 + 192; u32x4 rkA_, rvA_, rkB_, rvB_;
    __syncthreads();
    stage_ld(K, Vt, SEQ, key0, tid, rkA_, rvA_); stage_st(lds, 0, tid, rkA_, rvA_);
    if (key0 >= 64) stage_ld(K, Vt, SEQ, key0 - 64, tid, rkA_, rvA_);
    __syncthreads();
    int buf = 0;
    for (;;) {
        const bool has_next = key0 >= 64;
        if (key0 >= 128) stage_ld(K, Vt, SEQ, key0 - 128, tid, rkB_, rvB_);
        if (key0 <= q0 + 32 * w + 31) {
            LAS const unsigned char* ks = lds + buf * 18432; LAS const unsigned char* vs = ks + 9216;
            f32x16 s1 = qk_sub(ks, 1, qf, r, h); f32x16 s0 = qk_sub(ks, 0, qf, r, h);
            if (key0 + 32 <= q0 + 32 * w + 31) sb_sub(vs, 1, s1, ot, C, key0, t, r, h);
            sb_sub(vs, 0, s0, ot, C, key0, t, r, h);
        }
        const int alive = __syncthreads_or(C > -150.0f ? 1 : 0);
        if (!(has_next && alive)) break;
        stage_st(lds, buf ^ 1, tid, rkA_, rvA_);
        __syncthreads(); buf ^= 1; key0 -= 64; rkA_ = rkB_; rvA_ = rvB_;
    }
    store_ot(omix + ((size_t)b * SEQ + t) * DM + hd * 64, ot, h);
}

__device__ __forceinline__ void moba_unit(LAS unsigned char* lds, const unsigned char* hb, const float* kmean, bf16_t* omix, int b, int hd, int blk, int tid) {
    const int lane = tid & 63, w = tid >> 6, r = lane & 31, h = lane >> 5;
    const int bh = b * 4 + hd, q0 = blk * 256, t = q0 + 32 * w + r;
    const bf16_t* Qb = (const bf16_t*)(hb + HB_MBQ * MiB) + ((size_t)bh * SEQ + q0) * 64;
    const bf16_t* K = (const bf16_t*)(hb + HB_MBK * MiB) + (size_t)bh * SEQ * 64;
    const bf16_t* Vt = (const bf16_t*)(hb + HB_MBVT * MiB) + (size_t)bh * 64 * SEQ;
    LAS unsigned* misc = (LAS unsigned*)(lds + ATT_MISC); LAS unsigned* selm = (LAS unsigned*)(lds + ATT_SEL);
    LAS float* km = (LAS float*)(lds + ATT_X); LAS float* sc = km + 32 * 64;
    LAS const float* bt = (LAS const float*)(lds + ATT_BT) + hd * BT_N;
    __syncthreads();
    if (tid == 0) misc[1] = 0u;
    if (blk > 3) {
        for (int i = tid; i < blk * 64; i += 512) km[i] = kmean[(size_t)bh * 32 * 64 + i];
        __syncthreads();
        { const int qi = tid & 255, part = tid >> 8; float q[64];
            const u32x4* qp = (const u32x4*)(Qb + (size_t)qi * 64);
#pragma unroll
            for (int c = 0; c < 8; ++c) { const u32x4 v = qp[c]; q[8 * c] = bflo(v.x); q[8 * c + 1] = bfhi(v.x); q[8 * c + 2] = bflo(v.y); q[8 * c + 3] = bfhi(v.y); q[8 * c + 4] = bflo(v.z); q[8 * c + 5] = bfhi(v.z); q[8 * c + 6] = bflo(v.w); q[8 * c + 7] = bfhi(v.w); }
            for (int n = part; n < blk; n += 2) { float a = 0.f;
#pragma unroll
                for (int d = 0; d < 64; ++d) a = fmaf(q[d], km[n * 64 + d], a);
                sc[qi * 33 + n] = a; } }
        __syncthreads();
        if (tid < 256) { unsigned m = 0u; float sv[32];
#pragma unroll
            for (int n = 0; n < 32; ++n) sv[n] = n < blk ? sc[tid * 33 + n] : -3.0e38f;
#pragma unroll
            for (int k = 0; k < 3; ++k) { float best = -3.0e38f; int bi = 0;
#pragma unroll
                for (int n = 0; n < 32; ++n) { const bool take = !((m >> n) & 1u) && sv[n] > best; best = take ? sv[n] : best; bi = take ? n : bi; }
                m |= 1u << bi; }
            selm[tid] = m; atomicOr((unsigned*)&misc[1], m); }
    } else {
        const unsigned m = (1u << blk) - 1u; if (tid < 256) selm[tid] = m; if (tid == 0) misc[1] = m;
    }
    __syncthreads();
    const unsigned uni = misc[1], sel = selm[32 * w + r];
    bf16x8 qf[4]; load_q(Qb + (size_t)(32 * w + r) * 64, h, qf);
    f32x16 ot[2]; zero_ot(ot); float lsum = 0.f;
    const int kend = q0 + 256;
#define MOBA_NEXT(k_, out_) do { int kk_ = (k_) + 64; while (kk_ < q0 && !((uni >> (kk_ >> 8)) & 1u)) kk_ = (kk_ | 255) + 1; (out_) = kk_; } while (0)
    int key0, knext, knext2; MOBA_NEXT(-64, key0); MOBA_NEXT(key0, knext);
    u32x4 rkA_, rvA_, rkB_, rvB_;
    stage_ld(K, Vt, SEQ, key0, tid, rkA_, rvA_); stage_st(lds, 0, tid, rkA_, rvA_);
    if (knext < kend) stage_ld(K, Vt, SEQ, knext, tid, rkA_, rvA_);
    __syncthreads();
    int buf = 0;
    while (key0 < kend) {
        MOBA_NEXT(knext, knext2);
        if (knext < kend && knext2 < kend) stage_ld(K, Vt, SEQ, knext2, tid, rkB_, rvB_);
        {
            LAS const unsigned char* ks = lds + buf * 18432; LAS const unsigned char* vs = ks + 9216;
            const int n = key0 >> 8; const bool own = (n == blk);
            const bool lane_valid = own ? true : (((sel >> n) & 1u) != 0u);
            const bool skip = own ? (key0 > q0 + 32 * w + 31) : (__ballot(lane_valid) == 0ull);
            if (!skip) {
                const bool near = (q0 + 32 * w) - (key0 + 63) < 128;
                const int dist00 = t - (key0 + 8 * h);
                if (near) tile_soft<1>(ks, vs, qf, ot, lsum, lane_valid, dist00, 0, bt, r, h);
                else tile_soft<0>(ks, vs, qf, ot, lsum, lane_valid, dist00, 0, bt, r, h);
            }
        }
        if (knext < kend) stage_st(lds, buf ^ 1, tid, rkA_, rvA_);
        __syncthreads(); buf ^= 1; key0 = knext; knext = knext2; rkA_ = rkB_; rvA_ = rvB_;
    }
#undef MOBA_NEXT
    const float l = lsum + __shfl_xor(lsum, 32); const float inv = 1.0f / fmaxf(l, 1e-30f);
#pragma unroll
    for (int i = 0; i < 16; ++i) { ot[0][i] *= inv; ot[1][i] *= inv; }
    store_ot(omix + ((size_t)b * SEQ + t) * DM + 256 + hd * 64, ot, h);
}

__device__ __forceinline__ void imp_sub(f32x16& st, float invc, int nbase, LAS float* improw, int r) {
#pragma unroll
    for (int j = 0; j < 2; ++j) { const int a = (nbase + 16 * j) >> 3;
        float s0 = ((st[8 * j] + st[8 * j + 1]) + (st[8 * j + 2] + st[8 * j + 3])) * invc;
        float s1 = ((st[8 * j + 3] + st[8 * j + 4]) + (st[8 * j + 5] + st[8 * j + 6]) + st[8 * j + 7]) * invc;
        float s2 = st[8 * j + 7] * invc;
        s0 += __shfl_xor(s0, 8); s0 += __shfl_xor(s0, 16); s1 += __shfl_xor(s1, 8); s1 += __shfl_xor(s1, 16); s2 += __shfl_xor(s2, 8); s2 += __shfl_xor(s2, 16);
        if (r < 8) { LAS float* ip = improw + 2 * a; ip[0] += s0; ip[1] += s1; if (2 * a + 2 < 128) ip[2] += s2; } }
}
__device__ __forceinline__ void nsa_unit(LAS unsigned char* lds, const unsigned char* hb, const bf16_t* kc, const bf16_t* vct, const float* nsg, bf16_t* omix, int b, int g, int c, int tid) {
    const int lane = tid & 63, w = tid >> 6, r = lane & 31, h = lane >> 5;
    const int bg = b * 2 + g, q0 = c * 64, ql = 8 * w + (r & 7), t = q0 + ql, hq = 4 * g + (r >> 3);
    const bf16_t* Q = (const bf16_t*)(hb + HB_NSQ * MiB) + ((size_t)(b * 8 + hq) * SEQ + t) * 64;
    LAS unsigned* selm = (LAS unsigned*)(lds + ATT_SEL); LAS float* imp = (LAS float*)(lds + ATT_X);
    LAS const float* bt = (LAS const float*)(lds + ATT_BT) + (4 + hq) * BT_N;
    const float* gate = nsg + ((size_t)b * SEQ + t) * 24 + hq;
    bf16x8 qf[4]; load_q(Q, h, qf);
    f32x16 ot[2]; zero_ot(ot);
    LAS unsigned* oal = (LAS unsigned*)(lds + ATT_OA) + (w * 16) * 64 + lane;
    const bf16_t* Kc = kc + (size_t)bg * 512 * 64; const bf16_t* Vc = vct + (size_t)bg * 64 * 512;
    const int ntc = (4 * c + 3 + 63) >> 6;
    float lsum = 0.f;
    TILE_LOOP(Kc, Vc, 512, 0, ntc, {
        tile_soft<3>(ks, vs, qf, ot, lsum, true, t - 31 - 16 * (key0 + 8 * h), 0, bt, r, h); });
    const float lc = lsum + __shfl_xor(lsum, 32); const float invc = 1.0f / fmaxf(lc, 1e-30f);
    { const float gc = gate[0] * invc;
#pragma unroll
        for (int i = 0; i < 8; ++i) { oal[i * 64] = pk2(ot[0][2 * i] * gc, ot[0][2 * i + 1] * gc); oal[(8 + i) * 64] = pk2(ot[1][2 * i] * gc, ot[1][2 * i + 1] * gc); } }
    for (int i = tid; i < 64 * 129; i += 512) imp[i] = 0.f;
    if (tid < 256) selm[tid] = 0u;
    TILE_LOOP(Kc, Vc, 512, 0, ntc, {
        f32x16 s0 = qk_sub(ks, 0, qf, r, h); f32x16 s1 = qk_sub(ks, 1, qf, r, h); float dummy = 0.f;
        const int dist00 = t - 31 - 16 * (key0 + 8 * h);
        soft_sub<3>(s0, dummy, true, dist00, 0, bt); imp_sub(s0, invc, key0 + 8 * h, imp + ql * 129, r);
        soft_sub<3>(s1, dummy, true, dist00 - 512, 0, bt); imp_sub(s1, invc, key0 + 32 + 8 * h, imp + ql * 129, r); });
    { const int qi = tid >> 3, sub = tid & 7;
        if (c >= 16) {
            { LAS const float* row = imp + qi * 129; unsigned long long kv[16]; int cnt[16];
#pragma unroll
                for (int k = 0; k < 16; ++k) { const int m = 1 + sub + 8 * k; const int mi = m <= 128 ? m : 128; kv[k] = ((unsigned long long)__float_as_uint(row[mi]) << 8) | (unsigned long long)(255 - m); cnt[k] = 0; }
                for (int m2 = 1; m2 <= c - 2; m2 += 8) { unsigned long long kx[8];
#pragma unroll
                    for (int j = 0; j < 8; ++j) { const int mm = m2 + j; const int mi = mm <= 128 ? mm : 128; const float x = row[mi]; kx[j] = mm <= c - 2 ? (((unsigned long long)__float_as_uint(x) << 8) | (unsigned long long)(255 - mm)) : 0ull; }
#pragma unroll
                    for (int j = 0; j < 8; ++j)
#pragma unroll
                        for (int k = 0; k < 16; ++k) cnt[k] += kx[j] > kv[k] ? 1 : 0; }
#pragma unroll
                for (int k = 0; k < 16; ++k) { const int m = 1 + sub + 8 * k; if (m <= c - 2 && cnt[k] < 13) atomicOr((unsigned*)&selm[qi * 4 + (m >> 5)], 1u << (m & 31)); } }
            if (sub == 0) { atomicOr((unsigned*)&selm[qi * 4], 1u); atomicOr((unsigned*)&selm[qi * 4 + ((c - 1) >> 5)], 1u << ((c - 1) & 31)); atomicOr((unsigned*)&selm[qi * 4 + (c >> 5)], 1u << (c & 31)); }
        } else if (sub == 0) selm[qi * 4] = (1u << (c + 1)) - 1u;
    }
    __syncthreads();
    const unsigned sel0 = selm[ql * 4], sel1 = selm[ql * 4 + 1], sel2 = selm[ql * 4 + 2], sel3 = selm[ql * 4 + 3];
    { const bf16_t* Ks = (const bf16_t*)(hb + HB_KS * MiB) + (size_t)bg * SEQ * 64; const bf16_t* Vs = (const bf16_t*)(hb + HB_VST * MiB) + (size_t)bg * 64 * SEQ;
        zero_ot(ot); lsum = 0.f;
        TILE_LOOP(Ks, Vs, SEQ, 0, c + 1, {
            const int m = key0 >> 6; const unsigned sw = m < 32 ? sel0 : (m < 64 ? sel1 : (m < 96 ? sel2 : sel3));
            const bool lane_valid = ((sw >> (m & 31)) & 1u) != 0u;
            if (__ballot(lane_valid) != 0ull) { const int dist00 = t - (key0 + 8 * h);
                if ((c - m) < 3) tile_soft<1>(ks, vs, qf, ot, lsum, lane_valid, dist00, 0, bt, r, h);
                else tile_soft<0>(ks, vs, qf, ot, lsum, lane_valid, dist00, 0, bt, r, h); } });
        const float l = lsum + __shfl_xor(lsum, 32); const float gs = gate[8] / fmaxf(l, 1e-30f);
#pragma unroll
        for (int i = 0; i < 8; ++i) { const unsigned a0 = oal[i * 64], a1 = oal[(8 + i) * 64];
            oal[i * 64] = pk2(bflo(a0) + ot[0][2 * i] * gs, bfhi(a0) + ot[0][2 * i + 1] * gs); oal[(8 + i) * 64] = pk2(bflo(a1) + ot[1][2 * i] * gs, bfhi(a1) + ot[1][2 * i + 1] * gs); } }
    { const bf16_t* Kw = (const bf16_t*)(hb + HB_KW * MiB) + (size_t)bg * SEQ * 64; const bf16_t* Vw = (const bf16_t*)(hb + HB_VWT * MiB) + (size_t)bg * 64 * SEQ;
        zero_ot(ot); lsum = 0.f;
        const int kfirst = q0 >= 512 ? q0 - 512 : 0; const int ntw = ((q0 - kfirst) >> 6) + 1;
        TILE_LOOP(Kw, Vw, SEQ, kfirst, ntw, {
            const int dist00 = t - (key0 + 8 * h);
            if (key0 >= q0 - 128) tile_soft<1>(ks, vs, qf, ot, lsum, true, dist00, 0, bt, r, h);
            else if (key0 == q0 - 512) tile_soft<2>(ks, vs, qf, ot, lsum, true, dist00, 512, bt, r, h);
            else tile_soft<0>(ks, vs, qf, ot, lsum, true, dist00, 0, bt, r, h); });
        const float l = lsum + __shfl_xor(lsum, 32); const float gw = gate[16] / fmaxf(l, 1e-30f);
#pragma unroll
        for (int i = 0; i < 8; ++i) { const unsigned a0 = oal[i * 64], a1 = oal[(8 + i) * 64];
            ot[0][2 * i] = bflo(a0) + ot[0][2 * i] * gw; ot[0][2 * i + 1] = bfhi(a0) + ot[0][2 * i + 1] * gw; ot[1][2 * i] = bflo(a1) + ot[1][2 * i] * gw; ot[1][2 * i + 1] = bfhi(a1) + ot[1][2 * i + 1] * gw; } }
    store_ot(omix + ((size_t)b * SEQ + t) * DM + 512 + hq * 64, ot, h);
}

constexpr int FG_STAGE = 55296, FG_B = 36864, FG_PATCH = 110592;
__device__ __forceinline__ void fg_ld(const bf16_t* A, const bf16_t* Bt, int kt, int tid, u32x4 (&ra)[4], u32x4 (&rb)[2]) {
#pragma unroll
    for (int i = 0; i < 4; ++i) { const unsigned p = (unsigned)(tid + 512 * i); ra[i] = *(const u32x4*)(A + 64 * kt + ((p >> 3) * 1024u + 8u * (p & 7u))); }
#pragma unroll
    for (int i = 0; i < 2; ++i) { const unsigned p = (unsigned)(tid + 512 * i); rb[i] = *(const u32x4*)(Bt + 64 * kt + ((p >> 3) * 1024u + 8u * (p & 7u))); }
}
__device__ __forceinline__ void fg_st(LAS unsigned char* st, int tid, const u32x4 (&ra)[4], const u32x4 (&rb)[2]) {
#pragma unroll
    for (int i = 0; i < 4; ++i) { const int p = tid + 512 * i; *(LAS u32x4*)(st + (p >> 3) * 144 + (p & 7) * 16) = ra[i]; }
#pragma unroll
    for (int i = 0; i < 2; ++i) { const int p = tid + 512 * i; *(LAS u32x4*)(st + FG_B + (p >> 3) * 144 + (p & 7) * 16) = rb[i]; }
}
__device__ __forceinline__ void branch_tile(LAS unsigned char* lds, const bf16_t* omix, const bf16_t* wbr, const bf16_t* brg, bf16_t* mix, int pm, int pn, int tid) {
    const int lane = tid & 63, w = tid >> 6, r = lane & 31, h = lane >> 5, wr = w >> 1, wc = w & 1;
    const bf16_t* A = omix + (size_t)pm * 256 * DM; const bf16_t* Bt = wbr + (size_t)pn * 128 * DM;
    LAS unsigned char* patch = lds + FG_PATCH + w * 2560;
    f32x16 seg[2][2]; unsigned tot[2][2][8];
#pragma unroll
    for (int a = 0; a < 2; ++a)
#pragma unroll
        for (int c = 0; c < 2; ++c)
#pragma unroll
            for (int i = 0; i < 16; ++i) { seg[a][c][i] = 0.f; tot[a][c][i >> 1] = 0u; }
    u32x4 ra0[4], rb0[2], ra1[4], rb1[2];
    __syncthreads();
    fg_ld(A, Bt, 0, tid, ra0, rb0); fg_st(lds, tid, ra0, rb0);
    fg_ld(A, Bt, 1, tid, ra1, rb1);
    __syncthreads();
#define FG_COMPUTE(BUF) { LAS const unsigned char* sa = lds + (BUF) * FG_STAGE + (64 * wr + r) * 144 + h * 16; LAS const unsigned char* sb = lds + (BUF) * FG_STAGE + FG_B + (64 * wc + r) * 144 + h * 16; \
        _Pragma("unroll") for (int kk = 0; kk < 4; ++kk) { const bf16x8 a0 = *(LAS const bf16x8*)(sa + kk * 32), a1 = *(LAS const bf16x8*)(sa + 32 * 144 + kk * 32); \
            const bf16x8 b0 = *(LAS const bf16x8*)(sb + kk * 32), b1 = *(LAS const bf16x8*)(sb + 32 * 144 + kk * 32); \
            seg[0][0] = MFMA32(a0, b0, seg[0][0]); seg[0][1] = MFMA32(a0, b1, seg[0][1]); seg[1][0] = MFMA32(a1, b0, seg[1][0]); seg[1][1] = MFMA32(a1, b1, seg[1][1]); } }
#define FG_BAR() do { asm volatile("s_waitcnt lgkmcnt(0)" ::: "memory"); __builtin_amdgcn_s_barrier(); asm volatile("" ::: "memory"); } while (0)
#pragma unroll 1
    for (int kt = 0; kt < 16; kt += 2) {
        fg_ld(A, Bt, (kt + 2 < 16 ? kt + 2 : 15), tid, ra0, rb0);
        FG_COMPUTE(0);
        fg_st(lds + FG_STAGE, tid, ra1, rb1);
        FG_BAR();
        fg_ld(A, Bt, (kt + 3 < 16 ? kt + 3 : 15), tid, ra1, rb1);
        const bool segend = (kt == 2) || (kt == 6) || (kt == 14);
        const int s = kt == 2 ? 0 : (kt == 6 ? 1 : 2);
        u32x4 g0[2], g1[2];
#define FG_GLD(dst, rt_, ct_) { _Pragma("unroll") for (int j = 0; j < 2; ++j) { const int p = lane + 64 * j; dst[j] = *(const u32x4*)(brg + ((unsigned)(pm * 256 + 64 * wr + 32 * (rt_) + (p >> 2)) * 3072u + (unsigned)(1024 * s + pn * 128 + 64 * wc + 32 * (ct_) + 8 * (p & 3)))); } }
#define FG_GATE(src, rt_, ct_) { _Pragma("unroll") for (int j = 0; j < 2; ++j) { const int p = lane + 64 * j; *(LAS u32x4*)(patch + (p >> 2) * 80 + (p & 3) * 16) = src[j]; } }
#define FG_ACC(rt_, ct_) { float gg[16]; \
            _Pragma("unroll") for (int i = 0; i < 16; ++i) { const int tr = 8 * (i >> 2) + 4 * h + (i & 3); gg[i] = bf2f(*(LAS const unsigned short*)(patch + tr * 80 + r * 2)); } \
            _Pragma("unroll") for (int p2 = 0; p2 < 8; ++p2) { const unsigned tv = tot[rt_][ct_][p2]; \
                tot[rt_][ct_][p2] = pk2(fmaf(gg[2 * p2], seg[rt_][ct_][2 * p2], bflo(tv)), fmaf(gg[2 * p2 + 1], seg[rt_][ct_][2 * p2 + 1], bfhi(tv))); seg[rt_][ct_][2 * p2] = 0.f; seg[rt_][ct_][2 * p2 + 1] = 0.f; } }
        if (segend) { FG_GLD(g0, 0, 0); FG_GLD(g1, 0, 1); }
        FG_COMPUTE(1);
        if (segend) {
            FG_GATE(g0, 0, 0); FG_GLD(g0, 1, 0); FG_ACC(0, 0);
            FG_GATE(g1, 0, 1); FG_GLD(g1, 1, 1); FG_ACC(0, 1);
            FG_GATE(g0, 1, 0); FG_ACC(1, 0);
            FG_GATE(g1, 1, 1); FG_ACC(1, 1);
        }
#undef FG_GLD
#undef FG_GATE
#undef FG_ACC
        fg_st(lds, tid, ra0, rb0);
        FG_BAR();
    }
#undef FG_COMPUTE
#undef FG_BAR
#pragma unroll
    for (int rt = 0; rt < 2; ++rt)
#pragma unroll
        for (int ct = 0; ct < 2; ++ct) { const int tok0 = pm * 256 + 64 * wr + 32 * rt, n0 = pn * 128 + 64 * wc + 32 * ct;
#pragma unroll
            for (int p2 = 0; p2 < 8; ++p2) { const int tr = 8 * (p2 >> 1) + 4 * h + 2 * (p2 & 1); const unsigned tv = tot[rt][ct][p2];
                *(LAS unsigned short*)(patch + tr * 80 + r * 2) = (unsigned short)(tv & 0xffffu); *(LAS unsigned short*)(patch + (tr + 1) * 80 + r * 2) = (unsigned short)(tv >> 16); }
#pragma unroll
            for (int j = 0; j < 2; ++j) { const int p = lane + 64 * j; const u32x4 ov = *(LAS const u32x4*)(patch + (p >> 2) * 80 + (p & 3) * 16);
                *(u32x4*)(mix + ((unsigned)(tok0 + (p >> 2)) * 1024u + (unsigned)(n0 + 8 * (p & 3)))) = ov; } }
}

#define LAUNDER_S(x) asm volatile("" : "+s"(x))
#define GAS __attribute__((address_space(1)))
#define INP(k) ({ int k_ = (k); LAUNDER_S(k_); (const float*)(const GAS float*)P.in[k_]; })
#define POUT ((float*)(GAS float*)P.out)
#define PHASE_BEGIN int L = layer; LAUNDER_S(L); GAS unsigned char* wsg_ = (GAS unsigned char*)P.ws; LAUNDER_S(wsg_); unsigned char* ws = (unsigned char*)wsg_; int G = gridDim.x, bx = blockIdx.x; LAUNDER_S(G); LAUNDER_S(bx); int tid = threadIdx.x; asm volatile("" : "+v"(tid)); const int lane = tid & 63, wave = __builtin_amdgcn_readfirstlane(tid >> 6); (void)lane; (void)wave; (void)G; (void)bx; (void)L; (void)ws;
__global__ void __launch_bounds__(512, 2) hybrid_fwd(Params P) {
    extern __shared__ __attribute__((aligned(16))) unsigned char lds_raw[];
    LAS unsigned char* lds = (LAS unsigned char*)lds_raw;
    cg::grid_group grid = cg::this_grid();
#pragma unroll 1
    for (int layer = 0; layer < 2; ++layer) {
#ifndef REP_A
#define REP_A 1
#endif
#ifndef REP_CD
#define REP_CD 1
#endif
        for (int repa_ = 0; repa_ < REP_A; ++repa_)
        { PHASE_BEGIN
            const int gtid = bx * 512 + tid, gthreads = G * 512, gwave = bx * 8 + wave, nwaves = G * 8;
            prep_w<1>(INP(3) + (size_t)L * DM * NIN, DM, NIN, (bf16_t*)(ws + WS_WIN), NINP, DM, lds, tid, bx, G);
            prep_w<3>(INP(11) + (size_t)L * DM * DM, DM, DM, (bf16_t*)(ws + WS_WBR), DM, DM, lds, tid, bx, G);
            prep_w<0>(INP(12) + (size_t)L * DM * DM, DM, DM, (bf16_t*)(ws + WS_WOUT), DM, DM, lds, tid, bx, G);
            prep_w<2>(INP(14) + (size_t)L * DM * 2 * DFF, DM, 2 * DFF, (bf16_t*)(ws + WS_WGU), 2 * DFF, DM, lds, tid, bx, G);
            prep_w<0>(INP(15) + (size_t)L * DFF * DM, DFF, DM, (bf16_t*)(ws + WS_WDN), DM, DFF, lds, tid, bx, G);
            const float* cw1 = INP(9) + (size_t)L * 2 * 2048 * 256;
            prep_w<0>(cw1, 2048, 256, (bf16_t*)(ws + WS_WC1), 256, 2048, lds, tid, bx, G);
            prep_w<0>(cw1 + 2048 * 256, 2048, 256, (bf16_t*)(ws + WS_WC1) + 256 * 2048, 256, 2048, lds, tid, bx, G);
            rmsnorm_rows(L == 0 ? INP(0) : (const float*)POUT, INP(2) + L * DM, (bf16_t*)(ws + WS_H), gwave, nwaves, lane);
            if (gwave < 512) { const int kv = gwave >> 8, j = gwave & 255; const float* pp = INP(8) + (size_t)L * 2 * 2048 + kv * 2048; const float* ww = cw1 + (size_t)kv * 2048 * 256 + j; float a = 0.f;
#pragma unroll 8
                for (int i = lane; i < 2048; i += 64) a = fmaf(pp[i], ww[(size_t)i * 256], a);
                a = wave_sum(a);
                if (lane == 0) ((float*)(ws + WS_SMALL))[kv * 256 + j] = a; }
            if (bx == 1 && tid < 384) { float* nw = (float*)(ws + WS_SMALL + 2048); const float v = tid < 64 ? (INP(4) + L * 64)[tid] : (tid < 128 ? (INP(5) + L * 64)[tid - 64] : (tid < 192 ? (INP(6) + L * 64)[tid - 128] : (INP(7) + L * 192)[tid - 192])); nw[tid] = v; }
        }
        grid.sync();

        { PHASE_BEGIN
            pg8::Gemm g{(const bf16_t*)(ws + WS_H), (const bf16_t*)(ws + WS_WIN), MTOK, NINP, DM, DM, DM}; pg8::StaticOrder S; S.init(MTOK, NINP, G, bx);
            EpiInproj E{ws, (const float*)(ws + WS_SMALL + 2048)};
#ifndef SKIP_B
            pg8::gemm_phase<EpiInproj, pg8::StaticOrder, true, true>(lds, g, S, E, tid);
#endif
        }
        grid.sync();

        for (int repcd_ = 0; repcd_ < REP_CD; ++repcd_) {
        { PHASE_BEGIN
            if (bx < 128) { const int kv = bx >> 6, ks = (bx >> 4) & 3;
                pg8::Gemm g{(const bf16_t*)(ws + WS_B + (kv ? HB_VCR : HB_KCR) * MiB) + ks * 512, (const bf16_t*)(ws + WS_WC1) + (size_t)kv * 256 * 2048 + ks * 512, 4096, 256, 512, 1024, 2048};
                pg8::StaticOrder S; S.init(4096, 256, G, bx & 15);
                EpiStoreF32 E{(float*)(ws + WS_H) + (size_t)(kv * 4 + ks) * 4096 * 256};
#ifndef SKIP_C
                pg8::gemm_phase<EpiStoreF32, pg8::StaticOrder, true, true>(lds, g, S, E, tid);
#endif
            } else {
                const bf16_t* mbk = (const bf16_t*)(ws + WS_B + HB_MBK * MiB); float* KMEAN = (float*)(ws + WS_SMALL + 4096);
                for (int item = (bx - 128) * 8 + wave; item < 512; item += (G - 128) * 8) { const int bh = item >> 5, n = item & 31;
                    const bf16_t* kp = mbk + ((size_t)bh * SEQ + 256 * n) * 64 + lane; float a = 0.f;
#pragma unroll 8
                    for (int j = 0; j < 256; ++j) a += bf2f(kp[(size_t)j * 64]);
                    KMEAN[(size_t)item * 64 + lane] = a * (1.0f / 256.0f); }
            }
        }
        grid.sync();

        { PHASE_BEGIN
            const int gwave = bx * 8 + wave, nwaves = G * 8;
            const float* cw2 = INP(10) + (size_t)L * 2 * 256 * 64; const float* nkn = INP(7) + L * 192;
            bf16_t* KC = (bf16_t*)(ws + WS_KC); bf16_t* VCT = (bf16_t*)(ws + WS_VCT);
            for (int row = gwave; row < 8192; row += nwaves) { const int kv = row >> 12, rr = row & 4095, bg = rr >> 9, n = rr & 511;
                f32x4 hv = *(const f32x4*)((const float*)(ws + WS_SMALL) + kv * 256 + 4 * lane);
                { const float* pp = (const float*)(ws + WS_H) + ((size_t)(kv * 4) * 4096 + rr) * 256 + 4 * lane;
#pragma unroll
                    for (int ks = 0; ks < 4; ++ks) hv += *(const f32x4*)(pp + (size_t)ks * 4096 * 256);
#pragma unroll
                    for (int e = 0; e < 4; ++e) { const float t = hv[e], z = 0.7978845608028654f * (t + 0.044715f * t * t * t);
                        const float th = 1.0f - 2.0f * __builtin_amdgcn_rcpf(1.0f + __expf(2.0f * z)); hv[e] = 0.5f * t * (1.0f + th); } }
                const float* wp = cw2 + (size_t)kv * 256 * 64 + lane; float a = 0.f;
#pragma unroll
                for (int k = 0; k < 256; ++k) { const float hk = __uint_as_float(__builtin_amdgcn_readlane(__float_as_uint(hv[k & 3]), k >> 2)); a = fmaf(hk, wp[k * 64], a); }
                if (kv == 0) { const float ss = wave_sum(a * a); float y = a * __builtin_amdgcn_rsqf(ss * (1.0f / 64.0f) + 1e-6f) * nkn[lane]; if (n == 511) y = 0.f;
                    KC[((size_t)bg * 512 + n) * 64 + lane] = (bf16_t)(pk2(y, 0.f) & 0xffffu); }
                else { if (n == 511) a = 0.f; VCT[((size_t)bg * 64 + lane) * 512 + n] = (bf16_t)(pk2(a, 0.f) & 0xffffu); } }
        }
        grid.sync();

        }
        { PHASE_BEGIN
            LAS unsigned* misc = (LAS unsigned*)(lds + ATT_MISC); LAS float* btab = (LAS float*)(lds + ATT_BT);
            const float* rel_bias = INP(1);
            __syncthreads();
            if (wave == 0) { const float* mqn = INP(4) + L * 64; const float* mkn = INP(5) + L * 64; const float* nqn = INP(6) + L * 64; const float* nkn = INP(7) + L * 192;
                float gq = fmaxf(fabsf(mqn[lane]), fabsf(nqn[lane])); float gk = fmaxf(fmaxf(fabsf(mkn[lane]), fabsf(nkn[lane])), fmaxf(fabsf(nkn[64 + lane]), fabsf(nkn[128 + lane])));
                float bm = 0.f;
#pragma unroll
                for (int i = 0; i < 6; ++i) bm = fmaxf(bm, fabsf(rel_bias[lane + 64 * i]));
                gq = wave_max(gq); gk = wave_max(gk); bm = wave_max(bm);
                if (lane == 0) ((LAS float*)misc)[2] = 8.0f * gq * gk + bm; }
            __syncthreads();
            const float shift = ((LAS float*)misc)[2];
            for (int i = tid; i < 12 * BT_N; i += 512) { const int hd = i / BT_N, jx = i - hd * BT_N; const int d = jx - 64;
                float v = -3.0e38f;
                if (d >= 0) { int bk; if (d < 16) bk = d; else if (d >= 128) bk = 31; else { bk = 16 + (int)(__log2f((float)d * (1.0f / 16.0f)) * (16.0f / 3.0f)); bk = bk > 31 ? 31 : bk; }
                    v = (rel_bias[bk * 12 + hd] - shift) * L2E; }
                btab[i] = v; }
            __syncthreads();
#ifndef REP_E
#define REP_E 1
#endif
            for (int rep_ = 0; rep_ < REP_E; ++rep_) {
            unsigned* ctl = (unsigned*)(ws + WS_CTL) + L + 2 * rep_;
            unsigned char* HBUF = ws + WS_B; bf16_t* OMIX = (bf16_t*)(ws + WS_H);
            for (;;) {
                __syncthreads();
                if (tid == 0) misc[0] = atomicAdd(ctl, 1u);
                __syncthreads();
                const int u = (int)misc[0];
                if (u >= 2048) break;
                int tidu = tid; asm volatile("" : "+v"(tidu));
                if (u < 1024) { const int c = 127 - (u >> 3), bg = u & 7;
#ifndef SKIP_NSA
                    nsa_unit(lds, HBUF, (const bf16_t*)(ws + WS_KC), (const bf16_t*)(ws + WS_VCT), (const float*)(ws + WS_NSG), OMIX, bg >> 1, bg & 1, c, tidu);
#endif
                }
                else if (u < 1536) { const int v = u - 1024;
#ifndef SKIP_MOBA
                    moba_unit(lds, HBUF, (const float*)(ws + WS_SMALL + 4096), OMIX, (v & 15) >> 2, v & 3, 31 - (v >> 4), tidu);
#endif
                }
                else { const int v = u - 1536;
#ifndef SKIP_SB
                    sb_unit(lds, HBUF, OMIX, (v & 15) >> 2, v & 3, 31 - (v >> 4), tidu);
#endif
                }
            }
            }
        }
        grid.sync();

        { PHASE_BEGIN
            for (int tl = bx; tl < 1024; tl += G) { int tidu = tid; asm volatile("" : "+v"(tidu));
                branch_tile(lds, (const bf16_t*)(ws + WS_H), (const bf16_t*)(ws + WS_WBR), (const bf16_t*)(ws + WS_A), (bf16_t*)(ws + WS_B), tl >> 3, tl & 7, tidu); }
        }
        grid.sync();

        { PHASE_BEGIN
            pg8::Gemm g{(const bf16_t*)(ws + WS_B), (const bf16_t*)(ws + WS_WOUT), MTOK, DM, DM, DM, DM}; pg8::StaticOrder S; S.init(MTOK, DM, G, bx);
            EpiRes E{L == 0 ? INP(0) : (const float*)POUT, POUT};
#ifndef SKIP_GJ
            pg8::gemm_phase<EpiRes, pg8::StaticOrder, true, true>(lds, g, S, E, tid);
#endif
        }
        grid.sync();

        { PHASE_BEGIN
            rmsnorm_rows(POUT, INP(13) + L * DM, (bf16_t*)(ws + WS_H), bx * 8 + wave, G * 8, lane); }
        grid.sync();

        { PHASE_BEGIN
            pg8::Gemm g{(const bf16_t*)(ws + WS_H), (const bf16_t*)(ws + WS_WGU), MTOK, 2 * DFF, DM, DM, DM}; pg8::StaticOrder S; S.init(MTOK, 2 * DFF, G, bx); EpiSwiglu E{(bf16_t*)(ws + WS_A)};
#ifndef SKIP_I
            pg8::gemm_phase<EpiSwiglu, pg8::StaticOrder, true, true>(lds, g, S, E, tid);
#endif
        }
        grid.sync();

        { PHASE_BEGIN
            pg8::Gemm g{(const bf16_t*)(ws + WS_A), (const bf16_t*)(ws + WS_WDN), MTOK, DM, DFF, DFF, DFF}; pg8::StaticOrder S; S.init(MTOK, DM, G, bx); EpiRes E{POUT, POUT};
#ifndef SKIP_GJ
            pg8::gemm_phase<EpiRes, pg8::StaticOrder, true, true>(lds, g, S, E, tid);
#endif
        }
        if (layer == 0) grid.sync();
    }
}

extern "C" void kernel_launch(void* const* d_in, const int* in_sizes, int n_in, void* d_out, int out_size, void* d_ws, size_t ws_size, hipStream_t stream) {
    static int grid = 0;
    if (grid == 0) {
        if (n_in != 16 || out_size != MTOK * DM || ws_size < WS_END) { fprintf(stderr, "kernel_launch: unexpected shapes (n_in %d out %d ws %zu, need ws >= %zu)\n", n_in, out_size, ws_size, (size_t)WS_END); grid = -1; return; }
        int dev = 0, cus = 0, per_cu = 0;
        hipGetDevice(&dev); hipDeviceGetAttribute(&cus, hipDeviceAttributeMultiprocessorCount, dev);
        if (hipFuncSetAttribute((const void*)hybrid_fwd, hipFuncAttributeMaxDynamicSharedMemorySize, LDS_BYTES) != hipSuccess) { fprintf(stderr, "kernel_launch: hipFuncSetAttribute failed\n"); grid = -1; return; }
        if (hipOccupancyMaxActiveBlocksPerMultiprocessor(&per_cu, (const void*)hybrid_fwd, 512, LDS_BYTES) != hipSuccess || per_cu < 1) { fprintf(stderr, "kernel_launch: occupancy query gave %d\n", per_cu); per_cu = 1; }
        (void)hipGetLastError();
        grid = cus * 1;
    }
    if (grid < 0) return;
    hipMemsetAsync((char*)d_ws + WS_CTL, 0, 4096, stream);
    Params p{};
    for (int i = 0; i < 16; ++i) p.in[i] = (const float*)d_in[i];
    p.out = (float*)d_out; p.ws = (unsigned char*)d_ws;
    void* args[] = {&p};
    hipError_t e = hipLaunchCooperativeKernel((const void*)hybrid_fwd, dim3(grid), dim3(512), args, LDS_BYTES, stream);
    if (e != hipSuccess) fprintf(stderr, "cooperative launch failed: %s (grid %d)\n", hipGetErrorString(e), grid);
}
```

```cpp
#include <hip/hip_runtime.h>
#include <hip/hip_cooperative_groups.h>
#include <cstdio>
#include <cstdint>
namespace cg = cooperative_groups;
namespace pg8 {
#define PG8_LAS __attribute__((address_space(3)))
typedef unsigned short bf16_t;
typedef short bf16x8 __attribute__((ext_vector_type(8)));
typedef float f32x4 __attribute__((ext_vector_type(4)));
typedef unsigned u32x4 __attribute__((ext_vector_type(4)));
constexpr int BM = 256, BK = 64, HALF = 128, HTB = HALF * BK * 2  , STAGE_BYTES = 8 * HTB, NXCD = 8, WGM = 8;

__host__ __device__ __forceinline__ int lds_byte(int r, int c) { const int st = (r >> 4) * 2 + (c >> 5), rr = r & 15, cc = c & 31, ob = rr * 64 + cc * 2; return st * 1024 + (ob ^ (((ob >> 9) & 1) << 5)); }
__host__ __device__ __forceinline__ void stage_rc(int b, int& R, int& C) { const int st = b / 1024, sb = b % 1024, swz = sb ^ (((sb >> 9) & 1) << 5); R = (st >> 1) * 16 + swz / 64; C = (st & 1) * 32 + (swz % 64) / 2; }
__host__ __device__ __forceinline__ int perm32(int rho) { const int n = rho >> 4, i = rho & 15; return 8 * (i >> 2) + 4 * n + (i & 3); }

struct Unit { int pm, pn; };
struct Gemm { const bf16_t* A; const bf16_t* Bt; int M, N, K, lda, ldb; };

struct StaticOrder {
    int nM, nN, nwg, G, c;
    __host__ __device__ void init(int M, int N, int G_, int c_) { nM = M / BM; nN = N / BM; nwg = nM * nN; G = G_; c = c_; }
    __host__ __device__ bool next(int i, Unit& u) const {
        const long L = (long)i * G + c; if (L >= nwg) return false;
        int wgid = (int)L; { const int q = nwg / NXCD, r = nwg % NXCD, xcd = wgid % NXCD, off = wgid / NXCD; wgid = (xcd < r ? xcd * (q + 1) : r * (q + 1) + (xcd - r) * q) + off; }
        const int nig = WGM * nN, gid = wgid / nig, fm = gid * WGM, gsz = (nM - fm) < WGM ? (nM - fm) : WGM;
        u.pm = fm + ((wgid % nig) % gsz); u.pn = (wgid % nig) / gsz; return true;
    }
    __device__ __forceinline__ void a_ready(const Unit&) const {}
    __device__ __forceinline__ void done(const Unit&) const {}
};
template <class Epi, class Sched, bool ALIGN_EPI = false, bool SP2 = false>
__device__ __forceinline__ void gemm_phase(PG8_LAS unsigned char* lds, const Gemm g, const Sched& S, const Epi& E, int tid_in) {
    const int tid = tid_in, wid = __builtin_amdgcn_readfirstlane(tid >> 6), lane = tid & 63, wr = wid >> 2, wc = wid & 3, fr = lane & 15, fq = lane >> 4;
    const int K = g.K, nt = K / BK;
    unsigned voffA[2], voffB[2];
#pragma unroll
    for (int i = 0; i < 2; ++i) { int R, C; stage_rc(tid * 16 + i * 8192, R, C); const int Rb = Epi::PERM ? ((R & ~31) + perm32(R & 31)) : R;
        voffA[i] = (unsigned)(R * g.lda + C) * 2u; voffB[i] = (unsigned)(Rb * g.ldb + C) * 2u; }
    const size_t kstep = (size_t)(BK * 2);
    const size_t hstepA = (size_t)HALF * g.lda * 2, hstepB = (size_t)HALF * g.ldb * 2;
    const size_t tstepA = 2 * hstepA, tstepB = 2 * hstepB;
    const unsigned ldsw = (unsigned)wid * 1024u;
    const int aoff = lds_byte(wr * 64 + fr, fq * 8), boff = lds_byte(wc * 32 + fr, fq * 8);
#define PG8_SA(b, h) (((b) * 2 + (h)) * HTB)
#define PG8_SB(b, h) ((4 + (b) * 2 + (h)) * HTB)
#define PG8_STAGE(bufoff, gbase, voff) do { _Pragma("unroll") for (int _i = 0; _i < 2; ++_i) \
        __builtin_amdgcn_global_load_lds((const unsigned*)((const char*)(gbase) + (voff)[_i]), (PG8_LAS unsigned*)(lds + (bufoff) + ldsw + _i * 8192), 16, 0, 0); } while (0)
#define PG8_LDA(dst, b, h) do { _Pragma("unroll") for (int m = 0; m < 4; ++m) _Pragma("unroll") for (int k = 0; k < 2; ++k) dst[m][k] = *(const PG8_LAS bf16x8*)(lds + PG8_SA(b, h) + aoff + m * 2048 + k * 1024); } while (0)
#define PG8_LDB(dst, b, h) do { _Pragma("unroll") for (int n = 0; n < 2; ++n) _Pragma("unroll") for (int k = 0; k < 2; ++k) dst[n][k] = *(const PG8_LAS bf16x8*)(lds + PG8_SB(b, h) + boff + n * 2048 + k * 1024); } while (0)
#define PG8_MMA(ai, bj, At, Bt) do { __builtin_amdgcn_s_setprio(1); _Pragma("unroll") for (int m = 0; m < 4; ++m) _Pragma("unroll") for (int n = 0; n < 2; ++n) _Pragma("unroll") for (int k = 0; k < 2; ++k) \
        acc[ai][bj][m][n] = __builtin_amdgcn_mfma_f32_16x16x32_bf16(Bt[n][k], At[m][k], acc[ai][bj][m][n], 0, 0, 0); __builtin_amdgcn_s_setprio(0); } while (0)
#define PG8_WAIT_V(n) asm volatile("s_waitcnt vmcnt(" #n ")" ::: "memory")
#define PG8_WAIT_L(n) asm volatile("s_waitcnt lgkmcnt(" #n ")" ::: "memory")
#define PG8_BAR __builtin_amdgcn_s_barrier()
#define PG8_SCHED __builtin_amdgcn_sched_barrier(0)
    Unit cur, nxt; int ui = 0;
    if (!S.next(0, cur)) return;
    f32x4 acc[2][2][4][2];
#pragma unroll
    for (int a = 0; a < 2; ++a)
#pragma unroll
        for (int b = 0; b < 2; ++b)
#pragma unroll
            for (int m = 0; m < 4; ++m)
#pragma unroll
                for (int n = 0; n < 2; ++n) acc[a][b][m][n] = (f32x4){0.f, 0.f, 0.f, 0.f};
    bf16x8 At[4][2], B0[2][2], B1[2][2];
    const char* cA = (const char*)g.A + (size_t)cur.pm * tstepA; const char* cB = (const char*)g.Bt + (size_t)cur.pn * tstepB;
    S.a_ready(cur);
    if constexpr (SP2) {
        PG8_STAGE(PG8_SB(0, 0), cB, voffB); PG8_STAGE(PG8_SB(0, 1), cB + hstepB, voffB); PG8_STAGE(PG8_SA(0, 0), cA, voffA); PG8_STAGE(PG8_SA(0, 1), cA + hstepA, voffA);
        if (wr == 1) PG8_BAR;
        PG8_WAIT_V(2); PG8_BAR;
        PG8_STAGE(PG8_SB(1, 0), cB + kstep, voffB); PG8_STAGE(PG8_SA(1, 0), cA + kstep, voffA); PG8_STAGE(PG8_SB(1, 1), cB + hstepB + kstep, voffB);
        PG8_WAIT_V(6); PG8_BAR;
    } else {
        PG8_STAGE(PG8_SB(0, 0), cB, voffB); PG8_STAGE(PG8_SA(0, 0), cA, voffA); PG8_STAGE(PG8_SB(0, 1), cB + hstepB, voffB); PG8_STAGE(PG8_SA(0, 1), cA + hstepA, voffA);
        if (wr == 1) PG8_BAR;
        PG8_WAIT_V(4); PG8_BAR;
        PG8_STAGE(PG8_SB(1, 0), cB + kstep, voffB); PG8_STAGE(PG8_SA(1, 0), cA + kstep, voffA); PG8_STAGE(PG8_SB(1, 1), cB + hstepB + kstep, voffB);
        PG8_WAIT_V(6); PG8_BAR;
    }
    for (;;) {
        const bool has_next = S.next(ui + 1, nxt);
        const char* nA = has_next ? (const char*)g.A + (size_t)nxt.pm * tstepA : cA; const char* nB = has_next ? (const char*)g.Bt + (size_t)nxt.pn * tstepB : cB;
#pragma unroll 1
        for (int t = 0; t < nt; t += 2) {
            const bool last = (t == nt - 2);
            const char* a1 = cA + (size_t)(t + 1) * kstep;
            const char* a2 = last ? nA : cA + (size_t)(t + 2) * kstep; const char* b2 = last ? nB : cB + (size_t)(t + 2) * kstep;
            const char* a3 = a2 + kstep; const char* b3 = b2 + kstep;
            if (last && has_next) S.a_ready(nxt);
            if constexpr (SP2) {
            PG8_LDB(B0, 0, 0); PG8_LDB(B1, 0, 1); PG8_SCHED; PG8_LDA(At, 0, 0); PG8_STAGE(PG8_SA(1, 1), a1 + hstepA, voffA);
            PG8_WAIT_V(8); PG8_WAIT_L(0); PG8_BAR; PG8_MMA(0, 0, At, B0); PG8_MMA(0, 1, At, B1); PG8_BAR; PG8_SCHED;
            PG8_LDA(At, 0, 1); PG8_STAGE(PG8_SB(0, 0), b2, voffB); PG8_STAGE(PG8_SB(0, 1), b2 + hstepB, voffB); PG8_STAGE(PG8_SA(0, 0), a2, voffA);
            PG8_WAIT_V(8); PG8_WAIT_L(0); PG8_BAR; PG8_MMA(1, 0, At, B0); PG8_MMA(1, 1, At, B1); PG8_BAR; PG8_SCHED;
            PG8_LDB(B0, 1, 0); PG8_LDB(B1, 1, 1); PG8_SCHED; PG8_LDA(At, 1, 0); PG8_STAGE(PG8_SA(0, 1), a2 + hstepA, voffA);
            PG8_WAIT_V(8); PG8_WAIT_L(0); PG8_BAR; PG8_MMA(0, 0, At, B0); PG8_MMA(0, 1, At, B1); PG8_BAR; PG8_SCHED;
            PG8_LDA(At, 1, 1); PG8_STAGE(PG8_SB(1, 0), b3, voffB); PG8_STAGE(PG8_SB(1, 1), b3 + hstepB, voffB); PG8_STAGE(PG8_SA(1, 0), a3, voffA);
            PG8_WAIT_V(8); PG8_WAIT_L(0); PG8_BAR; PG8_MMA(1, 0, At, B0); PG8_MMA(1, 1, At, B1); PG8_BAR; PG8_SCHED;
            } else {
            PG8_LDB(B0, 0, 0); PG8_SCHED; PG8_LDA(At, 0, 0); PG8_STAGE(PG8_SA(1, 1), a1 + hstepA, voffA);
            PG8_WAIT_L(8); PG8_BAR; PG8_WAIT_L(0); PG8_MMA(0, 0, At, B0); PG8_BAR; PG8_SCHED;
            PG8_LDB(B1, 0, 1); PG8_STAGE(PG8_SB(0, 0), b2, voffB);
            PG8_BAR; PG8_WAIT_L(0); PG8_MMA(0, 1, At, B1); PG8_BAR;
            PG8_LDA(At, 0, 1); PG8_STAGE(PG8_SA(0, 0), a2, voffA);
            PG8_BAR; PG8_WAIT_L(0); PG8_MMA(1, 0, At, B0); PG8_BAR; PG8_SCHED;
            PG8_STAGE(PG8_SB(0, 1), b2 + hstepB, voffB);
            PG8_WAIT_V(6); PG8_BAR; PG8_MMA(1, 1, At, B1); PG8_BAR;
            PG8_LDB(B0, 1, 0); PG8_SCHED; PG8_LDA(At, 1, 0); PG8_STAGE(PG8_SA(0, 1), a2 + hstepA, voffA);
            PG8_WAIT_L(8); PG8_BAR; PG8_WAIT_L(0); PG8_MMA(0, 0, At, B0); PG8_BAR; PG8_SCHED;
            PG8_LDB(B1, 1, 1); PG8_STAGE(PG8_SB(1, 0), b3, voffB);
            PG8_BAR; PG8_WAIT_L(0); PG8_MMA(0, 1, At, B1); PG8_BAR;
            PG8_LDA(At, 1, 1); PG8_STAGE(PG8_SA(1, 0), a3, voffA);
            PG8_BAR; PG8_WAIT_L(0); PG8_MMA(1, 0, At, B0); PG8_BAR; PG8_SCHED;
            PG8_STAGE(PG8_SB(1, 1), b3 + hstepB, voffB);
            PG8_WAIT_V(6); PG8_BAR; PG8_MMA(1, 1, At, B1); PG8_BAR;
            }
        }
        if constexpr (ALIGN_EPI) { if (wr == 0) PG8_BAR; }
        if constexpr (!Epi::AFTER_DRAIN) { E(acc, cur, wr, wc, fr, fq); S.done(cur); }
        if (!has_next) break;
#pragma unroll
        for (int a = 0; a < 2; ++a)
#pragma unroll
            for (int b = 0; b < 2; ++b)
#pragma unroll
                for (int m = 0; m < 4; ++m)
#pragma unroll
                    for (int n = 0; n < 2; ++n) acc[a][b][m][n] = (f32x4){0.f, 0.f, 0.f, 0.f};
        cur = nxt; cA = nA; cB = nB; ++ui;
        if constexpr (ALIGN_EPI) { if (wr == 1) PG8_BAR; }
    }
    PG8_WAIT_V(0);
    if constexpr (!ALIGN_EPI) { if (wr == 0) PG8_BAR; }
    PG8_BAR;
    if constexpr (Epi::AFTER_DRAIN) { E.fused(acc, cur, wr, wc, fr, fq, lds, wid, lane); S.done(cur); }
#undef PG8_SA
#undef PG8_SB
#undef PG8_STAGE
#undef PG8_LDA
#undef PG8_LDB
#undef PG8_MMA
#undef PG8_WAIT_V
#undef PG8_WAIT_L
#undef PG8_BAR
#undef PG8_SCHED
}
}

#define LAS __attribute__((address_space(3)))
typedef unsigned short bf16_t;
typedef short bf16x8 __attribute__((ext_vector_type(8)));
typedef float f32x4 __attribute__((ext_vector_type(4)));
typedef float f32x16 __attribute__((ext_vector_type(16)));
typedef unsigned u32x4 __attribute__((ext_vector_type(4)));
typedef unsigned u32x2 __attribute__((ext_vector_type(2)));
typedef float f32x2_t __attribute__((ext_vector_type(2)));
typedef __bf16 bf16x2_t __attribute__((ext_vector_type(2)));

constexpr int MTOK = 32768, DM = 1024, SEQ = 8192;
constexpr int NIN = 5912, NINP = 6144, DFF = 2816;
constexpr float L2E = 1.4426950408889634f;
constexpr size_t MiB = 1048576;
constexpr size_t WS_CTL = 0, WS_WIN = 1 * MiB, WS_WBR = 13 * MiB, WS_WOUT = 15 * MiB, WS_WGU = 17 * MiB, WS_WDN = 28 * MiB, WS_WC1 = 34 * MiB,
                 WS_SMALL = 36 * MiB, WS_CMPH = 37 * MiB, WS_KC = 45 * MiB, WS_VCT = 45 * MiB + 512 * 1024, WS_NSG = 46 * MiB,
                 WS_H = 49 * MiB  , WS_A = 113 * MiB  ,
                 WS_B = 305 * MiB  , WS_END = 481 * MiB;
constexpr size_t HB_SBQ = 0, HB_SBK = 16, HB_SBVT = 32, HB_MBQ = 48, HB_MBK = 64, HB_MBVT = 80, HB_NSQ = 96, HB_KCR = 128, HB_VCR = 136,
                 HB_KS = 144, HB_VST = 152, HB_KW = 160, HB_VWT = 168;
constexpr int LDS_BYTES = 147456;
constexpr int ATT_BT = 36864, ATT_MISC = 50688, ATT_SEL = 50944, ATT_X = 51968, ATT_OA = 93952;

struct Params { const float* in[16]; float* out; unsigned char* ws; };

__device__ __forceinline__ unsigned pk2(float lo, float hi) { f32x2_t v = {lo, hi}; bf16x2_t b = __builtin_convertvector(v, bf16x2_t); return __builtin_bit_cast(unsigned, b); }
__device__ __forceinline__ float bf2f(unsigned v16) { return __uint_as_float(v16 << 16); }
__device__ __forceinline__ float bflo(unsigned w) { return __uint_as_float(w << 16); }
__device__ __forceinline__ float bfhi(unsigned w) { return __uint_as_float(w & 0xffff0000u); }
__device__ __forceinline__ float wave_sum(float v) { v += __shfl_xor(v, 1); v += __shfl_xor(v, 2); v += __shfl_xor(v, 4); v += __shfl_xor(v, 8); v += __shfl_xor(v, 16); v += __shfl_xor(v, 32); return v; }
__device__ __forceinline__ float wave_max(float v) { v = fmaxf(v, __shfl_xor(v, 1)); v = fmaxf(v, __shfl_xor(v, 2)); v = fmaxf(v, __shfl_xor(v, 4)); v = fmaxf(v, __shfl_xor(v, 8)); v = fmaxf(v, __shfl_xor(v, 16)); v = fmaxf(v, __shfl_xor(v, 32)); return v; }
__device__ __forceinline__ float sigmoidf_(float x) { return __builtin_amdgcn_rcpf(1.0f + __expf(-x)); }
__device__ __forceinline__ float ex2(float x) { return __builtin_amdgcn_exp2f(x); }
__device__ __forceinline__ float lg2(float x) { return __builtin_amdgcn_logf(x); }

template <int MAP> __device__ __forceinline__ int mapcol(int p) {
    const int pn = p >> 8, q = p & 255, bj = q >> 7, wc = (q >> 5) & 3, n = (q >> 4) & 1, fq = (q >> 2) & 3, e = q & 3;
    const int lc = 64 * wc + 32 * bj + 8 * fq + 4 * n + e;
    if (MAP == 3) return p;
    if (MAP == 0) return 256 * pn + lc;
    if (MAP == 1) { if (pn <= 10) return 256 * pn + lc; if (pn == 11) return lc < 24 ? 2816 + lc : -1; return 2840 + 256 * (pn - 12) + lc; }
    const int j = 128 * pn + 32 * wc + 8 * fq + 4 * n + e; return bj ? DFF + j : j;
}

struct EpiRes {
    static constexpr bool PERM = false, AFTER_DRAIN = false;
    const float* res; float* out;
    __device__ __forceinline__ void operator()(const f32x4 (&acc)[2][2][4][2], const pg8::Unit& u, int wr, int wc, int fr_, int fq_) const {
        int fr = fr_, fq = fq_; asm volatile("" : "+v"(fr), "+v"(fq));
#pragma unroll
        for (int ai = 0; ai < 2; ++ai)
#pragma unroll
            for (int m = 0; m < 4; ++m) { const unsigned row = (unsigned)(u.pm * 256 + 128 * ai + 64 * wr + 16 * m + fr);
#pragma unroll
                for (int bj = 0; bj < 2; ++bj)
#pragma unroll
                    for (int n = 0; n < 2; ++n) { const unsigned o = row * 1024u + (unsigned)(u.pn * 256 + 64 * wc + 32 * bj + 8 * fq + 4 * n);
                        const f32x4 r = *(const f32x4*)(res + o); *(f32x4*)(out + o) = r + acc[ai][bj][m][n]; }
                __builtin_amdgcn_sched_barrier(0); }
    }
};
struct EpiSwiglu {
    static constexpr bool PERM = false, AFTER_DRAIN = false;
    bf16_t* act;
    __device__ __forceinline__ void operator()(const f32x4 (&acc)[2][2][4][2], const pg8::Unit& u, int wr, int wc, int fr_, int fq_) const {
        int fr = fr_, fq = fq_; asm volatile("" : "+v"(fr), "+v"(fq));
#pragma unroll
        for (int ai = 0; ai < 2; ++ai)
#pragma unroll
            for (int m = 0; m < 4; ++m) { const unsigned row = (unsigned)(u.pm * 256 + 128 * ai + 64 * wr + 16 * m + fr);
                float v[8];
#pragma unroll
                for (int n = 0; n < 2; ++n)
#pragma unroll
                    for (int e = 0; e < 4; ++e) { const float g = acc[ai][0][m][n][e], up = acc[ai][1][m][n][e]; v[4 * n + e] = g * sigmoidf_(g) * up; }
                u32x4 w; w.x = pk2(v[0], v[1]); w.y = pk2(v[2], v[3]); w.z = pk2(v[4], v[5]); w.w = pk2(v[6], v[7]);
                *(u32x4*)(act + (row * 2816u + (unsigned)(u.pn * 128 + 32 * wc + 8 * fq))) = w; }
    }
};
template <int MODE> struct EpiBranch {
    static constexpr bool PERM = false, AFTER_DRAIN = false;
    const bf16_t* brg; bf16_t* mix; int s;
    __device__ __forceinline__ void operator()(const f32x4 (&acc)[2][2][4][2], const pg8::Unit& u, int wr, int wc, int fr_, int fq_) const {
        int fr = fr_, fq = fq_; asm volatile("" : "+v"(fr), "+v"(fq));
#pragma unroll
        for (int ai = 0; ai < 2; ++ai)
#pragma unroll
            for (int m = 0; m < 4; ++m) { const unsigned row = (unsigned)(u.pm * 256 + 128 * ai + 64 * wr + 16 * m + fr);
#pragma unroll
                for (int bj = 0; bj < 2; ++bj)
#pragma unroll
                    for (int n = 0; n < 2; ++n) { const unsigned c = (unsigned)(u.pn * 256 + 64 * wc + 32 * bj + 8 * fq + 4 * n);
                        const u32x2 g = *(const u32x2*)(brg + (row * 3072u + 1024u * (unsigned)s + c));
                        u32x2 o = {0u, 0u}; if (MODE) o = *(const u32x2*)(mix + (row * 1024u + c));
                        const f32x4 a = acc[ai][bj][m][n];
                        u32x2 w;
                        w.x = pk2(bflo(o.x) + bflo(g.x) * a[0], bfhi(o.x) + bfhi(g.x) * a[1]);
                        w.y = pk2(bflo(o.y) + bflo(g.y) * a[2], bfhi(o.y) + bfhi(g.y) * a[3]);
                        *(u32x2*)(mix + (row * 1024u + c)) = w; }
                __builtin_amdgcn_sched_barrier(0); }
    }
};
struct EpiCmp1 {
    static constexpr bool PERM = false, AFTER_DRAIN = false;
    const float* bias; float* hid;
    __device__ __forceinline__ void operator()(const f32x4 (&acc)[2][2][4][2], const pg8::Unit& u, int wr, int wc, int fr_, int fq_) const {
        int fr = fr_, fq = fq_; asm volatile("" : "+v"(fr), "+v"(fq));
#pragma unroll
        for (int ai = 0; ai < 2; ++ai)
#pragma unroll
            for (int m = 0; m < 4; ++m) { const unsigned row = (unsigned)(u.pm * 256 + 128 * ai + 64 * wr + 16 * m + fr);
#pragma unroll
                for (int bj = 0; bj < 2; ++bj)
#pragma unroll
                    for (int n = 0; n < 2; ++n) { const int c = 64 * wc + 32 * bj + 8 * fq + 4 * n;
                        const f32x4 b = *(const f32x4*)(bias + c); f32x4 x = acc[ai][bj][m][n] + b, y;
#pragma unroll
                        for (int e = 0; e < 4; ++e) { const float t = x[e], z = 0.7978845608028654f * (t + 0.044715f * t * t * t);
                            const float th = 1.0f - 2.0f * __builtin_amdgcn_rcpf(1.0f + __expf(2.0f * z)); y[e] = 0.5f * t * (1.0f + th); }
                        *(f32x4*)(hid + (row * 256u + (unsigned)c)) = y; } }
    }
};
struct EpiStoreF32 {
    static constexpr bool PERM = false, AFTER_DRAIN = false;
    float* hid;
    __device__ __forceinline__ void operator()(const f32x4 (&acc)[2][2][4][2], const pg8::Unit& u, int wr, int wc, int fr_, int fq_) const {
        int fr = fr_, fq = fq_; asm volatile("" : "+v"(fr), "+v"(fq));
#pragma unroll
        for (int ai = 0; ai < 2; ++ai)
#pragma unroll
            for (int m = 0; m < 4; ++m) { const unsigned row = (unsigned)(u.pm * 256 + 128 * ai + 64 * wr + 16 * m + fr);
#pragma unroll
                for (int bj = 0; bj < 2; ++bj)
#pragma unroll
                    for (int n = 0; n < 2; ++n) *(f32x4*)(hid + (row * 256u + (unsigned)(64 * wc + 32 * bj + 8 * fq + 4 * n))) = acc[ai][bj][m][n]; }
    }
};
struct EpiInproj {
    static constexpr bool PERM = false, AFTER_DRAIN = false;
    unsigned char* wsb; const float* nwb;
    __device__ __forceinline__ void operator()(const f32x4 (&acc)[2][2][4][2], const pg8::Unit& u, int wr, int wc, int fr_, int fq_) const {
        int fr = fr_, fq = fq_; asm volatile("" : "+v"(fr), "+v"(fq));
        const int t = u.pn; unsigned char* hb = wsb + WS_B; float* nsg = (float*)(wsb + WS_NSG); bf16_t* brg = (bf16_t*)(wsb + WS_A);
        const float* mqn = nwb; const float* mkn = nwb + 64; const float* nqn = nwb + 128; const float* nkn = nwb + 192;
        if (t <= 10) {
            const int hd = 4 * t + wc;
            const int grp = hd < 24 ? (hd >> 2) : (hd < 32 ? 6 : 7 + ((hd - 32) >> 1));
            const int hh = hd < 24 ? (hd & 3) : (hd < 32 ? hd - 24 : (hd & 1));
            const int H = grp < 6 ? 4 : (grp == 6 ? 8 : 2);
            bf16_t* base = (bf16_t*)(hb + (grp <= 6 ? (size_t)16 * grp : (size_t)(128 + 8 * (grp - 7))) * MiB);
            const bool trans = (grp == 2) | (grp == 5) | (grp == 10) | (grp == 12);
            const bool norm = (grp == 3) | (grp == 4) | (grp == 6) | (grp == 9) | (grp == 11);
            const float qs = ((grp == 0) | (grp == 3) | (grp == 6)) ? 0.125f * L2E : 1.0f;
            const float* nw = grp == 3 ? mqn : (grp == 4 ? mkn : (grp == 6 ? nqn : (grp == 9 ? nkn + 64 : nkn + 128)));
#pragma unroll
            for (int ai = 0; ai < 2; ++ai)
#pragma unroll
                for (int m = 0; m < 4; ++m) { const int row = u.pm * 256 + 128 * ai + 64 * wr + 16 * m + fr; const int b = row >> 13, s = row & 8191;
                    float v[2][8];
#pragma unroll
                    for (int bj = 0; bj < 2; ++bj)
#pragma unroll
                        for (int n = 0; n < 2; ++n)
#pragma unroll
                            for (int e = 0; e < 4; ++e) v[bj][4 * n + e] = acc[ai][bj][m][n][e];
                    float sc = qs;
                    if (norm) { float ss = 0.f;
#pragma unroll
                        for (int bj = 0; bj < 2; ++bj)
#pragma unroll
                            for (int j = 0; j < 8; ++j) ss += v[bj][j] * v[bj][j];
                        ss += __shfl_xor(ss, 16); ss += __shfl_xor(ss, 32);
                        sc = qs * __builtin_amdgcn_rsqf(ss * (1.0f / 64.0f) + 1e-6f);
#pragma unroll
                        for (int bj = 0; bj < 2; ++bj) { const f32x4 w0 = *(const f32x4*)(nw + 32 * bj + 8 * fq), w1 = *(const f32x4*)(nw + 32 * bj + 8 * fq + 4);
#pragma unroll
                            for (int e = 0; e < 4; ++e) { v[bj][e] *= w0[e]; v[bj][4 + e] *= w1[e]; } } }
                    if (!trans) {
#pragma unroll
                        for (int bj = 0; bj < 2; ++bj) { u32x4 w; w.x = pk2(v[bj][0] * sc, v[bj][1] * sc); w.y = pk2(v[bj][2] * sc, v[bj][3] * sc); w.z = pk2(v[bj][4] * sc, v[bj][5] * sc); w.w = pk2(v[bj][6] * sc, v[bj][7] * sc);
                            *(u32x4*)(base + (unsigned)(((b * H + hh) * SEQ + s) * 64 + 32 * bj + 8 * fq)) = w; }
                    } else {
#pragma unroll
                        for (int bj = 0; bj < 2; ++bj)
#pragma unroll
                            for (int j = 0; j < 8; j += 2) { const unsigned w = pk2(v[bj][j], v[bj][j + 1]); bf16_t* d = base + (unsigned)(((b * H + hh) * 64 + 32 * bj + 8 * fq + j) * SEQ + s);
                                d[0] = (bf16_t)(w & 0xffffu); d[SEQ] = (bf16_t)(w >> 16); }
                    } }
        } else if (t == 11) {
            if (wc == 0 && fq < 3) {
#pragma unroll
                for (int ai = 0; ai < 2; ++ai)
#pragma unroll
                    for (int m = 0; m < 4; ++m) { const unsigned row = (unsigned)(u.pm * 256 + 128 * ai + 64 * wr + 16 * m + fr);
#pragma unroll
                        for (int n = 0; n < 2; ++n) { f32x4 y;
#pragma unroll
                            for (int e = 0; e < 4; ++e) y[e] = sigmoidf_(acc[ai][0][m][n][e]);
                            *(f32x4*)(nsg + (row * 24u + (unsigned)(8 * fq + 4 * n))) = y; } }
            }
        } else {
#pragma unroll
            for (int ai = 0; ai < 2; ++ai)
#pragma unroll
                for (int m = 0; m < 4; ++m) { const unsigned row = (unsigned)(u.pm * 256 + 128 * ai + 64 * wr + 16 * m + fr);
#pragma unroll
                    for (int bj = 0; bj < 2; ++bj) { const f32x4 a0 = acc[ai][bj][m][0], a1 = acc[ai][bj][m][1]; u32x4 w;
                        w.x = pk2(sigmoidf_(a0[0]), sigmoidf_(a0[1])); w.y = pk2(sigmoidf_(a0[2]), sigmoidf_(a0[3]));
                        w.z = pk2(sigmoidf_(a1[0]), sigmoidf_(a1[1])); w.w = pk2(sigmoidf_(a1[2]), sigmoidf_(a1[3]));
                        *(u32x4*)(brg + (row * 3072u + (unsigned)((t - 12) * 256 + 64 * wc + 32 * bj + 8 * fq))) = w; } }
        }
    }
};

template <int MAP> __device__ __forceinline__ void prep_w(const float* __restrict__ W, int K, int ldw, bf16_t* __restrict__ Bt, int Np, int ldb, LAS unsigned char* lds, int tid, int bx, int G) {
    const int ntp = Np >> 6, ntiles = ntp * (K >> 6), w = tid >> 6, lane = tid & 63;
    float v[8];
    int tile = bx;
    if (tile < ntiles) { const int tk = tile / ntp, tp = tile - tk * ntp; const int col = mapcol<MAP>(tp * 64 + lane); const float* s = W + (size_t)(tk * 64 + 8 * w) * ldw + (col < 0 ? 0 : col);
#pragma unroll
        for (int i = 0; i < 8; ++i) v[i] = col >= 0 ? s[(size_t)i * ldw] : 0.f; }
    for (; tile < ntiles; tile += G) {
        const int tk = tile / ntp, tp = tile - tk * ntp;
        u32x4 pw; pw.x = pk2(v[0], v[1]); pw.y = pk2(v[2], v[3]); pw.z = pk2(v[4], v[5]); pw.w = pk2(v[6], v[7]);
        *(LAS u32x4*)(lds + lane * 144 + w * 16) = pw;
        __syncthreads();
        const int nx = tile + G;
        if (nx < ntiles) { const int tk2 = nx / ntp, tp2 = nx - tk2 * ntp; const int col = mapcol<MAP>(tp2 * 64 + lane); const float* s = W + (size_t)(tk2 * 64 + 8 * w) * ldw + (col < 0 ? 0 : col);
#pragma unroll
            for (int i = 0; i < 8; ++i) v[i] = col >= 0 ? s[(size_t)i * ldw] : 0.f; }
        { const int p = tid >> 3, pc = tid & 7; const u32x4 o = *(LAS const u32x4*)(lds + p * 144 + pc * 16);
            *(u32x4*)(Bt + (size_t)(tp * 64 + p) * ldb + tk * 64 + pc * 8) = o; }
        __syncthreads();
    }
}
__device__ __forceinline__ void rmsnorm_rows(const float* __restrict__ x, const float* __restrict__ g, bf16_t* __restrict__ h, int gwave, int nwaves, int lane) {
    for (int row = gwave; row < MTOK; row += nwaves) {
        const f32x4* xr = (const f32x4*)(x + (size_t)row * DM); f32x4 v[4]; float ss = 0.f;
#pragma unroll
        for (int i = 0; i < 4; ++i) { v[i] = xr[lane + 64 * i]; ss += v[i][0] * v[i][0] + v[i][1] * v[i][1] + v[i][2] * v[i][2] + v[i][3] * v[i][3]; }
        ss = wave_sum(ss); const float rs = __builtin_amdgcn_rsqf(ss * (1.0f / DM) + 1e-6f);
#pragma unroll
        for (int i = 0; i < 4; ++i) { const f32x4 gv = ((const f32x4*)g)[lane + 64 * i]; u32x2 w; w.x = pk2(v[i][0] * rs * gv[0], v[i][1] * rs * gv[1]); w.y = pk2(v[i][2] * rs * gv[2], v[i][3] * rs * gv[3]);
            *(u32x2*)(h + (size_t)row * DM + (lane + 64 * i) * 4) = w; }
    }
}

#define MFMA32(a, b, c) __builtin_amdgcn_mfma_f32_32x32x16_bf16((a), (b), (c), 0, 0, 0)
__device__ __forceinline__ void stage_ld(const bf16_t* K, const bf16_t* Vt, int ldvt, int key0, int tid, u32x4& rk, u32x4& rv) {
    const int row = tid >> 3, pc = tid & 7;
    rk = *(const u32x4*)(K + (size_t)(key0 + row) * 64 + pc * 8);
    rv = *(const u32x4*)(Vt + (size_t)row * ldvt + key0 + pc * 8);
}
__device__ __forceinline__ void stage_st(LAS unsigned char* lds, int buf, int tid, const u32x4& rk, const u32x4& rv) {
    const int row = tid >> 3, pc = tid & 7; LAS unsigned char* p = lds + buf * 18432 + row * 144 + pc * 16;
    *(LAS u32x4*)p = rk; *(LAS u32x4*)(p + 9216) = rv;
}
__device__ __forceinline__ void load_q(const bf16_t* qrow, int h, bf16x8 (&qf)[4]) {
#pragma unroll
    for (int kk = 0; kk < 4; ++kk) qf[kk] = *(const bf16x8*)(qrow + 16 * kk + 8 * h);
}
__device__ __forceinline__ f32x16 qk_sub(LAS const unsigned char* ks, int sub, const bf16x8 (&qf)[4], int r, int h, float init = 0.f) {
    const int pr = (r & 0x13) | ((r & 4) << 1) | ((r & 8) >> 1);
    LAS const unsigned char* p = ks + (32 * sub + pr) * 144 + h * 16;
    f32x16 st;
#pragma unroll
    for (int i = 0; i < 16; ++i) st[i] = init;
#pragma unroll
    for (int kk = 0; kk < 4; ++kk) { const bf16x8 kf = *(LAS const bf16x8*)(p + kk * 32); st = MFMA32(kf, qf[kk], st); }
    return st;
}
__device__ __forceinline__ void pv_sub(LAS const unsigned char* vs, int sub, const f32x16& p, f32x16 (&ot)[2], int r, int h) {
#pragma unroll
    for (int j = 0; j < 2; ++j) {
        u32x4 w; w.x = pk2(p[8 * j], p[8 * j + 1]); w.y = pk2(p[8 * j + 2], p[8 * j + 3]); w.z = pk2(p[8 * j + 4], p[8 * j + 5]); w.w = pk2(p[8 * j + 6], p[8 * j + 7]);
        const bf16x8 pf = __builtin_bit_cast(bf16x8, w);
#pragma unroll
        for (int mt = 0; mt < 2; ++mt) { const bf16x8 vf = *(LAS const bf16x8*)(vs + (32 * mt + r) * 144 + (32 * sub + 16 * j + 8 * h) * 2); ot[mt] = MFMA32(vf, pf, ot[mt]); }
    }
}
constexpr int BT_N = 288, BT_FAR = 64 + 223;
template <int MODE> __device__ __forceinline__ void soft_sub(f32x16& st, float& lsum, bool lane_valid, int dist0, int dmax, LAS const float* bt) {
    if (MODE == 0) {
#pragma unroll
        for (int i = 0; i < 16; ++i) { const float p = ex2(st[i]); lsum += p; st[i] = p; }
    } else if (MODE == 2) {
        const float cf = lane_valid ? bt[BT_FAR] : -3.0e38f;
#pragma unroll
        for (int i = 0; i < 16; ++i) { const int dist = dist0 - (16 * (i >> 3) + (i & 7)); const float b = dist < dmax ? cf : -3.0e38f;
            const float p = ex2(st[i] + b); lsum += p; st[i] = p; }
    } else if (MODE == 1) {
        float bb[16];
#pragma unroll
        for (int j = 0; j < 2; ++j) { int db = dist0 - 16 * j; db = db < -57 ? -57 : (db > 223 ? 223 : db); if (!lane_valid) db = -57;
            LAS const float* p = bt + (db + 64);
#pragma unroll
            for (int k = 0; k < 8; ++k) bb[8 * j + k] = p[-k]; }
#pragma unroll
        for (int i = 0; i < 16; ++i) { const float p = ex2(st[i] + bb[i]); lsum += p; st[i] = p; }
    } else {
        float bb[16];
#pragma unroll
        for (int i = 0; i < 16; ++i) { int d = dist0 - 16 * (16 * (i >> 3) + (i & 7)); d = d < -64 ? -64 : (d > 223 ? 223 : d); bb[i] = bt[d + 64]; }
#pragma unroll
        for (int i = 0; i < 16; ++i) { const float p = ex2(st[i] + bb[i]); lsum += p; st[i] = p; }
    }
}
__device__ __forceinline__ bf16x8 pack_p(const f32x16& p, int j) {
    u32x4 w; w.x = pk2(p[8 * j], p[8 * j + 1]); w.y = pk2(p[8 * j + 2], p[8 * j + 3]); w.z = pk2(p[8 * j + 4], p[8 * j + 5]); w.w = pk2(p[8 * j + 6], p[8 * j + 7]);
    return __builtin_bit_cast(bf16x8, w);
}
template <int MODE> __device__ __forceinline__ void tile_soft_gen(LAS const unsigned char* ks, LAS const unsigned char* vs, const bf16x8 (&qf)[4], f32x16 (&ot)[2], float& lsum,
                                                              bool lane_valid, int dist00, int dmax, LAS const float* bt, int r, int h) {
    const float init = MODE == 0 ? (lane_valid ? bt[BT_FAR] : -3.0e38f) : 0.f;
    const int pr = (r & 0x13) | ((r & 4) << 1) | ((r & 8) >> 1);
    LAS const unsigned char* kp = ks + pr * 144 + h * 16; LAS const unsigned char* vp = vs + r * 144 + h * 16;
    bf16x8 k0[4], k1[4], v0[2][2], v1[2][2];
#pragma unroll
    for (int kk = 0; kk < 4; ++kk) { k0[kk] = *(LAS const bf16x8*)(kp + kk * 32); k1[kk] = *(LAS const bf16x8*)(kp + 32 * 144 + kk * 32); }
    __builtin_amdgcn_sched_barrier(0);
    f32x16 s0, s1;
#pragma unroll
    for (int i = 0; i < 16; ++i) { s0[i] = init; s1[i] = init; }
#pragma unroll
    for (int kk = 0; kk < 4; ++kk) s0 = MFMA32(k0[kk], qf[kk], s0);
#pragma unroll
    for (int mt = 0; mt < 2; ++mt)
#pragma unroll
        for (int j = 0; j < 2; ++j) v0[mt][j] = *(LAS const bf16x8*)(vp + 32 * mt * 144 + 32 * j);
    __builtin_amdgcn_sched_barrier(0);
#pragma unroll
    for (int kk = 0; kk < 4; ++kk) s1 = MFMA32(k1[kk], qf[kk], s1);
#pragma unroll
    for (int mt = 0; mt < 2; ++mt)
#pragma unroll
        for (int j = 0; j < 2; ++j) v1[mt][j] = *(LAS const bf16x8*)(vp + 32 * mt * 144 + 64 + 32 * j);
    soft_sub<MODE>(s0, lsum, lane_valid, dist00, dmax, bt);
    __builtin_amdgcn_sched_barrier(0);
#pragma unroll
    for (int j = 0; j < 2; ++j) { const bf16x8 pf = pack_p(s0, j); ot[0] = MFMA32(v0[0][j], pf, ot[0]); ot[1] = MFMA32(v0[1][j], pf, ot[1]); }
    soft_sub<MODE>(s1, lsum, lane_valid, dist00 - (MODE == 3 ? 512 : 32), dmax, bt);
    __builtin_amdgcn_sched_barrier(0);
#pragma unroll
    for (int j = 0; j < 2; ++j) { const bf16x8 pf = pack_p(s1, j); ot[0] = MFMA32(v1[0][j], pf, ot[0]); ot[1] = MFMA32(v1[1][j], pf, ot[1]); }
}
#define SOFT4(st_, i0_) { _Pragma("unroll") for (int i_ = (i0_); i_ < (i0_) + 4; ++i_) { const float p_ = ex2(st_[i_]); lsum += p_; st_[i_] = p_; } }
__device__ __forceinline__ void tile_soft_far(LAS const unsigned char* ks, LAS const unsigned char* vs, const bf16x8 (&qf)[4], f32x16 (&ot)[2], float& lsum, bool lane_valid, LAS const float* bt, int r, int h) {
    const float init = lane_valid ? bt[BT_FAR] : -3.0e38f;
    const int pr = (r & 0x13) | ((r & 4) << 1) | ((r & 8) >> 1);
    LAS const unsigned char* kp = ks + pr * 144 + h * 16; LAS const unsigned char* vp = vs + r * 144 + h * 16;
    bf16x8 k0[4], k1[4], v0[2][2], v1[2][2];
#pragma unroll
    for (int kk = 0; kk < 4; ++kk) { k0[kk] = *(LAS const bf16x8*)(kp + kk * 32); k1[kk] = *(LAS const bf16x8*)(kp + 32 * 144 + kk * 32); }
    __builtin_amdgcn_sched_barrier(0);
    f32x16 s0, s1;
#pragma unroll
    for (int i = 0; i < 16; ++i) { s0[i] = init; s1[i] = init; }
#pragma unroll
    for (int kk = 0; kk < 4; ++kk) s0 = MFMA32(k0[kk], qf[kk], s0);
#pragma unroll
    for (int mt = 0; mt < 2; ++mt)
#pragma unroll
        for (int j = 0; j < 2; ++j) { v0[mt][j] = *(LAS const bf16x8*)(vp + 32 * mt * 144 + 32 * j); v1[mt][j] = *(LAS const bf16x8*)(vp + 32 * mt * 144 + 64 + 32 * j); }
    __builtin_amdgcn_sched_barrier(0);
    s1 = MFMA32(k1[0], qf[0], s1); SOFT4(s0, 0);  __builtin_amdgcn_sched_barrier(0);
    s1 = MFMA32(k1[1], qf[1], s1); SOFT4(s0, 4);  __builtin_amdgcn_sched_barrier(0);
    s1 = MFMA32(k1[2], qf[2], s1); SOFT4(s0, 8);  __builtin_amdgcn_sched_barrier(0);
    s1 = MFMA32(k1[3], qf[3], s1); SOFT4(s0, 12); __builtin_amdgcn_sched_barrier(0);
    const bf16x8 pa = pack_p(s0, 0);
    ot[0] = MFMA32(v0[0][0], pa, ot[0]); SOFT4(s1, 0);  __builtin_amdgcn_sched_barrier(0);
    ot[1] = MFMA32(v0[1][0], pa, ot[1]); SOFT4(s1, 4);  const bf16x8 pb = pack_p(s0, 1); __builtin_amdgcn_sched_barrier(0);
    ot[0] = MFMA32(v0[0][1], pb, ot[0]); SOFT4(s1, 8);  __builtin_amdgcn_sched_barrier(0);
    ot[1] = MFMA32(v0[1][1], pb, ot[1]); SOFT4(s1, 12); __builtin_amdgcn_sched_barrier(0);
#pragma unroll
    for (int j = 0; j < 2; ++j) { const bf16x8 pf = pack_p(s1, j); ot[0] = MFMA32(v1[0][j], pf, ot[0]); ot[1] = MFMA32(v1[1][j], pf, ot[1]); }
}
template <int MODE> __device__ __forceinline__ void tile_soft(LAS const unsigned char* ks, LAS const unsigned char* vs, const bf16x8 (&qf)[4], f32x16 (&ot)[2], float& lsum,
                                                              bool lane_valid, int dist00, int dmax, LAS const float* bt, int r, int h) {
    if (MODE == 0) tile_soft_far(ks, vs, qf, ot, lsum, lane_valid, bt, r, h);
    else tile_soft_gen<MODE>(ks, vs, qf, ot, lsum, lane_valid, dist00, dmax, bt, r, h);
}
__device__ __forceinline__ void zero_ot(f32x16 (&ot)[2]) {
#pragma unroll
    for (int i = 0; i < 16; ++i) { ot[0][i] = 0.f; ot[1][i] = 0.f; }
}
__device__ __forceinline__ void store_ot(bf16_t* orow, const f32x16 (&ot)[2], int h) {
#pragma unroll
    for (int mt = 0; mt < 2; ++mt)
#pragma unroll
        for (int g = 0; g < 4; ++g) { u32x2 w; w.x = pk2(ot[mt][4 * g], ot[mt][4 * g + 1]); w.y = pk2(ot[mt][4 * g + 2], ot[mt][4 * g + 3]);
            *(u32x2*)(orow + 32 * mt + 8 * g + 4 * h) = w; }
}

#define TILE_LOOP(KP, VP, LDV, KEY_FIRST, NT, BODY) do { \
    int key0 = (KEY_FIRST); const int nt_ = (NT); u32x4 rkA_, rvA_, rkB_, rvB_; \
    __syncthreads(); \
    stage_ld((KP), (VP), (LDV), key0, tid, rkA_, rvA_); stage_st(lds, 0, tid, rkA_, rvA_); \
    if (nt_ > 1) stage_ld((KP), (VP), (LDV), key0 + 64, tid, rkA_, rvA_); \
    __syncthreads(); \
    for (int it_ = 0; it_ < nt_; ++it_) { const int buf_ = it_ & 1; \
        if (it_ + 2 < nt_) stage_ld((KP), (VP), (LDV), key0 + 128, tid, rkB_, rvB_); \
        { LAS const unsigned char* ks = lds + buf_ * 18432; LAS const unsigned char* vs = ks + 9216; BODY } \
        if (it_ + 1 < nt_) stage_st(lds, buf_ ^ 1, tid, rkA_, rvA_); \
        __syncthreads(); key0 += 64; rkA_ = rkB_; rvA_ = rvB_; } } while (0)

__device__ __forceinline__ void sb_sub(LAS const unsigned char* vs, int sb, f32x16& st, f32x16 (&ot)[2], float& C, int key0, int t, int r, int h) {
    float ls[16]; float Rlo = 0.f, Rhi = 0.f;
#pragma unroll
    for (int i = 0; i < 16; ++i) { const int s = key0 + 32 * sb + 16 * (i >> 3) + 8 * h + (i & 7); const bool causal = s < t;
        const float u = st[i]; const float sp = fmaxf(u, 0.f) + lg2(1.0f + ex2(-fabsf(u)));
        ls[i] = causal ? -sp : 0.f; st[i] = causal ? (u - sp) : -3.0e38f;
        if (i < 8) Rlo += ls[i]; else Rhi += ls[i]; }
    const float Plo = __shfl_xor(Rlo, 32), Phi = __shfl_xor(Rhi, 32);
    float la = C + (h == 0 ? Phi : 0.f);
#pragma unroll
    for (int i = 15; i >= 8; --i) { const float a = ex2(st[i] + la); la += ls[i]; st[i] = a; }
    la = C + Rhi + Phi + (h == 0 ? Plo : 0.f);
#pragma unroll
    for (int i = 7; i >= 0; --i) { const float a = ex2(st[i] + la); la += ls[i]; st[i] = a; }
    C += (Rlo + Rhi) + (Plo + Phi);
    pv_sub(vs, sb, st, ot, r, h);
}
__device__ __forceinline__ void sb_unit(LAS unsigned char* lds, const unsigned char* hb, bf16_t* omix, int b, int hd, int qblk, int tid) {
    const int lane = tid & 63, w = tid >> 6, r = lane & 31, h = lane >> 5;
    const int bh = b * 4 + hd, q0 = qblk * 256, t = q0 + 32 * w + r;
    const bf16_t* Q = (const bf16_t*)(hb + HB_SBQ * MiB) + ((size_t)bh * SEQ + t) * 64;
    const bf16_t* K = (const bf16_t*)(hb + HB_SBK * MiB) + (size_t)bh * SEQ * 64;
    const bf16_t* Vt = (const bf16_t*)(hb + HB_SBVT * MiB) + (size_t)bh * 64 * SEQ;
    bf16x8 qf[4]; load_q(Q, h, qf);
    f32x16 ot[2]; zero_ot(ot);
    float C = 0.f;
    int key0 = q0 + 192; u32x4 rkA_, rvA_, rkB_, rvB_;
    __syncthreads();
    stage_ld(K, Vt, SEQ, key0, tid, rkA_, rvA_); stage_st(lds, 0, tid, rkA_, rvA_);
    if (key0 >= 64) stage_ld(K, Vt, SEQ, key0 - 64, tid, rkA_, rvA_);
    __syncthreads();
    int buf = 0;
    for (;;) {
        const bool has_next = key0 >= 64;
        if (key0 >= 128) stage_ld(K, Vt, SEQ, key0 - 128, tid, rkB_, rvB_);
        if (key0 <= q0 + 32 * w + 31) {
            LAS const unsigned char* ks = lds + buf * 18432; LAS const unsigned char* vs = ks + 9216;
            f32x16 s1 = qk_sub(ks, 1, qf, r, h); f32x16 s0 = qk_sub(ks, 0, qf, r, h);
            if (key0 + 32 <= q0 + 32 * w + 31) sb_sub(vs, 1, s1, ot, C, key0, t, r, h);
            sb_sub(vs, 0, s0, ot, C, key0, t, r, h);
        }
        const int alive = __syncthreads_or(C > -150.0f ? 1 : 0);
        if (!(has_next && alive)) break;
        stage_st(lds, buf ^ 1, tid, rkA_, rvA_);
        __syncthreads(); buf ^= 1; key0 -= 64; rkA_ = rkB_; rvA_ = rvB_;
    }
    store_ot(omix + ((size_t)b * SEQ + t) * DM + hd * 64, ot, h);
}

__device__ __forceinline__ void moba_unit(LAS unsigned char* lds, const unsigned char* hb, const float* kmean, bf16_t* omix, int b, int hd, int blk, int tid) {
    const int lane = tid & 63, w = tid >> 6, r = lane & 31, h = lane >> 5;
    const int bh = b * 4 + hd, q0 = blk * 256, t = q0 + 32 * w + r;
    const bf16_t* Qb = (const bf16_t*)(hb + HB_MBQ * MiB) + ((size_t)bh * SEQ + q0) * 64;
    const bf16_t* K = (const bf16_t*)(hb + HB_MBK * MiB) + (size_t)bh * SEQ * 64;
    const bf16_t* Vt = (const bf16_t*)(hb + HB_MBVT * MiB) + (size_t)bh * 64 * SEQ;
    LAS unsigned* misc = (LAS unsigned*)(lds + ATT_MISC); LAS unsigned* selm = (LAS unsigned*)(lds + ATT_SEL);
    LAS float* km = (LAS float*)(lds + ATT_X); LAS float* sc = km + 32 * 64;
    LAS const float* bt = (LAS const float*)(lds + ATT_BT) + hd * BT_N;
    __syncthreads();
    if (tid == 0) misc[1] = 0u;
    if (blk > 3) {
        for (int i = tid; i < blk * 64; i += 512) km[i] = kmean[(size_t)bh * 32 * 64 + i];
        __syncthreads();
        { const int qi = tid & 255, part = tid >> 8; float q[64];
            const u32x4* qp = (const u32x4*)(Qb + (size_t)qi * 64);
#pragma unroll
            for (int c = 0; c < 8; ++c) { const u32x4 v = qp[c]; q[8 * c] = bflo(v.x); q[8 * c + 1] = bfhi(v.x); q[8 * c + 2] = bflo(v.y); q[8 * c + 3] = bfhi(v.y); q[8 * c + 4] = bflo(v.z); q[8 * c + 5] = bfhi(v.z); q[8 * c + 6] = bflo(v.w); q[8 * c + 7] = bfhi(v.w); }
            for (int n = part; n < blk; n += 2) { float a = 0.f;
#pragma unroll
                for (int d = 0; d < 64; ++d) a = fmaf(q[d], km[n * 64 + d], a);
                sc[qi * 33 + n] = a; } }
        __syncthreads();
        if (tid < 256) { unsigned m = 0u; float sv[32];
#pragma unroll
            for (int n = 0; n < 32; ++n) sv[n] = n < blk ? sc[tid * 33 + n] : -3.0e38f;
#pragma unroll
            for (int k = 0; k < 3; ++k) { float best = -3.0e38f; int bi = 0;
#pragma unroll
                for (int n = 0; n < 32; ++n) { const bool take = !((m >> n) & 1u) && sv[n] > best; best = take ? sv[n] : best; bi = take ? n : bi; }
                m |= 1u << bi; }
            selm[tid] = m; atomicOr((unsigned*)&misc[1], m); }
    } else {
        const unsigned m = (1u << blk) - 1u; if (tid < 256) selm[tid] = m; if (tid == 0) misc[1] = m;
    }
    __syncthreads();
    const unsigned uni = misc[1], sel = selm[32 * w + r];
    bf16x8 qf[4]; load_q(Qb + (size_t)(32 * w + r) * 64, h, qf);
    f32x16 ot[2]; zero_ot(ot); float lsum = 0.f;
    const int kend = q0 + 256;
#define MOBA_NEXT(k_, out_) do { int kk_ = (k_) + 64; while (kk_ < q0 && !((uni >> (kk_ >> 8)) & 1u)) kk_ = (kk_ | 255) + 1; (out_) = kk_; } while (0)
    int key0, knext, knext2; MOBA_NEXT(-64, key0); MOBA_NEXT(key0, knext);
    u32x4 rkA_, rvA_, rkB_, rvB_;
    stage_ld(K, Vt, SEQ, key0, tid, rkA_, rvA_); stage_st(lds, 0, tid, rkA_, rvA_);
    if (knext < kend) stage_ld(K, Vt, SEQ, knext, tid, rkA_, rvA_);
    __syncthreads();
    int buf = 0;
    while (key0 < kend) {
        MOBA_NEXT(knext, knext2);
        if (knext < kend && knext2 < kend) stage_ld(K, Vt, SEQ, knext2, tid, rkB_, rvB_);
        {
            LAS const unsigned char* ks = lds + buf * 18432; LAS const unsigned char* vs = ks + 9216;
            const int n = key0 >> 8; const bool own = (n == blk);
            const bool lane_valid = own ? true : (((sel >> n) & 1u) != 0u);
            const bool skip = own ? (key0 > q0 + 32 * w + 31) : (__ballot(lane_valid) == 0ull);
            if (!skip) {
                const bool near = (q0 + 32 * w) - (key0 + 63) < 128;
                const int dist00 = t - (key0 + 8 * h);
                if (near) tile_soft<1>(ks, vs, qf, ot, lsum, lane_valid, dist00, 0, bt, r, h);
                else tile_soft<0>(ks, vs, qf, ot, lsum, lane_valid, dist00, 0, bt, r, h);
            }
        }
        if (knext < kend) stage_st(lds, buf ^ 1, tid, rkA_, rvA_);
        __syncthreads(); buf ^= 1; key0 = knext; knext = knext2; rkA_ = rkB_; rvA_ = rvB_;
    }
#undef MOBA_NEXT
    const float l = lsum + __shfl_xor(lsum, 32); const float inv = 1.0f / fmaxf(l, 1e-30f);
#pragma unroll
    for (int i = 0; i < 16; ++i) { ot[0][i] *= inv; ot[1][i] *= inv; }
    store_ot(omix + ((size_t)b * SEQ + t) * DM + 256 + hd * 64, ot, h);
}

__device__ __forceinline__ void imp_sub(f32x16& st, float invc, int nbase, LAS float* improw, int r) {
#pragma unroll
    for (int j = 0; j < 2; ++j) { const int a = (nbase + 16 * j) >> 3;
        float s0 = ((st[8 * j] + st[8 * j + 1]) + (st[8 * j + 2] + st[8 * j + 3])) * invc;
        float s1 = ((st[8 * j + 3] + st[8 * j + 4]) + (st[8 * j + 5] + st[8 * j + 6]) + st[8 * j + 7]) * invc;
        float s2 = st[8 * j + 7] * invc;
        s0 += __shfl_xor(s0, 8); s0 += __shfl_xor(s0, 16); s1 += __shfl_xor(s1, 8); s1 += __shfl_xor(s1, 16); s2 += __shfl_xor(s2, 8); s2 += __shfl_xor(s2, 16);
        if (r < 8) { LAS float* ip = improw + 2 * a; ip[0] += s0; ip[1] += s1; if (2 * a + 2 < 128) ip[2] += s2; } }
}
__device__ __forceinline__ void nsa_unit(LAS unsigned char* lds, const unsigned char* hb, const bf16_t* kc, const bf16_t* vct, const float* nsg, bf16_t* omix, int b, int g, int c, int tid) {
    const int lane = tid & 63, w = tid >> 6, r = lane & 31, h = lane >> 5;
    const int bg = b * 2 + g, q0 = c * 64, ql = 8 * w + (r & 7), t = q0 + ql, hq = 4 * g + (r >> 3);
    const bf16_t* Q = (const bf16_t*)(hb + HB_NSQ * MiB) + ((size_t)(b * 8 + hq) * SEQ + t) * 64;
    LAS unsigned* selm = (LAS unsigned*)(lds + ATT_SEL); LAS float* imp = (LAS float*)(lds + ATT_X);
    LAS const float* bt = (LAS const float*)(lds + ATT_BT) + (4 + hq) * BT_N;
    const float* gate = nsg + ((size_t)b * SEQ + t) * 24 + hq;
    bf16x8 qf[4]; load_q(Q, h, qf);
    f32x16 ot[2]; zero_ot(ot);
    LAS unsigned* oal = (LAS unsigned*)(lds + ATT_OA) + (w * 16) * 64 + lane;
    const bf16_t* Kc = kc + (size_t)bg * 512 * 64; const bf16_t* Vc = vct + (size_t)bg * 64 * 512;
    const int ntc = (4 * c + 3 + 63) >> 6;
    float lsum = 0.f;
    TILE_LOOP(Kc, Vc, 512, 0, ntc, {
        tile_soft<3>(ks, vs, qf, ot, lsum, true, t - 31 - 16 * (key0 + 8 * h), 0, bt, r, h); });
    const float lc = lsum + __shfl_xor(lsum, 32); const float invc = 1.0f / fmaxf(lc, 1e-30f);
    { const float gc = gate[0] * invc;
#pragma unroll
        for (int i = 0; i < 8; ++i) { oal[i * 64] = pk2(ot[0][2 * i] * gc, ot[0][2 * i + 1] * gc); oal[(8 + i) * 64] = pk2(ot[1][2 * i] * gc, ot[1][2 * i + 1] * gc); } }
    for (int i = tid; i < 64 * 129; i += 512) imp[i] = 0.f;
    if (tid < 256) selm[tid] = 0u;
    TILE_LOOP(Kc, Vc, 512, 0, ntc, {
        f32x16 s0 = qk_sub(ks, 0, qf, r, h); f32x16 s1 = qk_sub(ks, 1, qf, r, h); float dummy = 0.f;
        const int dist00 = t - 31 - 16 * (key0 + 8 * h);
        soft_sub<3>(s0, dummy, true, dist00, 0, bt); imp_sub(s0, invc, key0 + 8 * h, imp + ql * 129, r);
        soft_sub<3>(s1, dummy, true, dist00 - 512, 0, bt); imp_sub(s1, invc, key0 + 32 + 8 * h, imp + ql * 129, r); });
    { const int qi = tid >> 3, sub = tid & 7;
        if (c >= 16) {
            { LAS const float* row = imp + qi * 129; unsigned long long kv[16]; int cnt[16];
#pragma unroll
                for (int k = 0; k < 16; ++k) { const int m = 1 + sub + 8 * k; const int mi = m <= 128 ? m : 128; kv[k] = ((unsigned long long)__float_as_uint(row[mi]) << 8) | (unsigned long long)(255 - m); cnt[k] = 0; }
                for (int m2 = 1; m2 <= c - 2; m2 += 8) { unsigned long long kx[8];
#pragma unroll
                    for (int j = 0; j < 8; ++j) { const int mm = m2 + j; const int mi = mm <= 128 ? mm : 128; const float x = row[mi]; kx[j] = mm <= c - 2 ? (((unsigned long long)__float_as_uint(x) << 8) | (unsigned long long)(255 - mm)) : 0ull; }
#pragma unroll
                    for (int j = 0; j < 8; ++j)
#pragma unroll
                        for (int k = 0; k < 16; ++k) cnt[k] += kx[j] > kv[k] ? 1 : 0; }
#pragma unroll
                for (int k = 0; k < 16; ++k) { const int m = 1 + sub + 8 * k; if (m <= c - 2 && cnt[k] < 13) atomicOr((unsigned*)&selm[qi * 4 + (m >> 5)], 1u << (m & 31)); } }
            if (sub == 0) { atomicOr((unsigned*)&selm[qi * 4], 1u); atomicOr((unsigned*)&selm[qi * 4 + ((c - 1) >> 5)], 1u << ((c - 1) & 31)); atomicOr((unsigned*)&selm[qi * 4 + (c >> 5)], 1u << (c & 31)); }
        } else if (sub == 0) selm[qi * 4] = (1u << (c + 1)) - 1u;
    }
    __syncthreads();
    const unsigned sel0 = selm[ql * 4], sel1 = selm[ql * 4 + 1], sel2 = selm[ql * 4 + 2], sel3 = selm[ql * 4 + 3];
    { const bf16_t* Ks = (const bf16_t*)(hb + HB_KS * MiB) + (size_t)bg * SEQ * 64; const bf16_t* Vs = (const bf16_t*)(hb + HB_VST * MiB) + (size_t)bg * 64 * SEQ;
        zero_ot(ot); lsum = 0.f;
        TILE_LOOP(Ks, Vs, SEQ, 0, c + 1, {
            const int m = key0 >> 6; const unsigned sw = m < 32 ? sel0 : (m < 64 ? sel1 : (m < 96 ? sel2 : sel3));
            const bool lane_valid = ((sw >> (m & 31)) & 1u) != 0u;
            if (__ballot(lane_valid) != 0ull) { const int dist00 = t - (key0 + 8 * h);
                if ((c - m) < 3) tile_soft<1>(ks, vs, qf, ot, lsum, lane_valid, dist00, 0, bt, r, h);
                else tile_soft<0>(ks, vs, qf, ot, lsum, lane_valid, dist00, 0, bt, r, h); } });
        const float l = lsum + __shfl_xor(lsum, 32); const float gs = gate[8] / fmaxf(l, 1e-30f);
#pragma unroll
        for (int i = 0; i < 8; ++i) { const unsigned a0 = oal[i * 64], a1 = oal[(8 + i) * 64];
            oal[i * 64] = pk2(bflo(a0) + ot[0][2 * i] * gs, bfhi(a0) + ot[0][2 * i + 1] * gs); oal[(8 + i) * 64] = pk2(bflo(a1) + ot[1][2 * i] * gs, bfhi(a1) + ot[1][2 * i + 1] * gs); } }
    { const bf16_t* Kw = (const bf16_t*)(hb + HB_KW * MiB) + (size_t)bg * SEQ * 64; const bf16_t* Vw = (const bf16_t*)(hb + HB_VWT * MiB) + (size_t)bg * 64 * SEQ;
        zero_ot(ot); lsum = 0.f;
        const int kfirst = q0 >= 512 ? q0 - 512 : 0; const int ntw = ((q0 - kfirst) >> 6) + 1;
        TILE_LOOP(Kw, Vw, SEQ, kfirst, ntw, {
            const int dist00 = t - (key0 + 8 * h);
            if (key0 >= q0 - 128) tile_soft<1>(ks, vs, qf, ot, lsum, true, dist00, 0, bt, r, h);
            else if (key0 == q0 - 512) tile_soft<2>(ks, vs, qf, ot, lsum, true, dist00, 512, bt, r, h);
            else tile_soft<0>(ks, vs, qf, ot, lsum, true, dist00, 0, bt, r, h); });
        const float l = lsum + __shfl_xor(lsum, 32); const float gw = gate[16] / fmaxf(l, 1e-30f);
#pragma unroll
        for (int i = 0; i < 8; ++i) { const unsigned a0 = oal[i * 64], a1 = oal[(8 + i) * 64];
            ot[0][2 * i] = bflo(a0) + ot[0][2 * i] * gw; ot[0][2 * i + 1] = bfhi(a0) + ot[0][2 * i + 1] * gw; ot[1][2 * i] = bflo(a1) + ot[1][2 * i] * gw; ot[1][2 * i + 1] = bfhi(a1) + ot[1][2 * i + 1] * gw; } }
    store_ot(omix + ((size_t)b * SEQ + t) * DM + 512 + hq * 64, ot, h);
}

constexpr int FG_STAGE = 55296, FG_B = 36864, FG_PATCH = 110592;
__device__ __forceinline__ void fg_ld(const bf16_t* A, const bf16_t* Bt, int kt, int tid, u32x4 (&ra)[4], u32x4 (&rb)[2]) {
#pragma unroll
    for (int i = 0; i < 4; ++i) { const unsigned p = (unsigned)(tid + 512 * i); ra[i] = *(const u32x4*)(A + 64 * kt + ((p >> 3) * 1024u + 8u * (p & 7u))); }
#pragma unroll
    for (int i = 0; i < 2; ++i) { const unsigned p = (unsigned)(tid + 512 * i); rb[i] = *(const u32x4*)(Bt + 64 * kt + ((p >> 3) * 1024u + 8u * (p & 7u))); }
}
__device__ __forceinline__ void fg_st(LAS unsigned char* st, int tid, const u32x4 (&ra)[4], const u32x4 (&rb)[2]) {
#pragma unroll
    for (int i = 0; i < 4; ++i) { const int p = tid + 512 * i; *(LAS u32x4*)(st + (p >> 3) * 144 + (p & 7) * 16) = ra[i]; }
#pragma unroll
    for (int i = 0; i < 2; ++i) { const int p = tid + 512 * i; *(LAS u32x4*)(st + FG_B + (p >> 3) * 144 + (p & 7) * 16) = rb[i]; }
}
__device__ __forceinline__ void branch_tile(LAS unsigned char* lds, const bf16_t* omix, const bf16_t* wbr, const bf16_t* brg, bf16_t* mix, int pm, int pn, int tid) {
    const int lane = tid & 63, w = tid >> 6, r = lane & 31, h = lane >> 5, wr = w >> 1, wc = w & 1;
    const bf16_t* A = omix + (size_t)pm * 256 * DM; const bf16_t* Bt = wbr + (size_t)pn * 128 * DM;
    LAS unsigned char* patch = lds + FG_PATCH + w * 2560;
    f32x16 seg[2][2]; unsigned tot[2][2][8];
#pragma unroll
    for (int a = 0; a < 2; ++a)
#pragma unroll
        for (int c = 0; c < 2; ++c)
#pragma unroll
            for (int i = 0; i < 16; ++i) { seg[a][c][i] = 0.f; tot[a][c][i >> 1] = 0u; }
    u32x4 ra0[4], rb0[2], ra1[4], rb1[2];
    __syncthreads();
    fg_ld(A, Bt, 0, tid, ra0, rb0); fg_st(lds, tid, ra0, rb0);
    fg_ld(A, Bt, 1, tid, ra1, rb1);
    __syncthreads();
#define FG_COMPUTE(BUF) { LAS const unsigned char* sa = lds + (BUF) * FG_STAGE + (64 * wr + r) * 144 + h * 16; LAS const unsigned char* sb = lds + (BUF) * FG_STAGE + FG_B + (64 * wc + r) * 144 + h * 16; \
        _Pragma("unroll") for (int kk = 0; kk < 4; ++kk) { const bf16x8 a0 = *(LAS const bf16x8*)(sa + kk * 32), a1 = *(LAS const bf16x8*)(sa + 32 * 144 + kk * 32); \
            const bf16x8 b0 = *(LAS const bf16x8*)(sb + kk * 32), b1 = *(LAS const bf16x8*)(sb + 32 * 144 + kk * 32); \
            seg[0][0] = MFMA32(a0, b0, seg[0][0]); seg[0][1] = MFMA32(a0, b1, seg[0][1]); seg[1][0] = MFMA32(a1, b0, seg[1][0]); seg[1][1] = MFMA32(a1, b1, seg[1][1]); } }
#define FG_BAR() do { asm volatile("s_waitcnt lgkmcnt(0)" ::: "memory"); __builtin_amdgcn_s_barrier(); asm volatile("" ::: "memory"); } while (0)
#pragma unroll 1
    for (int kt = 0; kt < 16; kt += 2) {
        fg_ld(A, Bt, (kt + 2 < 16 ? kt + 2 : 15), tid, ra0, rb0);
        FG_COMPUTE(0);
        fg_st(lds + FG_STAGE, tid, ra1, rb1);
        FG_BAR();
        fg_ld(A, Bt, (kt + 3 < 16 ? kt + 3 : 15), tid, ra1, rb1);
        const bool segend = (kt == 2) || (kt == 6) || (kt == 14);
        const int s = kt == 2 ? 0 : (kt == 6 ? 1 : 2);
        u32x4 g0[2], g1[2];
#define FG_GLD(dst, rt_, ct_) { _Pragma("unroll") for (int j = 0; j < 2; ++j) { const int p = lane + 64 * j; dst[j] = *(const u32x4*)(brg + ((unsigned)(pm * 256 + 64 * wr + 32 * (rt_) + (p >> 2)) * 3072u + (unsigned)(1024 * s + pn * 128 + 64 * wc + 32 * (ct_) + 8 * (p & 3)))); } }
#define FG_GATE(src, rt_, ct_) { _Pragma("unroll") for (int j = 0; j < 2; ++j) { const int p = lane + 64 * j; *(LAS u32x4*)(patch + (p >> 2) * 80 + (p & 3) * 16) = src[j]; } }
#define FG_ACC(rt_, ct_) { float gg[16]; \
            _Pragma("unroll") for (int i = 0; i < 16; ++i) { const int tr = 8 * (i >> 2) + 4 * h + (i & 3); gg[i] = bf2f(*(LAS const unsigned short*)(patch + tr * 80 + r * 2)); } \
            _Pragma("unroll") for (int p2 = 0; p2 < 8; ++p2) { const unsigned tv = tot[rt_][ct_][p2]; \
                tot[rt_][ct_][p2] = pk2(fmaf(gg[2 * p2], seg[rt_][ct_][2 * p2], bflo(tv)), fmaf(gg[2 * p2 + 1], seg[rt_][ct_][2 * p2 + 1], bfhi(tv))); seg[rt_][ct_][2 * p2] = 0.f; seg[rt_][ct_][2 * p2 + 1] = 0.f; } }
        if (segend) { FG_GLD(g0, 0, 0); FG_GLD(g1, 0, 1); }
        FG_COMPUTE(1);
        if (segend) {
            FG_GATE(g0, 0, 0); FG_GLD(g0, 1, 0); FG_ACC(0, 0);
            FG_GATE(g1, 0, 1); FG_GLD(g1, 1, 1); FG_ACC(0, 1);
            FG_GATE(g0, 1, 0); FG_ACC(1, 0);
            FG_GATE(g1, 1, 1); FG_ACC(1, 1);
        }
#undef FG_GLD
#undef FG_GATE
#undef FG_ACC
        fg_st(lds, tid, ra0, rb0);
        FG_BAR();
    }
#undef FG_COMPUTE
#undef FG_BAR
#pragma unroll
    for (int rt = 0; rt < 2; ++rt)
#pragma unroll
        for (int ct = 0; ct < 2; ++ct) { const int tok0 = pm * 256 + 64 * wr + 32 * rt, n0 = pn * 128 + 64 * wc + 32 * ct;
#pragma unroll
            for (int p2 = 0; p2 < 8; ++p2) { const int tr = 8 * (p2 >> 1) + 4 * h + 2 * (p2 & 1); const unsigned tv = tot[rt][ct][p2];
                *(LAS unsigned short*)(patch + tr * 80 + r * 2) = (unsigned short)(tv & 0xffffu); *(LAS unsigned short*)(patch + (tr + 1) * 80 + r * 2) = (unsigned short)(tv >> 16); }
#pragma unroll
            for (int j = 0; j < 2; ++j) { const int p = lane + 64 * j; const u32x4 ov = *(LAS const u32x4*)(patch + (p >> 2) * 80 + (p & 3) * 16);
                *(u32x4*)(mix + ((unsigned)(tok0 + (p >> 2)) * 1024u + (unsigned)(n0 + 8 * (p & 3)))) = ov; } }
}

#define LAUNDER_S(x) asm volatile("" : "+s"(x))
#define GAS __attribute__((address_space(1)))
#define INP(k) ({ int k_ = (k); LAUNDER_S(k_); (const float*)(const GAS float*)P.in[k_]; })
#define POUT ((float*)(GAS float*)P.out)
#define PHASE_BEGIN int L = layer; LAUNDER_S(L); GAS unsigned char* wsg_ = (GAS unsigned char*)P.ws; LAUNDER_S(wsg_); unsigned char* ws = (unsigned char*)wsg_; int G = gridDim.x, bx = blockIdx.x; LAUNDER_S(G); LAUNDER_S(bx); int tid = threadIdx.x; asm volatile("" : "+v"(tid)); const int lane = tid & 63, wave = __builtin_amdgcn_readfirstlane(tid >> 6); (void)lane; (void)wave; (void)G; (void)bx; (void)L; (void)ws;
__global__ void __launch_bounds__(512, 2) hybrid_fwd(Params P) {
    extern __shared__ __attribute__((aligned(16))) unsigned char lds_raw[];
    LAS unsigned char* lds = (LAS unsigned char*)lds_raw;
    cg::grid_group grid = cg::this_grid();
#pragma unroll 1
    for (int layer = 0; layer < 2; ++layer) {
#ifndef REP_A
#define REP_A 1
#endif
#ifndef REP_CD
#define REP_CD 1
#endif
        for (int repa_ = 0; repa_ < REP_A; ++repa_)
        { PHASE_BEGIN
            const int gtid = bx * 512 + tid, gthreads = G * 512, gwave = bx * 8 + wave, nwaves = G * 8;
            prep_w<1>(INP(3) + (size_t)L * DM * NIN, DM, NIN, (bf16_t*)(ws + WS_WIN), NINP, DM, lds, tid, bx, G);
            prep_w<3>(INP(11) + (size_t)L * DM * DM, DM, DM, (bf16_t*)(ws + WS_WBR), DM, DM, lds, tid, bx, G);
            prep_w<0>(INP(12) + (size_t)L * DM * DM, DM, DM, (bf16_t*)(ws + WS_WOUT), DM, DM, lds, tid, bx, G);
            prep_w<2>(INP(14) + (size_t)L * DM * 2 * DFF, DM, 2 * DFF, (bf16_t*)(ws + WS_WGU), 2 * DFF, DM, lds, tid, bx, G);
            prep_w<0>(INP(15) + (size_t)L * DFF * DM, DFF, DM, (bf16_t*)(ws + WS_WDN), DM, DFF, lds, tid, bx, G);
            const float* cw1 = INP(9) + (size_t)L * 2 * 2048 * 256;
            prep_w<0>(cw1, 2048, 256, (bf16_t*)(ws + WS_WC1), 256, 2048, lds, tid, bx, G);
            prep_w<0>(cw1 + 2048 * 256, 2048, 256, (bf16_t*)(ws + WS_WC1) + 256 * 2048, 256, 2048, lds, tid, bx, G);
            rmsnorm_rows(L == 0 ? INP(0) : (const float*)POUT, INP(2) + L * DM, (bf16_t*)(ws + WS_H), gwave, nwaves, lane);
            if (gwave < 512) { const int kv = gwave >> 8, j = gwave & 255; const float* pp = INP(8) + (size_t)L * 2 * 2048 + kv * 2048; const float* ww = cw1 + (size_t)kv * 2048 * 256 + j; float a = 0.f;
#pragma unroll 8
                for (int i = lane; i < 2048; i += 64) a = fmaf(pp[i], ww[(size_t)i * 256], a);
                a = wave_sum(a);
                if (lane == 0) ((float*)(ws + WS_SMALL))[kv * 256 + j] = a; }
            if (bx == 1 && tid < 384) { float* nw = (float*)(ws + WS_SMALL + 2048); const float v = tid < 64 ? (INP(4) + L * 64)[tid] : (tid < 128 ? (INP(5) + L * 64)[tid - 64] : (tid < 192 ? (INP(6) + L * 64)[tid - 128] : (INP(7) + L * 192)[tid - 192])); nw[tid] = v; }
        }
        grid.sync();

        { PHASE_BEGIN
            pg8::Gemm g{(const bf16_t*)(ws + WS_H), (const bf16_t*)(ws + WS_WIN), MTOK, NINP, DM, DM, DM}; pg8::StaticOrder S; S.init(MTOK, NINP, G, bx);
            EpiInproj E{ws, (const float*)(ws + WS_SMALL + 2048)};
#ifndef SKIP_B
            pg8::gemm_phase<EpiInproj, pg8::StaticOrder, true, true>(lds, g, S, E, tid);
#endif
        }
        grid.sync();

        for (int repcd_ = 0; repcd_ < REP_CD; ++repcd_) {
        { PHASE_BEGIN
            if (bx < 128) { const int kv = bx >> 6, ks = (bx >> 4) & 3;
                pg8::Gemm g{(const bf16_t*)(ws + WS_B + (kv ? HB_VCR : HB_KCR) * MiB) + ks * 512, (const bf16_t*)(ws + WS_WC1) + (size_t)kv * 256 * 2048 + ks * 512, 4096, 256, 512, 1024, 2048};
                pg8::StaticOrder S; S.init(4096, 256, G, bx & 15);
                EpiStoreF32 E{(float*)(ws + WS_H) + (size_t)(kv * 4 + ks) * 4096 * 256};
#ifndef SKIP_C
                pg8::gemm_phase<EpiStoreF32, pg8::StaticOrder, true, true>(lds, g, S, E, tid);
#endif
            } else {
                const bf16_t* mbk = (const bf16_t*)(ws + WS_B + HB_MBK * MiB); float* KMEAN = (float*)(ws + WS_SMALL + 4096);
                for (int item = (bx - 128) * 8 + wave; item < 512; item += (G - 128) * 8) { const int bh = item >> 5, n = item & 31;
                    const bf16_t* kp = mbk + ((size_t)bh * SEQ + 256 * n) * 64 + lane; float a = 0.f;
#pragma unroll 8
                    for (int j = 0; j < 256; ++j) a += bf2f(kp[(size_t)j * 64]);
                    KMEAN[(size_t)item * 64 + lane] = a * (1.0f / 256.0f); }
            }
        }
        grid.sync();

        { PHASE_BEGIN
            const int gwave = bx * 8 + wave, nwaves = G * 8;
            const float* cw2 = INP(10) + (size_t)L * 2 * 256 * 64; const float* nkn = INP(7) + L * 192;
            bf16_t* KC = (bf16_t*)(ws + WS_KC); bf16_t* VCT = (bf16_t*)(ws + WS_VCT);
            for (int row = gwave; row < 8192; row += nwaves) { const int kv = row >> 12, rr = row & 4095, bg = rr >> 9, n = rr & 511;
                f32x4 hv = *(const f32x4*)((const float*)(ws + WS_SMALL) + kv * 256 + 4 * lane);
                { const float* pp = (const float*)(ws + WS_H) + ((size_t)(kv * 4) * 4096 + rr) * 256 + 4 * lane;
#pragma unroll
                    for (int ks = 0; ks < 4; ++ks) hv += *(const f32x4*)(pp + (size_t)ks * 4096 * 256);
#pragma unroll
                    for (int e = 0; e < 4; ++e) { const float t = hv[e], z = 0.7978845608028654f * (t + 0.044715f * t * t * t);
                        const float th = 1.0f - 2.0f * __builtin_amdgcn_rcpf(1.0f + __expf(2.0f * z)); hv[e] = 0.5f * t * (1.0f + th); } }
                const float* wp = cw2 + (size_t)kv * 256 * 64 + lane; float a = 0.f;
#pragma unroll
                for (int k = 0; k < 256; ++k) { const float hk = __uint_as_float(__builtin_amdgcn_readlane(__float_as_uint(hv[k & 3]), k >> 2)); a = fmaf(hk, wp[k * 64], a); }
                if (kv == 0) { const float ss = wave_sum(a * a); float y = a * __builtin_amdgcn_rsqf(ss * (1.0f / 64.0f) + 1e-6f) * nkn[lane]; if (n == 511) y = 0.f;
                    KC[((size_t)bg * 512 + n) * 64 + lane] = (bf16_t)(pk2(y, 0.f) & 0xffffu); }
                else { if (n == 511) a = 0.f; VCT[((size_t)bg * 64 + lane) * 512 + n] = (bf16_t)(pk2(a, 0.f) & 0xffffu); } }
        }
        grid.sync();

        }
        { PHASE_BEGIN
            LAS unsigned* misc = (LAS unsigned*)(lds + ATT_MISC); LAS float* btab = (LAS float*)(lds + ATT_BT);
            const float* rel_bias = INP(1);
            __syncthreads();
            if (wave == 0) { const float* mqn = INP(4) + L * 64; const float* mkn = INP(5) + L * 64; const float* nqn = INP(6) + L * 64; const float* nkn = INP(7) + L * 192;
                float gq = fmaxf(fabsf(mqn[lane]), fabsf(nqn[lane])); float gk = fmaxf(fmaxf(fabsf(mkn[lane]), fabsf(nkn[lane])), fmaxf(fabsf(nkn[64 + lane]), fabsf(nkn[128 + lane])));
                float bm = 0.f;
#pragma unroll
                for (int i = 0; i < 6; ++i) bm = fmaxf(bm, fabsf(rel_bias[lane + 64 * i]));
                gq = wave_max(gq); gk = wave_max(gk); bm = wave_max(bm);
                if (lane == 0) ((LAS float*)misc)[2] = 8.0f * gq * gk + bm; }
            __syncthreads();
            const float shift = ((LAS float*)misc)[2];
            for (int i = tid; i < 12 * BT_N; i += 512) { const int hd = i / BT_N, jx = i - hd * BT_N; const int d = jx - 64;
                float v = -3.0e38f;
                if (d >= 0) { int bk; if (d < 16) bk = d; else if (d >= 128) bk = 31; else { bk = 16 + (int)(__log2f((float)d * (1.0f / 16.0f)) * (16.0f / 3.0f)); bk = bk > 31 ? 31 : bk; }
                    v = (rel_bias[bk * 12 + hd] - shift) * L2E; }
                btab[i] = v; }
            __syncthreads();
#ifndef REP_E
#define REP_E 1
#endif
            for (int rep_ = 0; rep_ < REP_E; ++rep_) {
            unsigned* ctl = (unsigned*)(ws + WS_CTL) + L + 2 * rep_;
            unsigned char* HBUF = ws + WS_B; bf16_t* OMIX = (bf16_t*)(ws + WS_H);
            for (;;) {
                __syncthreads();
                if (tid == 0) misc[0] = atomicAdd(ctl, 1u);
                __syncthreads();
                const int u = (int)misc[0];
                if (u >= 2048) break;
                int tidu = tid; asm volatile("" : "+v"(tidu));
                if (u < 1024) { const int c = 127 - (u >> 3), bg = u & 7;
#ifndef SKIP_NSA
                    nsa_unit(lds, HBUF, (const bf16_t*)(ws + WS_KC), (const bf16_t*)(ws + WS_VCT), (const float*)(ws + WS_NSG), OMIX, bg >> 1, bg & 1, c, tidu);
#endif
                }
                else if (u < 1536) { const int v = u - 1024;
#ifndef SKIP_MOBA
                    moba_unit(lds, HBUF, (const float*)(ws + WS_SMALL + 4096), OMIX, (v & 15) >> 2, v & 3, 31 - (v >> 4), tidu);
#endif
                }
                else { const int v = u - 1536;
#ifndef SKIP_SB
                    sb_unit(lds, HBUF, OMIX, (v & 15) >> 2, v & 3, 31 - (v >> 4), tidu);
#endif
                }
            }
            }
        }
        grid.sync();

        { PHASE_BEGIN
            for (int tl = bx; tl < 1024; tl += G) { int tidu = tid; asm volatile("" : "+v"(tidu));
                branch_tile(lds, (const bf16_t*)(ws + WS_H), (const bf16_t*)(ws + WS_WBR), (const bf16_t*)(ws + WS_A), (bf16_t*)(ws + WS_B), tl >> 3, tl & 7, tidu); }
        }
        grid.sync();

        { PHASE_BEGIN
            pg8::Gemm g{(const bf16_t*)(ws + WS_B), (const bf16_t*)(ws + WS_WOUT), MTOK, DM, DM, DM, DM}; pg8::StaticOrder S; S.init(MTOK, DM, G, bx);
            EpiRes E{L == 0 ? INP(0) : (const float*)POUT, POUT};
#ifndef SKIP_GJ
            pg8::gemm_phase<EpiRes, pg8::StaticOrder, true, true>(lds, g, S, E, tid);
#endif
        }
        grid.sync();

        { PHASE_BEGIN
            rmsnorm_rows(POUT, INP(13) + L * DM, (bf16_t*)(ws + WS_H), bx * 8 + wave, G * 8, lane); }
        grid.sync();

        { PHASE_BEGIN
            pg8::Gemm g{(const bf16_t*)(ws + WS_H), (const bf16_t*)(ws + WS_WGU), MTOK, 2 * DFF, DM, DM, DM}; pg8::StaticOrder S; S.init(MTOK, 2 * DFF, G, bx); EpiSwiglu E{(bf16_t*)(ws + WS_A)};
#ifndef SKIP_I
            pg8::gemm_phase<EpiSwiglu, pg8::StaticOrder, true, true>(lds, g, S, E, tid);
#endif
        }
        grid.sync();

        { PHASE_BEGIN
            pg8::Gemm g{(const bf16_t*)(ws + WS_A), (const bf16_t*)(ws + WS_WDN), MTOK, DM, DFF, DFF, DFF}; pg8::StaticOrder S; S.init(MTOK, DM, G, bx); EpiRes E{POUT, POUT};
#ifndef SKIP_GJ
            pg8::gemm_phase<EpiRes, pg8::StaticOrder, true, true>(lds, g, S, E, tid);
#endif
        }
        if (layer == 0) grid.sync();
    }
}

extern "C" void kernel_launch(void* const* d_in, const int* in_sizes, int n_in, void* d_out, int out_size, void* d_ws, size_t ws_size, hipStream_t stream) {
    static int grid = 0;
    if (grid == 0) {
        if (n_in != 16 || out_size != MTOK * DM || ws_size < WS_END) { fprintf(stderr, "kernel_launch: unexpected shapes (n_in %d out %d ws %zu, need ws >= %zu)\n", n_in, out_size, ws_size, (size_t)WS_END); grid = -1; return; }
        int dev = 0, cus = 0, per_cu = 0;
        hipGetDevice(&dev); hipDeviceGetAttribute(&cus, hipDeviceAttributeMultiprocessorCount, dev);
        if (hipFuncSetAttribute((const void*)hybrid_fwd, hipFuncAttributeMaxDynamicSharedMemorySize, LDS_BYTES) != hipSuccess) { fprintf(stderr, "kernel_launch: hipFuncSetAttribute failed\n"); grid = -1; return; }
        if (hipOccupancyMaxActiveBlocksPerMultiprocessor(&per_cu, (const void*)hybrid_fwd, 512, LDS_BYTES) != hipSuccess || per_cu < 1) { fprintf(stderr, "kernel_launch: occupancy query gave %d\n", per_cu); per_cu = 1; }
        (void)hipGetLastError();
        grid = cus * 1;
    }
    if (grid < 0) return;
    hipMemsetAsync((char*)d_ws + WS_CTL, 0, 4096, stream);
    Params p{};
    for (int i = 0; i < 16; ++i) p.in[i] = (const float*)d_in[i];
    p.out = (float*)d_out; p.ws = (unsigned char*)d_ws;
    void* args[] = {&p};
    hipError_t e = hipLaunchCooperativeKernel((const void*)hybrid_fwd, dim3(grid), dim3(512), args, LDS_BYTES, stream);
    if (e != hipSuccess) fprintf(stderr, "cooperative launch failed: %s (grid %d)\n", hipGetErrorString(e), grid);
}
```

```cpp
#include <hip/hip_runtime.h>
#include <hip/hip_cooperative_groups.h>
#include <cstdio>
#include <cstdint>
namespace cg = cooperative_groups;
namespace pg8 {
#define PG8_LAS __attribute__((address_space(3)))
typedef unsigned short bf16_t;
typedef short bf16x8 __attribute__((ext_vector_type(8)));
typedef float f32x4 __attribute__((ext_vector_type(4)));
typedef unsigned u32x4 __attribute__((ext_vector_type(4)));
constexpr int BM = 256, BK = 64, HALF = 128, HTB = HALF * BK * 2  , STAGE_BYTES = 8 * HTB, NXCD = 8, WGM = 8;

__host__ __device__ __forceinline__ int lds_byte(int r, int c) { const int st = (r >> 4) * 2 + (c >> 5), rr = r & 15, cc = c & 31, ob = rr * 64 + cc * 2; return st * 1024 + (ob ^ (((ob >> 9) & 1) << 5)); }
__host__ __device__ __forceinline__ void stage_rc(int b, int& R, int& C) { const int st = b / 1024, sb = b % 1024, swz = sb ^ (((sb >> 9) & 1) << 5); R = (st >> 1) * 16 + swz / 64; C = (st & 1) * 32 + (swz % 64) / 2; }
__host__ __device__ __forceinline__ int perm32(int rho) { const int n = rho >> 4, i = rho & 15; return 8 * (i >> 2) + 4 * n + (i & 3); }

struct Unit { int pm, pn; };
struct Gemm { const bf16_t* A; const bf16_t* Bt; int M, N, K, lda, ldb; };

struct StaticOrder {
    int nM, nN, nwg, G, c;
    __host__ __device__ void init(int M, int N, int G_, int c_) { nM = M / BM; nN = N / BM; nwg = nM * nN; G = G_; c = c_; }
    __host__ __device__ bool next(int i, Unit& u) const {
        const long L = (long)i * G + c; if (L >= nwg) return false;
        int wgid = (int)L; { const int q = nwg / NXCD, r = nwg % NXCD, xcd = wgid % NXCD, off = wgid / NXCD; wgid = (xcd < r ? xcd * (q + 1) : r * (q + 1) + (xcd - r) * q) + off; }
        const int nig = WGM * nN, gid = wgid / nig, fm = gid * WGM, gsz = (nM - fm) < WGM ? (nM - fm) : WGM;
        u.pm = fm + ((wgid % nig) % gsz); u.pn = (wgid % nig) / gsz; return true;
    }
    __device__ __forceinline__ void a_ready(const Unit&) const {}
    __device__ __forceinline__ void done(const Unit&) const {}
};
template <class Epi, class Sched, bool ALIGN_EPI = false, bool SP2 = false>
__device__ __forceinline__ void gemm_phase(PG8_LAS unsigned char* lds, const Gemm g, const Sched& S, const Epi& E, int tid_in) {
    const int tid = tid_in, wid = __builtin_amdgcn_readfirstlane(tid >> 6), lane = tid & 63, wr = wid >> 2, wc = wid & 3, fr = lane & 15, fq = lane >> 4;
    const int K = g.K, nt = K / BK;
    unsigned voffA[2], voffB[2];
#pragma unroll
    for (int i = 0; i < 2; ++i) { int R, C; stage_rc(tid * 16 + i * 8192, R, C); const int Rb = Epi::PERM ? ((R & ~31) + perm32(R & 31)) : R;
        voffA[i] = (unsigned)(R * g.lda + C) * 2u; voffB[i] = (unsigned)(Rb * g.ldb + C) * 2u; }
    const size_t kstep = (size_t)(BK * 2);
    const size_t hstepA = (size_t)HALF * g.lda * 2, hstepB = (size_t)HALF * g.ldb * 2;
    const size_t tstepA = 2 * hstepA, tstepB = 2 * hstepB;
    const unsigned ldsw = (unsigned)wid * 1024u;
    const int aoff = lds_byte(wr * 64 + fr, fq * 8), boff = lds_byte(wc * 32 + fr, fq * 8);
#define PG8_SA(b, h) (((b) * 2 + (h)) * HTB)
#define PG8_SB(b, h) ((4 + (b) * 2 + (h)) * HTB)
#define PG8_STAGE(bufoff, gbase, voff) do { _Pragma("unroll") for (int _i = 0; _i < 2; ++_i) \
        __builtin_amdgcn_global_load_lds((const unsigned*)((const char*)(gbase) + (voff)[_i]), (PG8_LAS unsigned*)(lds + (bufoff) + ldsw + _i * 8192), 16, 0, 0); } while (0)
#define PG8_LDA(dst, b, h) do { _Pragma("unroll") for (int m = 0; m < 4; ++m) _Pragma("unroll") for (int k = 0; k < 2; ++k) dst[m][k] = *(const PG8_LAS bf16x8*)(lds + PG8_SA(b, h) + aoff + m * 2048 + k * 1024); } while (0)
#define PG8_LDB(dst, b, h) do { _Pragma("unroll") for (int n = 0; n < 2; ++n) _Pragma("unroll") for (int k = 0; k < 2; ++k) dst[n][k] = *(const PG8_LAS bf16x8*)(lds + PG8_SB(b, h) + boff + n * 2048 + k * 1024); } while (0)
#define PG8_MMA(ai, bj, At, Bt) do { __builtin_amdgcn_s_setprio(1); _Pragma("unroll") for (int m = 0; m < 4; ++m) _Pragma("unroll") for (int n = 0; n < 2; ++n) _Pragma("unroll") for (int k = 0; k < 2; ++k) \
        acc[ai][bj][m][n] = __builtin_amdgcn_mfma_f32_16x16x32_bf16(Bt[n][k], At[m][k], acc[ai][bj][m][n], 0, 0, 0); __builtin_amdgcn_s_setprio(0); } while (0)
#define PG8_WAIT_V(n) asm volatile("s_waitcnt vmcnt(" #n ")" ::: "memory")
#define PG8_WAIT_L(n) asm volatile("s_waitcnt lgkmcnt(" #n ")" ::: "memory")
#define PG8_BAR __builtin_amdgcn_s_barrier()
#define PG8_SCHED __builtin_amdgcn_sched_barrier(0)
    Unit cur, nxt; int ui = 0;
    if (!S.next(0, cur)) return;
    f32x4 acc[2][2][4][2];
#pragma unroll
    for (int a = 0; a < 2; ++a)
#pragma unroll
        for (int b = 0; b < 2; ++b)
#pragma unroll
            for (int m = 0; m < 4; ++m)
#pragma unroll
                for (int n = 0; n < 2; ++n) acc[a][b][m][n] = (f32x4){0.f, 0.f, 0.f, 0.f};
    bf16x8 At[4][2], B0[2][2], B1[2][2];
    const char* cA = (const char*)g.A + (size_t)cur.pm * tstepA; const char* cB = (const char*)g.Bt + (size_t)cur.pn * tstepB;
    S.a_ready(cur);
    if constexpr (SP2) {
        PG8_STAGE(PG8_SB(0, 0), cB, voffB); PG8_STAGE(PG8_SB(0, 1), cB + hstepB, voffB); PG8_STAGE(PG8_SA(0, 0), cA, voffA); PG8_STAGE(PG8_SA(0, 1), cA + hstepA, voffA);
        if (wr == 1) PG8_BAR;
        PG8_WAIT_V(2); PG8_BAR;
        PG8_STAGE(PG8_SB(1, 0), cB + kstep, voffB); PG8_STAGE(PG8_SA(1, 0), cA + kstep, voffA); PG8_STAGE(PG8_SB(1, 1), cB + hstepB + kstep, voffB);
        PG8_WAIT_V(6); PG8_BAR;
    } else {
        PG8_STAGE(PG8_SB(0, 0), cB, voffB); PG8_STAGE(PG8_SA(0, 0), cA, voffA); PG8_STAGE(PG8_SB(0, 1), cB + hstepB, voffB); PG8_STAGE(PG8_SA(0, 1), cA + hstepA, voffA);
        if (wr == 1) PG8_BAR;
        PG8_WAIT_V(4); PG8_BAR;
        PG8_STAGE(PG8_SB(1, 0), cB + kstep, voffB); PG8_STAGE(PG8_SA(1, 0), cA + kstep, voffA); PG8_STAGE(PG8_SB(1, 1), cB + hstepB + kstep, voffB);
        PG8_WAIT_V(6); PG8_BAR;
    }
    for (;;) {
        const bool has_next = S.next(ui + 1, nxt);
        const char* nA = has_next ? (const char*)g.A + (size_t)nxt.pm * tstepA : cA; const char* nB = has_next ? (const char*)g.Bt + (size_t)nxt.pn * tstepB : cB;
#pragma unroll 1
        for (int t = 0; t < nt; t += 2) {
            const bool last = (t == nt - 2);
            const char* a1 = cA + (size_t)(t + 1) * kstep;
            const char* a2 = last ? nA : cA + (size_t)(t + 2) * kstep; const char* b2 = last ? nB : cB + (size_t)(t + 2) * kstep;
            const char* a3 = a2 + kstep; const char* b3 = b2 + kstep;
            if (last && has_next) S.a_ready(nxt);
            if constexpr (SP2) {
            PG8_LDB(B0, 0, 0); PG8_LDB(B1, 0, 1); PG8_SCHED; PG8_LDA(At, 0, 0); PG8_STAGE(PG8_SA(1, 1), a1 + hstepA, voffA);
            PG8_WAIT_V(8); PG8_WAIT_L(0); PG8_BAR; PG8_MMA(0, 0, At, B0); PG8_MMA(0, 1, At, B1); PG8_BAR; PG8_SCHED;
            PG8_LDA(At, 0, 1); PG8_STAGE(PG8_SB(0, 0), b2, voffB); PG8_STAGE(PG8_SB(0, 1), b2 + hstepB, voffB); PG8_STAGE(PG8_SA(0, 0), a2, voffA);
            PG8_WAIT_V(8); PG8_WAIT_L(0); PG8_BAR; PG8_MMA(1, 0, At, B0); PG8_MMA(1, 1, At, B1); PG8_BAR; PG8_SCHED;
            PG8_LDB(B0, 1, 0); PG8_LDB(B1, 1, 1); PG8_SCHED; PG8_LDA(At, 1, 0); PG8_STAGE(PG8_SA(0, 1), a2 + hstepA, voffA);
            PG8_WAIT_V(8); PG8_WAIT_L(0); PG8_BAR; PG8_MMA(0, 0, At, B0); PG8_MMA(0, 1, At, B1); PG8_BAR; PG8_SCHED;
            PG8_LDA(At, 1, 1); PG8_STAGE(PG8_SB(1, 0), b3, voffB); PG8_STAGE(PG8_SB(1, 1), b3 + hstepB, voffB); PG8_STAGE(PG8_SA(1, 0), a3, voffA);
            PG8_WAIT_V(8); PG8_WAIT_L(0); PG8_BAR; PG8_MMA(1, 0, At, B0); PG8_MMA(1, 1, At, B1); PG8_BAR; PG8_SCHED;
            } else {
            PG8_LDB(B0, 0, 0); PG8_SCHED; PG8_LDA(At, 0, 0); PG8_STAGE(PG8_SA(1, 1), a1 + hstepA, voffA);
            PG8_WAIT_L(8); PG8_BAR; PG8_WAIT_L(0); PG8_MMA(0, 0, At, B0); PG8_BAR; PG8_SCHED;
            PG8_LDB(B1, 0, 1); PG8_STAGE(PG8_SB(0, 0), b2, voffB);
            PG8_BAR; PG8_WAIT_L(0); PG8_MMA(0, 1, At, B1); PG8_BAR;
            PG8_LDA(At, 0, 1); PG8_STAGE(PG8_SA(0, 0), a2, voffA);
            PG8_BAR; PG8_WAIT_L(0); PG8_MMA(1, 0, At, B0); PG8_BAR; PG8_SCHED;
            PG8_STAGE(PG8_SB(0, 1), b2 + hstepB, voffB);
            PG8_WAIT_V(6); PG8_BAR; PG8_MMA(1, 1, At, B1); PG8_BAR;
            PG8_LDB(B0, 1, 0); PG8_SCHED; PG8_LDA(At, 1, 0); PG8_STAGE(PG8_SA(0, 1), a2 + hstepA, voffA);
            PG8_WAIT_L(8); PG8_BAR; PG8_WAIT_L(0); PG8_MMA(0, 0, At, B0); PG8_BAR; PG8_SCHED;
            PG8_LDB(B1, 1, 1); PG8_STAGE(PG8_SB(1, 0), b3, voffB);
            PG8_BAR; PG8_WAIT_L(0); PG8_MMA(0, 1, At, B1); PG8_BAR;
            PG8_LDA(At, 1, 1); PG8_STAGE(PG8_SA(1, 0), a3, voffA);
            PG8_BAR; PG8_WAIT_L(0); PG8_MMA(1, 0, At, B0); PG8_BAR; PG8_SCHED;
            PG8_STAGE(PG8_SB(1, 1), b3 + hstepB, voffB);
            PG8_WAIT_V(6); PG8_BAR; PG8_MMA(1, 1, At, B1); PG8_BAR;
            }
        }
        if constexpr (ALIGN_EPI) { if (wr == 0) PG8_BAR; }
        if constexpr (!Epi::AFTER_DRAIN) { E(acc, cur, wr, wc, fr, fq); S.done(cur); }
        if (!has_next) break;
#pragma unroll
        for (int a = 0; a < 2; ++a)
#pragma unroll
            for (int b = 0; b < 2; ++b)
#pragma unroll
                for (int m = 0; m < 4; ++m)
#pragma unroll
                    for (int n = 0; n < 2; ++n) acc[a][b][m][n] = (f32x4){0.f, 0.f, 0.f, 0.f};
        cur = nxt; cA = nA; cB = nB; ++ui;
        if constexpr (ALIGN_EPI) { if (wr == 1) PG8_BAR; }
    }
    PG8_WAIT_V(0);
    if constexpr (!ALIGN_EPI) { if (wr == 0) PG8_BAR; }
    PG8_BAR;
    if constexpr (Epi::AFTER_DRAIN) { E.fused(acc, cur, wr, wc, fr, fq, lds, wid, lane); S.done(cur); }
#undef PG8_SA
#undef PG8_SB
#undef PG8_STAGE
#undef PG8_LDA
#undef PG8_LDB
#undef PG8_MMA
#undef PG8_WAIT_V
#undef PG8_WAIT_L
#undef PG8_BAR
#undef PG8_SCHED
}
}

#define LAS __attribute__((address_space(3)))
typedef unsigned short bf16_t;
typedef short bf16x8 __attribute__((ext_vector_type(8)));
typedef float f32x4 __attribute__((ext_vector_type(4)));
typedef float f32x16 __attribute__((ext_vector_type(16)));
typedef unsigned u32x4 __attribute__((ext_vector_type(4)));
typedef unsigned u32x2 __attribute__((ext_vector_type(2)));
typedef float f32x2_t __attribute__((ext_vector_type(2)));
typedef __bf16 bf16x2_t __attribute__((ext_vector_type(2)));

constexpr int MTOK = 32768, DM = 1024, SEQ = 8192;
constexpr int NIN = 5912, NINP = 6144, DFF = 2816;
constexpr float L2E = 1.4426950408889634f;
constexpr size_t MiB = 1048576;
constexpr size_t WS_CTL = 0, WS_WIN = 1 * MiB, WS_WBR = 13 * MiB, WS_WOUT = 15 * MiB, WS_WGU = 17 * MiB, WS_WDN = 28 * MiB, WS_WC1 = 34 * MiB,
                 WS_SMALL = 36 * MiB, WS_CMPH = 37 * MiB, WS_KC = 45 * MiB, WS_VCT = 45 * MiB + 512 * 1024, WS_NSG = 46 * MiB,
                 WS_H = 49 * MiB  , WS_A = 113 * MiB  ,
                 WS_B = 305 * MiB  , WS_END = 481 * MiB;
constexpr size_t HB_SBQ = 0, HB_SBK = 16, HB_SBVT = 32, HB_MBQ = 48, HB_MBK = 64, HB_MBVT = 80, HB_NSQ = 96, HB_KCR = 128, HB_VCR = 136,
                 HB_KS = 144, HB_VST = 152, HB_KW = 160, HB_VWT = 168;
constexpr int LDS_BYTES = 147456;
constexpr int ATT_BT = 36864, ATT_MISC = 50688, ATT_SEL = 50944, ATT_X = 51968, ATT_OA = 93952;

struct Params { const float* in[16]; float* out; unsigned char* ws; };

__device__ __forceinline__ unsigned pk2(float lo, float hi) { f32x2_t v = {lo, hi}; bf16x2_t b = __builtin_convertvector(v, bf16x2_t); return __builtin_bit_cast(unsigned, b); }
__device__ __forceinline__ float bf2f(unsigned v16) { return __uint_as_float(v16 << 16); }
__device__ __forceinline__ float bflo(unsigned w) { return __uint_as_float(w << 16); }
__device__ __forceinline__ float bfhi(unsigned w) { return __uint_as_float(w & 0xffff0000u); }
__device__ __forceinline__ float wave_sum(float v) { v += __shfl_xor(v, 1); v += __shfl_xor(v, 2); v += __shfl_xor(v, 4); v += __shfl_xor(v, 8); v += __shfl_xor(v, 16); v += __shfl_xor(v, 32); return v; }
__device__ __forceinline__ float wave_max(float v) { v = fmaxf(v, __shfl_xor(v, 1)); v = fmaxf(v, __shfl_xor(v, 2)); v = fmaxf(v, __shfl_xor(v, 4)); v = fmaxf(v, __shfl_xor(v, 8)); v = fmaxf(v, __shfl_xor(v, 16)); v = fmaxf(v, __shfl_xor(v, 32)); return v; }
__device__ __forceinline__ float sigmoidf_(float x) { return __builtin_amdgcn_rcpf(1.0f + __expf(-x)); }
__device__ __forceinline__ float ex2(float x) { return __builtin_amdgcn_exp2f(x); }
__device__ __forceinline__ float lg2(float x) { return __builtin_amdgcn_logf(x); }

template <int MAP> __device__ __forceinline__ int mapcol(int p) {
    const int pn = p >> 8, q = p & 255, bj = q >> 7, wc = (q >> 5) & 3, n = (q >> 4) & 1, fq = (q >> 2) & 3, e = q & 3;
    const int lc = 64 * wc + 32 * bj + 8 * fq + 4 * n + e;
    if (MAP == 3) return p;
    if (MAP == 0) return 256 * pn + lc;
    if (MAP == 1) { if (pn <= 10) return 256 * pn + lc; if (pn == 11) return lc < 24 ? 2816 + lc : -1; return 2840 + 256 * (pn - 12) + lc; }
    const int j = 128 * pn + 32 * wc + 8 * fq + 4 * n + e; return bj ? DFF + j : j;
}

struct EpiRes {
    static constexpr bool PERM = false, AFTER_DRAIN = false;
    const float* res; float* out;
    __device__ __forceinline__ void operator()(const f32x4 (&acc)[2][2][4][2], const pg8::Unit& u, int wr, int wc, int fr_, int fq_) const {
        int fr = fr_, fq = fq_; asm volatile("" : "+v"(fr), "+v"(fq));
#pragma unroll
        for (int ai = 0; ai < 2; ++ai)
#pragma unroll
            for (int m = 0; m < 4; ++m) { const unsigned row = (unsigned)(u.pm * 256 + 128 * ai + 64 * wr + 16 * m + fr);
#pragma unroll
                for (int bj = 0; bj < 2; ++bj)
#pragma unroll
                    for (int n = 0; n < 2; ++n) { const unsigned o = row * 1024u + (unsigned)(u.pn * 256 + 64 * wc + 32 * bj + 8 * fq + 4 * n);
                        const f32x4 r = *(const f32x4*)(res + o); *(f32x4*)(out + o) = r + acc[ai][bj][m][n]; }
                __builtin_amdgcn_sched_barrier(0); }
    }
};
struct EpiSwiglu {
    static constexpr bool PERM = false, AFTER_DRAIN = false;
    bf16_t* act;
    __device__ __forceinline__ void operator()(const f32x4 (&acc)[2][2][4][2], const pg8::Unit& u, int wr, int wc, int fr_, int fq_) const {
        int fr = fr_, fq = fq_; asm volatile("" : "+v"(fr), "+v"(fq));
#pragma unroll
        for (int ai = 0; ai < 2; ++ai)
#pragma unroll
            for (int m = 0; m < 4; ++m) { const unsigned row = (unsigned)(u.pm * 256 + 128 * ai + 64 * wr + 16 * m + fr);
                float v[8];
#pragma unroll
                for (int n = 0; n < 2; ++n)
#pragma unroll
                    for (int e = 0; e < 4; ++e) { const float g = acc[ai][0][m][n][e], up = acc[ai][1][m][n][e]; v[4 * n + e] = g * sigmoidf_(g) * up; }
                u32x4 w; w.x = pk2(v[0], v[1]); w.y = pk2(v[2], v[3]); w.z = pk2(v[4], v[5]); w.w = pk2(v[6], v[7]);
                *(u32x4*)(act + (row * 2816u + (unsigned)(u.pn * 128 + 32 * wc + 8 * fq))) = w; }
    }
};
template <int MODE> struct EpiBranch {
    static constexpr bool PERM = false, AFTER_DRAIN = false;
    const bf16_t* brg; bf16_t* mix; int s;
    __device__ __forceinline__ void operator()(const f32x4 (&acc)[2][2][4][2], const pg8::Unit& u, int wr, int wc, int fr_, int fq_) const {
        int fr = fr_, fq = fq_; asm volatile("" : "+v"(fr), "+v"(fq));
#pragma unroll
        for (int ai = 0; ai < 2; ++ai)
#pragma unroll
            for (int m = 0; m < 4; ++m) { const unsigned row = (unsigned)(u.pm * 256 + 128 * ai + 64 * wr + 16 * m + fr);
#pragma unroll
                for (int bj = 0; bj < 2; ++bj)
#pragma unroll
                    for (int n = 0; n < 2; ++n) { const unsigned c = (unsigned)(u.pn * 256 + 64 * wc + 32 * bj + 8 * fq + 4 * n);
                        const u32x2 g = *(const u32x2*)(brg + (row * 3072u + 1024u * (unsigned)s + c));
                        u32x2 o = {0u, 0u}; if (MODE) o = *(const u32x2*)(mix + (row * 1024u + c));
                        const f32x4 a = acc[ai][bj][m][n];
                        u32x2 w;
                        w.x = pk2(bflo(o.x) + bflo(g.x) * a[0], bfhi(o.x) + bfhi(g.x) * a[1]);
                        w.y = pk2(bflo(o.y) + bflo(g.y) * a[2], bfhi(o.y) + bfhi(g.y) * a[3]);
                        *(u32x2*)(mix + (row * 1024u + c)) = w; }
                __builtin_amdgcn_sched_barrier(0); }
    }
};
struct EpiCmp1 {
    static constexpr bool PERM = false, AFTER_DRAIN = false;
    const float* bias; float* hid;
    __device__ __forceinline__ void operator()(const f32x4 (&acc)[2][2][4][2], const pg8::Unit& u, int wr, int wc, int fr_, int fq_) const {
        int fr = fr_, fq = fq_; asm volatile("" : "+v"(fr), "+v"(fq));
#pragma unroll
        for (int ai = 0; ai < 2; ++ai)
#pragma unroll
            for (int m = 0; m < 4; ++m) { const unsigned row = (unsigned)(u.pm * 256 + 128 * ai + 64 * wr + 16 * m + fr);
#pragma unroll
                for (int bj = 0; bj < 2; ++bj)
#pragma unroll
                    for (int n = 0; n < 2; ++n) { const int c = 64 * wc + 32 * bj + 8 * fq + 4 * n;
                        const f32x4 b = *(const f32x4*)(bias + c); f32x4 x = acc[ai][bj][m][n] + b, y;
#pragma unroll
                        for (int e = 0; e < 4; ++e) { const float t = x[e], z = 0.7978845608028654f * (t + 0.044715f * t * t * t);
                            const float th = 1.0f - 2.0f * __builtin_amdgcn_rcpf(1.0f + __expf(2.0f * z)); y[e] = 0.5f * t * (1.0f + th); }
                        *(f32x4*)(hid + (row * 256u + (unsigned)c)) = y; } }
    }
};
struct EpiStoreF32 {
    static constexpr bool PERM = false, AFTER_DRAIN = false;
    float* hid;
    __device__ __forceinline__ void operator()(const f32x4 (&acc)[2][2][4][2], const pg8::Unit& u, int wr, int wc, int fr_, int fq_) const {
        int fr = fr_, fq = fq_; asm volatile("" : "+v"(fr), "+v"(fq));
#pragma unroll
        for (int ai = 0; ai < 2; ++ai)
#pragma unroll
            for (int m = 0; m < 4; ++m) { const unsigned row = (unsigned)(u.pm * 256 + 128 * ai + 64 * wr + 16 * m + fr);
#pragma unroll
                for (int bj = 0; bj < 2; ++bj)
#pragma unroll
                    for (int n = 0; n < 2; ++n) *(f32x4*)(hid + (row * 256u + (unsigned)(64 * wc + 32 * bj + 8 * fq + 4 * n))) = acc[ai][bj][m][n]; }
    }
};
__device__ __forceinline__ unsigned gq8(float x) { return (unsigned)(sigmoidf_(x) * 255.0f + 0.5f); }
struct EpiInproj {
    static constexpr bool PERM = false, AFTER_DRAIN = false;
    unsigned char* wsb; const float* nwb;
    __device__ __forceinline__ void operator()(const f32x4 (&acc)[2][2][4][2], const pg8::Unit& u, int wr, int wc, int fr_, int fq_) const {
        int fr = fr_, fq = fq_; asm volatile("" : "+v"(fr), "+v"(fq));
        const int t = u.pn; unsigned char* hb = wsb + WS_B; float* nsg = (float*)(wsb + WS_NSG); bf16_t* brg = (bf16_t*)(wsb + WS_A);
        const float* mqn = nwb; const float* mkn = nwb + 64; const float* nqn = nwb + 128; const float* nkn = nwb + 192;
        if (t <= 10) {
            const int hd = 4 * t + wc;
            const int grp = hd < 24 ? (hd >> 2) : (hd < 32 ? 6 : 7 + ((hd - 32) >> 1));
            const int hh = hd < 24 ? (hd & 3) : (hd < 32 ? hd - 24 : (hd & 1));
            const int H = grp < 6 ? 4 : (grp == 6 ? 8 : 2);
            bf16_t* base = (bf16_t*)(hb + (grp <= 6 ? (size_t)16 * grp : (size_t)(128 + 8 * (grp - 7))) * MiB);
            const bool trans = (grp == 2) | (grp == 5) | (grp == 10) | (grp == 12);
            const bool norm = (grp == 3) | (grp == 4) | (grp == 6) | (grp == 9) | (grp == 11);
            const float qs = ((grp == 0) | (grp == 3) | (grp == 6)) ? 0.125f * L2E : 1.0f;
            const float* nw = grp == 3 ? mqn : (grp == 4 ? mkn : (grp == 6 ? nqn : (grp == 9 ? nkn + 64 : nkn + 128)));
#pragma unroll
            for (int ai = 0; ai < 2; ++ai)
#pragma unroll
                for (int m = 0; m < 4; ++m) { const int row = u.pm * 256 + 128 * ai + 64 * wr + 16 * m + fr; const int b = row >> 13, s = row & 8191;
                    float v[2][8];
#pragma unroll
                    for (int bj = 0; bj < 2; ++bj)
#pragma unroll
                        for (int n = 0; n < 2; ++n)
#pragma unroll
                            for (int e = 0; e < 4; ++e) v[bj][4 * n + e] = acc[ai][bj][m][n][e];
                    float sc = qs;
                    if (norm) { float ss = 0.f;
#pragma unroll
                        for (int bj = 0; bj < 2; ++bj)
#pragma unroll
                            for (int j = 0; j < 8; ++j) ss += v[bj][j] * v[bj][j];
                        ss += __shfl_xor(ss, 16); ss += __shfl_xor(ss, 32);
                        sc = qs * __builtin_amdgcn_rsqf(ss * (1.0f / 64.0f) + 1e-6f);
#pragma unroll
                        for (int bj = 0; bj < 2; ++bj) { const f32x4 w0 = *(const f32x4*)(nw + 32 * bj + 8 * fq), w1 = *(const f32x4*)(nw + 32 * bj + 8 * fq + 4);
#pragma unroll
                            for (int e = 0; e < 4; ++e) { v[bj][e] *= w0[e]; v[bj][4 + e] *= w1[e]; } } }
                    if (!trans) {
#pragma unroll
                        for (int bj = 0; bj < 2; ++bj) { u32x4 w; w.x = pk2(v[bj][0] * sc, v[bj][1] * sc); w.y = pk2(v[bj][2] * sc, v[bj][3] * sc); w.z = pk2(v[bj][4] * sc, v[bj][5] * sc); w.w = pk2(v[bj][6] * sc, v[bj][7] * sc);
                            *(u32x4*)(base + (unsigned)(((b * H + hh) * SEQ + s) * 64 + 32 * bj + 8 * fq)) = w; }
                    } else {
#pragma unroll
                        for (int bj = 0; bj < 2; ++bj)
#pragma unroll
                            for (int j = 0; j < 8; j += 2) { const unsigned w = pk2(v[bj][j], v[bj][j + 1]); bf16_t* d = base + (unsigned)(((b * H + hh) * 64 + 32 * bj + 8 * fq + j) * SEQ + s);
                                d[0] = (bf16_t)(w & 0xffffu); d[SEQ] = (bf16_t)(w >> 16); }
                    } }
        } else if (t == 11) {
            if (wc == 0 && fq < 3) {
#pragma unroll
                for (int ai = 0; ai < 2; ++ai)
#pragma unroll
                    for (int m = 0; m < 4; ++m) { const unsigned row = (unsigned)(u.pm * 256 + 128 * ai + 64 * wr + 16 * m + fr);
#pragma unroll
                        for (int n = 0; n < 2; ++n) { f32x4 y;
#pragma unroll
                            for (int e = 0; e < 4; ++e) y[e] = sigmoidf_(acc[ai][0][m][n][e]);
                            *(f32x4*)(nsg + (row * 24u + (unsigned)(8 * fq + 4 * n))) = y; } }
            }
        } else {
#pragma unroll
            for (int ai = 0; ai < 2; ++ai)
#pragma unroll
                for (int m = 0; m < 4; ++m) { const unsigned row = (unsigned)(u.pm * 256 + 128 * ai + 64 * wr + 16 * m + fr);
#pragma unroll
                    for (int bj = 0; bj < 2; ++bj) { const f32x4 a0 = acc[ai][bj][m][0], a1 = acc[ai][bj][m][1]; u32x2 w;
                        w.x = gq8(a0[0]) | (gq8(a0[1]) << 8) | (gq8(a0[2]) << 16) | (gq8(a0[3]) << 24);
                        w.y = gq8(a1[0]) | (gq8(a1[1]) << 8) | (gq8(a1[2]) << 16) | (gq8(a1[3]) << 24);
                        *(u32x2*)((unsigned char*)brg + (row * 3072u + (unsigned)((t - 12) * 256 + 64 * wc + 32 * bj + 8 * fq))) = w; } }
        }
    }
};

template <int MAP> __device__ __forceinline__ void prep_w(const float* __restrict__ W, int K, int ldw, bf16_t* __restrict__ Bt, int Np, int ldb, LAS unsigned char* lds, int tid, int bx, int G) {
    const int ntp = Np >> 6, ntiles = ntp * (K >> 6), w = tid >> 6, lane = tid & 63;
    float v[8];
    int tile = bx;
    if (tile < ntiles) { const int tk = tile / ntp, tp = tile - tk * ntp; const int col = mapcol<MAP>(tp * 64 + lane); const float* s = W + (size_t)(tk * 64 + 8 * w) * ldw + (col < 0 ? 0 : col);
#pragma unroll
        for (int i = 0; i < 8; ++i) v[i] = col >= 0 ? s[(size_t)i * ldw] : 0.f; }
    for (; tile < ntiles; tile += G) {
        const int tk = tile / ntp, tp = tile - tk * ntp;
        u32x4 pw; pw.x = pk2(v[0], v[1]); pw.y = pk2(v[2], v[3]); pw.z = pk2(v[4], v[5]); pw.w = pk2(v[6], v[7]);
        *(LAS u32x4*)(lds + lane * 144 + w * 16) = pw;
        __syncthreads();
        const int nx = tile + G;
        if (nx < ntiles) { const int tk2 = nx / ntp, tp2 = nx - tk2 * ntp; const int col = mapcol<MAP>(tp2 * 64 + lane); const float* s = W + (size_t)(tk2 * 64 + 8 * w) * ldw + (col < 0 ? 0 : col);
#pragma unroll
            for (int i = 0; i < 8; ++i) v[i] = col >= 0 ? s[(size_t)i * ldw] : 0.f; }
        { const int p = tid >> 3, pc = tid & 7; const u32x4 o = *(LAS const u32x4*)(lds + p * 144 + pc * 16);
            *(u32x4*)(Bt + (size_t)(tp * 64 + p) * ldb + tk * 64 + pc * 8) = o; }
        __syncthreads();
    }
}
__device__ __forceinline__ void rmsnorm_rows(const float* __restrict__ x, const float* __restrict__ g, bf16_t* __restrict__ h, int gwave, int nwaves, int lane) {
    for (int row = gwave; row < MTOK; row += nwaves) {
        const f32x4* xr = (const f32x4*)(x + (size_t)row * DM); f32x4 v[4]; float ss = 0.f;
#pragma unroll
        for (int i = 0; i < 4; ++i) { v[i] = xr[lane + 64 * i]; ss += v[i][0] * v[i][0] + v[i][1] * v[i][1] + v[i][2] * v[i][2] + v[i][3] * v[i][3]; }
        ss = wave_sum(ss); const float rs = __builtin_amdgcn_rsqf(ss * (1.0f / DM) + 1e-6f);
#pragma unroll
        for (int i = 0; i < 4; ++i) { const f32x4 gv = ((const f32x4*)g)[lane + 64 * i]; u32x2 w; w.x = pk2(v[i][0] * rs * gv[0], v[i][1] * rs * gv[1]); w.y = pk2(v[i][2] * rs * gv[2], v[i][3] * rs * gv[3]);
            *(u32x2*)(h + (size_t)row * DM + (lane + 64 * i) * 4) = w; }
    }
}

#define MFMA32(a, b, c) __builtin_amdgcn_mfma_f32_32x32x16_bf16((a), (b), (c), 0, 0, 0)
__device__ __forceinline__ void stage_ld(const bf16_t* K, const bf16_t* Vt, int ldvt, int key0, int tid, u32x4& rk, u32x4& rv) {
    const int row = tid >> 3, pc = tid & 7;
    rk = *(const u32x4*)(K + (size_t)(key0 + row) * 64 + pc * 8);
    rv = *(const u32x4*)(Vt + (size_t)row * ldvt + key0 + pc * 8);
}
__device__ __forceinline__ void stage_st(LAS unsigned char* lds, int buf, int tid, const u32x4& rk, const u32x4& rv) {
    const int row = tid >> 3, pc = tid & 7; LAS unsigned char* p = lds + buf * 18432 + row * 144 + pc * 16;
    *(LAS u32x4*)p = rk; *(LAS u32x4*)(p + 9216) = rv;
}
__device__ __forceinline__ void load_q(const bf16_t* qrow, int h, bf16x8 (&qf)[4]) {
#pragma unroll
    for (int kk = 0; kk < 4; ++kk) qf[kk] = *(const bf16x8*)(qrow + 16 * kk + 8 * h);
}
__device__ __forceinline__ f32x16 qk_sub(LAS const unsigned char* ks, int sub, const bf16x8 (&qf)[4], int r, int h, float init = 0.f) {
    const int pr = (r & 0x13) | ((r & 4) << 1) | ((r & 8) >> 1);
    LAS const unsigned char* p = ks + (32 * sub + pr) * 144 + h * 16;
    f32x16 st;
#pragma unroll
    for (int i = 0; i < 16; ++i) st[i] = init;
#pragma unroll
    for (int kk = 0; kk < 4; ++kk) { const bf16x8 kf = *(LAS const bf16x8*)(p + kk * 32); st = MFMA32(kf, qf[kk], st); }
    return st;
}
__device__ __forceinline__ void pv_sub(LAS const unsigned char* vs, int sub, const f32x16& p, f32x16 (&ot)[2], int r, int h) {
#pragma unroll
    for (int j = 0; j < 2; ++j) {
        u32x4 w; w.x = pk2(p[8 * j], p[8 * j + 1]); w.y = pk2(p[8 * j + 2], p[8 * j + 3]); w.z = pk2(p[8 * j + 4], p[8 * j + 5]); w.w = pk2(p[8 * j + 6], p[8 * j + 7]);
        const bf16x8 pf = __builtin_bit_cast(bf16x8, w);
#pragma unroll
        for (int mt = 0; mt < 2; ++mt) { const bf16x8 vf = *(LAS const bf16x8*)(vs + (32 * mt + r) * 144 + (32 * sub + 16 * j + 8 * h) * 2); ot[mt] = MFMA32(vf, pf, ot[mt]); }
    }
}
constexpr int BT_N = 288, BT_FAR = 64 + 223;
template <int MODE> __device__ __forceinline__ void soft_sub(f32x16& st, float& lsum, bool lane_valid, int dist0, int dmax, LAS const float* bt) {
    if (MODE == 0) {
#pragma unroll
        for (int i = 0; i < 16; ++i) { const float p = ex2(st[i]); lsum += p; st[i] = p; }
    } else if (MODE == 2) {
        const float cf = lane_valid ? bt[BT_FAR] : -3.0e38f;
#pragma unroll
        for (int i = 0; i < 16; ++i) { const int dist = dist0 - (16 * (i >> 3) + (i & 7)); const float b = dist < dmax ? cf : -3.0e38f;
            const float p = ex2(st[i] + b); lsum += p; st[i] = p; }
    } else if (MODE == 1) {
        float bb[16];
#pragma unroll
        for (int j = 0; j < 2; ++j) { int db = dist0 - 16 * j; db = db < -57 ? -57 : (db > 223 ? 223 : db); if (!lane_valid) db = -57;
            LAS const float* p = bt + (db + 64);
#pragma unroll
            for (int k = 0; k < 8; ++k) bb[8 * j + k] = p[-k]; }
#pragma unroll
        for (int i = 0; i < 16; ++i) { const float p = ex2(st[i] + bb[i]); lsum += p; st[i] = p; }
    } else {
        float bb[16];
#pragma unroll
        for (int i = 0; i < 16; ++i) { int d = dist0 - 16 * (16 * (i >> 3) + (i & 7)); d = d < -64 ? -64 : (d > 223 ? 223 : d); bb[i] = bt[d + 64]; }
#pragma unroll
        for (int i = 0; i < 16; ++i) { const float p = ex2(st[i] + bb[i]); lsum += p; st[i] = p; }
    }
}
__device__ __forceinline__ bf16x8 pack_p(const f32x16& p, int j) {
    u32x4 w; w.x = pk2(p[8 * j], p[8 * j + 1]); w.y = pk2(p[8 * j + 2], p[8 * j + 3]); w.z = pk2(p[8 * j + 4], p[8 * j + 5]); w.w = pk2(p[8 * j + 6], p[8 * j + 7]);
    return __builtin_bit_cast(bf16x8, w);
}
template <int MODE> __device__ __forceinline__ void tile_soft_gen(LAS const unsigned char* ks, LAS const unsigned char* vs, const bf16x8 (&qf)[4], f32x16 (&ot)[2], float& lsum,
                                                              bool lane_valid, int dist00, int dmax, LAS const float* bt, int r, int h) {
    const float init = MODE == 0 ? (lane_valid ? bt[BT_FAR] : -3.0e38f) : 0.f;
    const int pr = (r & 0x13) | ((r & 4) << 1) | ((r & 8) >> 1);
    LAS const unsigned char* kp = ks + pr * 144 + h * 16; LAS const unsigned char* vp = vs + r * 144 + h * 16;
    bf16x8 k0[4], k1[4], v0[2][2], v1[2][2];
#pragma unroll
    for (int kk = 0; kk < 4; ++kk) { k0[kk] = *(LAS const bf16x8*)(kp + kk * 32); k1[kk] = *(LAS const bf16x8*)(kp + 32 * 144 + kk * 32); }
    __builtin_amdgcn_sched_barrier(0);
    f32x16 s0, s1;
#pragma unroll
    for (int i = 0; i < 16; ++i) { s0[i] = init; s1[i] = init; }
#pragma unroll
    for (int kk = 0; kk < 4; ++kk) s0 = MFMA32(k0[kk], qf[kk], s0);
#pragma unroll
    for (int mt = 0; mt < 2; ++mt)
#pragma unroll
        for (int j = 0; j < 2; ++j) v0[mt][j] = *(LAS const bf16x8*)(vp + 32 * mt * 144 + 32 * j);
    __builtin_amdgcn_sched_barrier(0);
#pragma unroll
    for (int kk = 0; kk < 4; ++kk) s1 = MFMA32(k1[kk], qf[kk], s1);
#pragma unroll
    for (int mt = 0; mt < 2; ++mt)
#pragma unroll
        for (int j = 0; j < 2; ++j) v1[mt][j] = *(LAS const bf16x8*)(vp + 32 * mt * 144 + 64 + 32 * j);
    soft_sub<MODE>(s0, lsum, lane_valid, dist00, dmax, bt);
    __builtin_amdgcn_sched_barrier(0);
#pragma unroll
    for (int j = 0; j < 2; ++j) { const bf16x8 pf = pack_p(s0, j); ot[0] = MFMA32(v0[0][j], pf, ot[0]); ot[1] = MFMA32(v0[1][j], pf, ot[1]); }
    soft_sub<MODE>(s1, lsum, lane_valid, dist00 - (MODE == 3 ? 512 : 32), dmax, bt);
    __builtin_amdgcn_sched_barrier(0);
#pragma unroll
    for (int j = 0; j < 2; ++j) { const bf16x8 pf = pack_p(s1, j); ot[0] = MFMA32(v1[0][j], pf, ot[0]); ot[1] = MFMA32(v1[1][j], pf, ot[1]); }
}
#define SOFT4(st_, i0_) { _Pragma("unroll") for (int i_ = (i0_); i_ < (i0_) + 4; ++i_) { const float p_ = ex2(st_[i_]); lsum += p_; st_[i_] = p_; } }
__device__ __forceinline__ void tile_soft_far(LAS const unsigned char* ks, LAS const unsigned char* vs, const bf16x8 (&qf)[4], f32x16 (&ot)[2], float& lsum, bool lane_valid, LAS const float* bt, int r, int h) {
    const float init = lane_valid ? bt[BT_FAR] : -3.0e38f;
    const int pr = (r & 0x13) | ((r & 4) << 1) | ((r & 8) >> 1);
    LAS const unsigned char* kp = ks + pr * 144 + h * 16; LAS const unsigned char* vp = vs + r * 144 + h * 16;
    bf16x8 k0[4], k1[4], v0[2][2], v1[2][2];
#pragma unroll
    for (int kk = 0; kk < 4; ++kk) { k0[kk] = *(LAS const bf16x8*)(kp + kk * 32); k1[kk] = *(LAS const bf16x8*)(kp + 32 * 144 + kk * 32); }
    __builtin_amdgcn_sched_barrier(0);
    f32x16 s0, s1;
#pragma unroll
    for (int i = 0; i < 16; ++i) { s0[i] = init; s1[i] = init; }
#pragma unroll
    for (int kk = 0; kk < 4; ++kk) s0 = MFMA32(k0[kk], qf[kk], s0);
#pragma unroll
    for (int mt = 0; mt < 2; ++mt)
#pragma unroll
        for (int j = 0; j < 2; ++j) { v0[mt][j] = *(LAS const bf16x8*)(vp + 32 * mt * 144 + 32 * j); v1[mt][j] = *(LAS const bf16x8*)(vp + 32 * mt * 144 + 64 + 32 * j); }
    __builtin_amdgcn_sched_barrier(0);
    s1 = MFMA32(k1[0], qf[0], s1); SOFT4(s0, 0);  __builtin_amdgcn_sched_barrier(0);
    s1 = MFMA32(k1[1], qf[1], s1); SOFT4(s0, 4);  __builtin_amdgcn_sched_barrier(0);
    s1 = MFMA32(k1[2], qf[2], s1); SOFT4(s0, 8);  __builtin_amdgcn_sched_barrier(0);
    s1 = MFMA32(k1[3], qf[3], s1); SOFT4(s0, 12); __builtin_amdgcn_sched_barrier(0);
    const bf16x8 pa = pack_p(s0, 0);
    ot[0] = MFMA32(v0[0][0], pa, ot[0]); SOFT4(s1, 0);  __builtin_amdgcn_sched_barrier(0);
    ot[1] = MFMA32(v0[1][0], pa, ot[1]); SOFT4(s1, 4);  const bf16x8 pb = pack_p(s0, 1); __builtin_amdgcn_sched_barrier(0);
    ot[0] = MFMA32(v0[0][1], pb, ot[0]); SOFT4(s1, 8);  __builtin_amdgcn_sched_barrier(0);
    ot[1] = MFMA32(v0[1][1], pb, ot[1]); SOFT4(s1, 12); __builtin_amdgcn_sched_barrier(0);
#pragma unroll
    for (int j = 0; j < 2; ++j) { const bf16x8 pf = pack_p(s1, j); ot[0] = MFMA32(v1[0][j], pf, ot[0]); ot[1] = MFMA32(v1[1][j], pf, ot[1]); }
}
template <int MODE> __device__ __forceinline__ void tile_soft(LAS const unsigned char* ks, LAS const unsigned char* vs, const bf16x8 (&qf)[4], f32x16 (&ot)[2], float& lsum,
                                                              bool lane_valid, int dist00, int dmax, LAS const float* bt, int r, int h) {
    if (MODE == 0) tile_soft_far(ks, vs, qf, ot, lsum, lane_valid, bt, r, h);
    else tile_soft_gen<MODE>(ks, vs, qf, ot, lsum, lane_valid, dist00, dmax, bt, r, h);
}
__device__ __forceinline__ void zero_ot(f32x16 (&ot)[2]) {
#pragma unroll
    for (int i = 0; i < 16; ++i) { ot[0][i] = 0.f; ot[1][i] = 0.f; }
}
__device__ __forceinline__ void store_ot(bf16_t* orow, const f32x16 (&ot)[2], int h) {
#pragma unroll
    for (int mt = 0; mt < 2; ++mt)
#pragma unroll
        for (int g = 0; g < 4; ++g) { u32x2 w; w.x = pk2(ot[mt][4 * g], ot[mt][4 * g + 1]); w.y = pk2(ot[mt][4 * g + 2], ot[mt][4 * g + 3]);
            *(u32x2*)(orow + 32 * mt + 8 * g + 4 * h) = w; }
}

#define TILE_LOOP(KP, VP, LDV, KEY_FIRST, NT, BODY) do { \
    int key0 = (KEY_FIRST); const int nt_ = (NT); u32x4 rkA_, rvA_, rkB_, rvB_; \
    __syncthreads(); \
    stage_ld((KP), (VP), (LDV), key0, tid, rkA_, rvA_); stage_st(lds, 0, tid, rkA_, rvA_); \
    if (nt_ > 1) stage_ld((KP), (VP), (LDV), key0 + 64, tid, rkA_, rvA_); \
    __syncthreads(); \
    for (int it_ = 0; it_ < nt_; ++it_) { const int buf_ = it_ & 1; \
        if (it_ + 2 < nt_) stage_ld((KP), (VP), (LDV), key0 + 128, tid, rkB_, rvB_); \
        { LAS const unsigned char* ks = lds + buf_ * 18432; LAS const unsigned char* vs = ks + 9216; BODY } \
        if (it_ + 1 < nt_) stage_st(lds, buf_ ^ 1, tid, rkA_, rvA_); \
        __syncthreads(); key0 += 64; rkA_ = rkB_; rvA_ = rvB_; } } while (0)

__device__ __forceinline__ void sb_sub(LAS const unsigned char* vs, int sb, f32x16& st, f32x16 (&ot)[2], float& C, int key0, int t, int r, int h) {
    float ls[16]; float Rlo = 0.f, Rhi = 0.f;
#pragma unroll
    for (int i = 0; i < 16; ++i) { const int s = key0 + 32 * sb + 16 * (i >> 3) + 8 * h + (i & 7); const bool causal = s < t;
        const float u = st[i]; const float sp = fmaxf(u, 0.f) + lg2(1.0f + ex2(-fabsf(u)));
        ls[i] = causal ? -sp : 0.f; st[i] = causal ? (u - sp) : -3.0e38f;
        if (i < 8) Rlo += ls[i]; else Rhi += ls[i]; }
    const float Plo = __shfl_xor(Rlo, 32), Phi = __shfl_xor(Rhi, 32);
    float la = C + (h == 0 ? Phi : 0.f);
#pragma unroll
    for (int i = 15; i >= 8; --i) { const float a = ex2(st[i] + la); la += ls[i]; st[i] = a; }
    la = C + Rhi + Phi + (h == 0 ? Plo : 0.f);
#pragma unroll
    for (int i = 7; i >= 0; --i) { const float a = ex2(st[i] + la); la += ls[i]; st[i] = a; }
    C += (Rlo + Rhi) + (Plo + Phi);
    pv_sub(vs, sb, st, ot, r, h);
}
__device__ __forceinline__ void sb_unit(LAS unsigned char* lds, const unsigned char* hb, bf16_t* omix, int b, int hd, int qblk, int tid) {
    const int lane = tid & 63, w = tid >> 6, r = lane & 31, h = lane >> 5;
    const int bh = b * 4 + hd, q0 = qblk * 256, t = q0 + 32 * w + r;
    const bf16_t* Q = (const bf16_t*)(hb + HB_SBQ * MiB) + ((size_t)bh * SEQ + t) * 64;
    const bf16_t* K = (const bf16_t*)(hb + HB_SBK * MiB) + (size_t)bh * SEQ * 64;
    const bf16_t* Vt = (const bf16_t*)(hb + HB_SBVT * MiB) + (size_t)bh * 64 * SEQ;
    bf16x8 qf[4]; load_q(Q, h, qf);
    f32x16 ot[2]; zero_ot(ot);
    float C = 0.f;
    int key0 = q0 + 192; u32x4 rkA_, rvA_, rkB_, rvB_;
    __syncthreads();
    stage_ld(K, Vt, SEQ, key0, tid, rkA_, rvA_); stage_st(lds, 0, tid, rkA_, rvA_);
    if (key0 >= 64) stage_ld(K, Vt, SEQ, key0 - 64, tid, rkA_, rvA_);
    __syncthreads();
    int buf = 0;
    for (;;) {
        const bool has_next = key0 >= 64;
        if (key0 >= 128) stage_ld(K, Vt, SEQ, key0 - 128, tid, rkB_, rvB_);
        if (key0 <= q0 + 32 * w + 31) {
            LAS const unsigned char* ks = lds + buf * 18432; LAS const unsigned char* vs = ks + 9216;
            f32x16 s1 = qk_sub(ks, 1, qf, r, h); f32x16 s0 = qk_sub(ks, 0, qf, r, h);
            if (key0 + 32 <= q0 + 32 * w + 31) sb_sub(vs, 1, s1, ot, C, key0, t, r, h);
            sb_sub(vs, 0, s0, ot, C, key0, t, r, h);
        }
        const int alive = __syncthreads_or(C > -150.0f ? 1 : 0);
        if (!(has_next && alive)) break;
        stage_st(lds, buf ^ 1, tid, rkA_, rvA_);
        __syncthreads(); buf ^= 1; key0 -= 64; rkA_ = rkB_; rvA_ = rvB_;
    }
    store_ot(omix + ((size_t)b * SEQ + t) * DM + hd * 64, ot, h);
}

__device__ __forceinline__ void moba_unit(LAS unsigned char* lds, const unsigned char* hb, const float* kmean, bf16_t* omix, int b, int hd, int blk, int tid) {
    const int lane = tid & 63, w = tid >> 6, r = lane & 31, h = lane >> 5;
    const int bh = b * 4 + hd, q0 = blk * 256, t = q0 + 32 * w + r;
    const bf16_t* Qb = (const bf16_t*)(hb + HB_MBQ * MiB) + ((size_t)bh * SEQ + q0) * 64;
    const bf16_t* K = (const bf16_t*)(hb + HB_MBK * MiB) + (size_t)bh * SEQ * 64;
    const bf16_t* Vt = (const bf16_t*)(hb + HB_MBVT * MiB) + (size_t)bh * 64 * SEQ;
    LAS unsigned* misc = (LAS unsigned*)(lds + ATT_MISC); LAS unsigned* selm = (LAS unsigned*)(lds + ATT_SEL);
    LAS float* km = (LAS float*)(lds + ATT_X); LAS float* sc = km + 32 * 64;
    LAS const float* bt = (LAS const float*)(lds + ATT_BT) + hd * BT_N;
    __syncthreads();
    if (tid == 0) misc[1] = 0u;
    if (blk > 3) {
        for (int i = tid; i < blk * 64; i += 512) km[i] = kmean[(size_t)bh * 32 * 64 + i];
        __syncthreads();
        { const int qi = tid & 255, part = tid >> 8; float q[64];
            const u32x4* qp = (const u32x4*)(Qb + (size_t)qi * 64);
#pragma unroll
            for (int c = 0; c < 8; ++c) { const u32x4 v = qp[c]; q[8 * c] = bflo(v.x); q[8 * c + 1] = bfhi(v.x); q[8 * c + 2] = bflo(v.y); q[8 * c + 3] = bfhi(v.y); q[8 * c + 4] = bflo(v.z); q[8 * c + 5] = bfhi(v.z); q[8 * c + 6] = bflo(v.w); q[8 * c + 7] = bfhi(v.w); }
            for (int n = part; n < blk; n += 2) { float a = 0.f;
#pragma unroll
                for (int d = 0; d < 64; ++d) a = fmaf(q[d], km[n * 64 + d], a);
                sc[qi * 33 + n] = a; } }
        __syncthreads();
        if (tid < 256) { unsigned m = 0u; float sv[32];
#pragma unroll
            for (int n = 0; n < 32; ++n) sv[n] = n < blk ? sc[tid * 33 + n] : -3.0e38f;
#pragma unroll
            for (int k = 0; k < 3; ++k) { float best = -3.0e38f; int bi = 0;
#pragma unroll
                for (int n = 0; n < 32; ++n) { const bool take = !((m >> n) & 1u) && sv[n] > best; best = take ? sv[n] : best; bi = take ? n : bi; }
                m |= 1u << bi; }
            selm[tid] = m; atomicOr((unsigned*)&misc[1], m); }
    } else {
        const unsigned m = (1u << blk) - 1u; if (tid < 256) selm[tid] = m; if (tid == 0) misc[1] = m;
    }
    __syncthreads();
    const unsigned uni = misc[1], sel = selm[32 * w + r];
    bf16x8 qf[4]; load_q(Qb + (size_t)(32 * w + r) * 64, h, qf);
    f32x16 ot[2]; zero_ot(ot); float lsum = 0.f;
    const int kend = q0 + 256;
#define MOBA_NEXT(k_, out_) do { int kk_ = (k_) + 64; while (kk_ < q0 && !((uni >> (kk_ >> 8)) & 1u)) kk_ = (kk_ | 255) + 1; (out_) = kk_; } while (0)
    int key0, knext, knext2; MOBA_NEXT(-64, key0); MOBA_NEXT(key0, knext);
    u32x4 rkA_, rvA_, rkB_, rvB_;
    stage_ld(K, Vt, SEQ, key0, tid, rkA_, rvA_); stage_st(lds, 0, tid, rkA_, rvA_);
    if (knext < kend) stage_ld(K, Vt, SEQ, knext, tid, rkA_, rvA_);
    __syncthreads();
    int buf = 0;
    while (key0 < kend) {
        MOBA_NEXT(knext, knext2);
        if (knext < kend && knext2 < kend) stage_ld(K, Vt, SEQ, knext2, tid, rkB_, rvB_);
        {
            LAS const unsigned char* ks = lds + buf * 18432; LAS const unsigned char* vs = ks + 9216;
            const int n = key0 >> 8; const bool own = (n == blk);
            const bool lane_valid = own ? true : (((sel >> n) & 1u) != 0u);
            const bool skip = own ? (key0 > q0 + 32 * w + 31) : (__ballot(lane_valid) == 0ull);
            if (!skip) {
                const bool near = (q0 + 32 * w) - (key0 + 63) < 128;
                const int dist00 = t - (key0 + 8 * h);
                if (near) tile_soft<1>(ks, vs, qf, ot, lsum, lane_valid, dist00, 0, bt, r, h);
                else tile_soft<0>(ks, vs, qf, ot, lsum, lane_valid, dist00, 0, bt, r, h);
            }
        }
        if (knext < kend) stage_st(lds, buf ^ 1, tid, rkA_, rvA_);
        __syncthreads(); buf ^= 1; key0 = knext; knext = knext2; rkA_ = rkB_; rvA_ = rvB_;
    }
#undef MOBA_NEXT
    const float l = lsum + __shfl_xor(lsum, 32); const float inv = 1.0f / fmaxf(l, 1e-30f);
#pragma unroll
    for (int i = 0; i < 16; ++i) { ot[0][i] *= inv; ot[1][i] *= inv; }
    store_ot(omix + ((size_t)b * SEQ + t) * DM + 256 + hd * 64, ot, h);
}

__device__ __forceinline__ void imp_sub(f32x16& st, float invc, int nbase, LAS float* improw, int r) {
#pragma unroll
    for (int j = 0; j < 2; ++j) { const int a = (nbase + 16 * j) >> 3;
        float s0 = ((st[8 * j] + st[8 * j + 1]) + (st[8 * j + 2] + st[8 * j + 3])) * invc;
        float s1 = ((st[8 * j + 3] + st[8 * j + 4]) + (st[8 * j + 5] + st[8 * j + 6]) + st[8 * j + 7]) * invc;
        float s2 = st[8 * j + 7] * invc;
        s0 += __shfl_xor(s0, 8); s0 += __shfl_xor(s0, 16); s1 += __shfl_xor(s1, 8); s1 += __shfl_xor(s1, 16); s2 += __shfl_xor(s2, 8); s2 += __shfl_xor(s2, 16);
        if (r < 8) { LAS float* ip = improw + 2 * a; ip[0] += s0; ip[1] += s1; if (2 * a + 2 < 128) ip[2] += s2; } }
}
__device__ __forceinline__ void nsa_unit(LAS unsigned char* lds, const unsigned char* hb, const bf16_t* kc, const bf16_t* vct, const float* nsg, bf16_t* omix, int b, int g, int c, int tid) {
    const int lane = tid & 63, w = tid >> 6, r = lane & 31, h = lane >> 5;
    const int bg = b * 2 + g, q0 = c * 64, ql = 8 * w + (r & 7), t = q0 + ql, hq = 4 * g + (r >> 3);
    const bf16_t* Q = (const bf16_t*)(hb + HB_NSQ * MiB) + ((size_t)(b * 8 + hq) * SEQ + t) * 64;
    LAS unsigned* selm = (LAS unsigned*)(lds + ATT_SEL); LAS float* imp = (LAS float*)(lds + ATT_X);
    LAS const float* bt = (LAS const float*)(lds + ATT_BT) + (4 + hq) * BT_N;
    const float* gate = nsg + ((size_t)b * SEQ + t) * 24 + hq;
    bf16x8 qf[4]; load_q(Q, h, qf);
    f32x16 ot[2]; zero_ot(ot);
    LAS unsigned* oal = (LAS unsigned*)(lds + ATT_OA) + (w * 16) * 64 + lane;
    const bf16_t* Kc = kc + (size_t)bg * 512 * 64; const bf16_t* Vc = vct + (size_t)bg * 64 * 512;
    const int ntc = (4 * c + 3 + 63) >> 6;
    float lsum = 0.f;
    TILE_LOOP(Kc, Vc, 512, 0, ntc, {
        tile_soft<3>(ks, vs, qf, ot, lsum, true, t - 31 - 16 * (key0 + 8 * h), 0, bt, r, h); });
    const float lc = lsum + __shfl_xor(lsum, 32); const float invc = 1.0f / fmaxf(lc, 1e-30f);
    { const float gc = gate[0] * invc;
#pragma unroll
        for (int i = 0; i < 8; ++i) { oal[i * 64] = pk2(ot[0][2 * i] * gc, ot[0][2 * i + 1] * gc); oal[(8 + i) * 64] = pk2(ot[1][2 * i] * gc, ot[1][2 * i + 1] * gc); } }
    for (int i = tid; i < 64 * 129; i += 512) imp[i] = 0.f;
    if (tid < 256) selm[tid] = 0u;
    TILE_LOOP(Kc, Vc, 512, 0, ntc, {
        f32x16 s0 = qk_sub(ks, 0, qf, r, h); f32x16 s1 = qk_sub(ks, 1, qf, r, h); float dummy = 0.f;
        const int dist00 = t - 31 - 16 * (key0 + 8 * h);
        soft_sub<3>(s0, dummy, true, dist00, 0, bt); imp_sub(s0, invc, key0 + 8 * h, imp + ql * 129, r);
        soft_sub<3>(s1, dummy, true, dist00 - 512, 0, bt); imp_sub(s1, invc, key0 + 32 + 8 * h, imp + ql * 129, r); });
    { const int qi = tid >> 3, sub = tid & 7;
        if (c >= 16) {
            { LAS const float* row = imp + qi * 129; unsigned long long kv[16]; int cnt[16];
#pragma unroll
                for (int k = 0; k < 16; ++k) { const int m = 1 + sub + 8 * k; const int mi = m <= 128 ? m : 128; kv[k] = ((unsigned long long)__float_as_uint(row[mi]) << 8) | (unsigned long long)(255 - m); cnt[k] = 0; }
                for (int m2 = 1; m2 <= c - 2; m2 += 8) { unsigned long long kx[8];
#pragma unroll
                    for (int j = 0; j < 8; ++j) { const int mm = m2 + j; const int mi = mm <= 128 ? mm : 128; const float x = row[mi]; kx[j] = mm <= c - 2 ? (((unsigned long long)__float_as_uint(x) << 8) | (unsigned long long)(255 - mm)) : 0ull; }
#pragma unroll
                    for (int j = 0; j < 8; ++j)
#pragma unroll
                        for (int k = 0; k < 16; ++k) cnt[k] += kx[j] > kv[k] ? 1 : 0; }
#pragma unroll
                for (int k = 0; k < 16; ++k) { const int m = 1 + sub + 8 * k; if (m <= c - 2 && cnt[k] < 13) atomicOr((unsigned*)&selm[qi * 4 + (m >> 5)], 1u << (m & 31)); } }
            if (sub == 0) { atomicOr((unsigned*)&selm[qi * 4], 1u); atomicOr((unsigned*)&selm[qi * 4 + ((c - 1) >> 5)], 1u << ((c - 1) & 31)); atomicOr((unsigned*)&selm[qi * 4 + (c >> 5)], 1u << (c & 31)); }
        } else if (sub == 0) selm[qi * 4] = (1u << (c + 1)) - 1u;
    }
    __syncthreads();
    const unsigned sel0 = selm[ql * 4], sel1 = selm[ql * 4 + 1], sel2 = selm[ql * 4 + 2], sel3 = selm[ql * 4 + 3];
    { const bf16_t* Ks = (const bf16_t*)(hb + HB_KS * MiB) + (size_t)bg * SEQ * 64; const bf16_t* Vs = (const bf16_t*)(hb + HB_VST * MiB) + (size_t)bg * 64 * SEQ;
        zero_ot(ot); lsum = 0.f;
        TILE_LOOP(Ks, Vs, SEQ, 0, c + 1, {
            const int m = key0 >> 6; const unsigned sw = m < 32 ? sel0 : (m < 64 ? sel1 : (m < 96 ? sel2 : sel3));
            const bool lane_valid = ((sw >> (m & 31)) & 1u) != 0u;
            if (__ballot(lane_valid) != 0ull) { const int dist00 = t - (key0 + 8 * h);
                if ((c - m) < 3) tile_soft<1>(ks, vs, qf, ot, lsum, lane_valid, dist00, 0, bt, r, h);
                else tile_soft<0>(ks, vs, qf, ot, lsum, lane_valid, dist00, 0, bt, r, h); } });
        const float l = lsum + __shfl_xor(lsum, 32); const float gs = gate[8] / fmaxf(l, 1e-30f);
#pragma unroll
        for (int i = 0; i < 8; ++i) { const unsigned a0 = oal[i * 64], a1 = oal[(8 + i) * 64];
            oal[i * 64] = pk2(bflo(a0) + ot[0][2 * i] * gs, bfhi(a0) + ot[0][2 * i + 1] * gs); oal[(8 + i) * 64] = pk2(bflo(a1) + ot[1][2 * i] * gs, bfhi(a1) + ot[1][2 * i + 1] * gs); } }
    { const bf16_t* Kw = (const bf16_t*)(hb + HB_KW * MiB) + (size_t)bg * SEQ * 64; const bf16_t* Vw = (const bf16_t*)(hb + HB_VWT * MiB) + (size_t)bg * 64 * SEQ;
        zero_ot(ot); lsum = 0.f;
        const int kfirst = q0 >= 512 ? q0 - 512 : 0; const int ntw = ((q0 - kfirst) >> 6) + 1;
        TILE_LOOP(Kw, Vw, SEQ, kfirst, ntw, {
            const int dist00 = t - (key0 + 8 * h);
            if (key0 >= q0 - 128) tile_soft<1>(ks, vs, qf, ot, lsum, true, dist00, 0, bt, r, h);
            else if (key0 == q0 - 512) tile_soft<2>(ks, vs, qf, ot, lsum, true, dist00, 512, bt, r, h);
            else tile_soft<0>(ks, vs, qf, ot, lsum, true, dist00, 0, bt, r, h); });
        const float l = lsum + __shfl_xor(lsum, 32); const float gw = gate[16] / fmaxf(l, 1e-30f);
#pragma unroll
        for (int i = 0; i < 8; ++i) { const unsigned a0 = oal[i * 64], a1 = oal[(8 + i) * 64];
            ot[0][2 * i] = bflo(a0) + ot[0][2 * i] * gw; ot[0][2 * i + 1] = bfhi(a0) + ot[0][2 * i + 1] * gw; ot[1][2 * i] = bflo(a1) + ot[1][2 * i] * gw; ot[1][2 * i + 1] = bfhi(a1) + ot[1][2 * i + 1] * gw; } }
    store_ot(omix + ((size_t)b * SEQ + t) * DM + 512 + hq * 64, ot, h);
}

constexpr int FG_STAGE = 55296, FG_B = 36864, FG_PATCH = 110592;
__device__ __forceinline__ void fg_ld(const bf16_t* A, const bf16_t* Bt, int kt, int tid, u32x4 (&ra)[4], u32x4 (&rb)[2]) {
#pragma unroll
    for (int i = 0; i < 4; ++i) { const unsigned p = (unsigned)(tid + 512 * i); ra[i] = *(const u32x4*)(A + 64 * kt + ((p >> 3) * 1024u + 8u * (p & 7u))); }
#pragma unroll
    for (int i = 0; i < 2; ++i) { const unsigned p = (unsigned)(tid + 512 * i); rb[i] = *(const u32x4*)(Bt + 64 * kt + ((p >> 3) * 1024u + 8u * (p & 7u))); }
}
__device__ __forceinline__ void fg_st(LAS unsigned char* st, int tid, const u32x4 (&ra)[4], const u32x4 (&rb)[2]) {
#pragma unroll
    for (int i = 0; i < 4; ++i) { const int p = tid + 512 * i; *(LAS u32x4*)(st + (p >> 3) * 144 + (p & 7) * 16) = ra[i]; }
#pragma unroll
    for (int i = 0; i < 2; ++i) { const int p = tid + 512 * i; *(LAS u32x4*)(st + FG_B + (p >> 3) * 144 + (p & 7) * 16) = rb[i]; }
}
__device__ __forceinline__ void branch_tile(LAS unsigned char* lds, const bf16_t* omix, const bf16_t* wbr, const bf16_t* brg, bf16_t* mix, int pm, int pn, int tid) {
    const int lane = tid & 63, w = tid >> 6, r = lane & 31, h = lane >> 5, wr = w >> 1, wc = w & 1;
    const bf16_t* A = omix + (size_t)pm * 256 * DM; const bf16_t* Bt = wbr + (size_t)pn * 128 * DM;
    LAS unsigned char* patch = lds + FG_PATCH + w * 2560;
    f32x16 seg[2][2]; unsigned tot[2][2][8];
#pragma unroll
    for (int a = 0; a < 2; ++a)
#pragma unroll
        for (int c = 0; c < 2; ++c)
#pragma unroll
            for (int i = 0; i < 16; ++i) { seg[a][c][i] = 0.f; tot[a][c][i >> 1] = 0u; }
    u32x4 ra0[4], rb0[2], ra1[4], rb1[2];
    __syncthreads();
    fg_ld(A, Bt, 0, tid, ra0, rb0); fg_st(lds, tid, ra0, rb0);
    fg_ld(A, Bt, 1, tid, ra1, rb1);
    __syncthreads();
#define FG_COMPUTE(BUF) { LAS const unsigned char* sa = lds + (BUF) * FG_STAGE + (64 * wr + r) * 144 + h * 16; LAS const unsigned char* sb = lds + (BUF) * FG_STAGE + FG_B + (64 * wc + r) * 144 + h * 16; \
        _Pragma("unroll") for (int kk = 0; kk < 4; ++kk) { const bf16x8 a0 = *(LAS const bf16x8*)(sa + kk * 32), a1 = *(LAS const bf16x8*)(sa + 32 * 144 + kk * 32); \
            const bf16x8 b0 = *(LAS const bf16x8*)(sb + kk * 32), b1 = *(LAS const bf16x8*)(sb + 32 * 144 + kk * 32); \
            seg[0][0] = MFMA32(a0, b0, seg[0][0]); seg[0][1] = MFMA32(a0, b1, seg[0][1]); seg[1][0] = MFMA32(a1, b0, seg[1][0]); seg[1][1] = MFMA32(a1, b1, seg[1][1]); } }
#define FG_BAR() do { asm volatile("s_waitcnt lgkmcnt(0)" ::: "memory"); __builtin_amdgcn_s_barrier(); asm volatile("" ::: "memory"); } while (0)
#pragma unroll 1
    for (int kt = 0; kt < 16; kt += 2) {
        fg_ld(A, Bt, (kt + 2 < 16 ? kt + 2 : 15), tid, ra0, rb0);
        FG_COMPUTE(0);
        fg_st(lds + FG_STAGE, tid, ra1, rb1);
        FG_BAR();
        fg_ld(A, Bt, (kt + 3 < 16 ? kt + 3 : 15), tid, ra1, rb1);
        const bool segend = (kt == 2) || (kt == 6) || (kt == 14);
        const int s = kt == 2 ? 0 : (kt == 6 ? 1 : 2);
        u32x4 g0, g1;
#define FG_GLD(dst, rt_, ct_) { dst = *(const u32x4*)((const unsigned char*)brg + ((unsigned)(pm * 256 + 64 * wr + 32 * (rt_) + (lane >> 1)) * 3072u + (unsigned)(1024 * s + pn * 128 + 64 * wc + 32 * (ct_) + 16 * (lane & 1)))); }
#define FG_GATE(src, rt_, ct_) { *(LAS u32x4*)(patch + (lane >> 1) * 48 + (lane & 1) * 16) = src; }
#define FG_ACC(rt_, ct_) { float gg[16]; \
            _Pragma("unroll") for (int i = 0; i < 16; ++i) { const int tr = 8 * (i >> 2) + 4 * h + (i & 3); gg[i] = (float)(*(LAS const unsigned char*)(patch + tr * 48 + r)) * (1.0f / 255.0f); } \
            _Pragma("unroll") for (int p2 = 0; p2 < 8; ++p2) { const unsigned tv = tot[rt_][ct_][p2]; \
                tot[rt_][ct_][p2] = pk2(fmaf(gg[2 * p2], seg[rt_][ct_][2 * p2], bflo(tv)), fmaf(gg[2 * p2 + 1], seg[rt_][ct_][2 * p2 + 1], bfhi(tv))); seg[rt_][ct_][2 * p2] = 0.f; seg[rt_][ct_][2 * p2 + 1] = 0.f; } }
        if (segend) { FG_GLD(g0, 0, 0); FG_GLD(g1, 0, 1); }
        FG_COMPUTE(1);
        if (segend) {
            FG_GATE(g0, 0, 0); FG_GLD(g0, 1, 0); FG_ACC(0, 0);
            FG_GATE(g1, 0, 1); FG_GLD(g1, 1, 1); FG_ACC(0, 1);
            FG_GATE(g0, 1, 0); FG_ACC(1, 0);
            FG_GATE(g1, 1, 1); FG_ACC(1, 1);
        }
#undef FG_GLD
#undef FG_GATE
#undef FG_ACC
        fg_st(lds, tid, ra0, rb0);
        FG_BAR();
    }
#undef FG_COMPUTE
#undef FG_BAR
#pragma unroll
    for (int rt = 0; rt < 2; ++rt)
#pragma unroll
        for (int ct = 0; ct < 2; ++ct) { const int tok0 = pm * 256 + 64 * wr + 32 * rt, n0 = pn * 128 + 64 * wc + 32 * ct;
#pragma unroll
            for (int p2 = 0; p2 < 8; ++p2) { const int tr = 8 * (p2 >> 1) + 4 * h + 2 * (p2 & 1); const unsigned tv = tot[rt][ct][p2];
                *(LAS unsigned short*)(patch + tr * 80 + r * 2) = (unsigned short)(tv & 0xffffu); *(LAS unsigned short*)(patch + (tr + 1) * 80 + r * 2) = (unsigned short)(tv >> 16); }
#pragma unroll
            for (int j = 0; j < 2; ++j) { const int p = lane + 64 * j; const u32x4 ov = *(LAS const u32x4*)(patch + (p >> 2) * 80 + (p & 3) * 16);
                *(u32x4*)(mix + ((unsigned)(tok0 + (p >> 2)) * 1024u + (unsigned)(n0 + 8 * (p & 3)))) = ov; } }
}

#define LAUNDER_S(x) asm volatile("" : "+s"(x))
#define GAS __attribute__((address_space(1)))
#define INP(k) ({ int k_ = (k); LAUNDER_S(k_); (const float*)(const GAS float*)P.in[k_]; })
#define POUT ((float*)(GAS float*)P.out)
#define PHASE_BEGIN int L = layer; LAUNDER_S(L); GAS unsigned char* wsg_ = (GAS unsigned char*)P.ws; LAUNDER_S(wsg_); unsigned char* ws = (unsigned char*)wsg_; int G = gridDim.x, bx = blockIdx.x; LAUNDER_S(G); LAUNDER_S(bx); int tid = threadIdx.x; asm volatile("" : "+v"(tid)); const int lane = tid & 63, wave = __builtin_amdgcn_readfirstlane(tid >> 6); (void)lane; (void)wave; (void)G; (void)bx; (void)L; (void)ws;
__global__ void __launch_bounds__(512, 2) hybrid_fwd(Params P) {
    extern __shared__ __attribute__((aligned(16))) unsigned char lds_raw[];
    LAS unsigned char* lds = (LAS unsigned char*)lds_raw;
    cg::grid_group grid = cg::this_grid();
#pragma unroll 1
    for (int layer = 0; layer < 2; ++layer) {
#ifndef REP_A
#define REP_A 1
#endif
#ifndef REP_CD
#define REP_CD 1
#endif
        for (int repa_ = 0; repa_ < REP_A; ++repa_)
        { PHASE_BEGIN
            const int gtid = bx * 512 + tid, gthreads = G * 512, gwave = bx * 8 + wave, nwaves = G * 8;
            prep_w<1>(INP(3) + (size_t)L * DM * NIN, DM, NIN, (bf16_t*)(ws + WS_WIN), NINP, DM, lds, tid, bx, G);
            prep_w<3>(INP(11) + (size_t)L * DM * DM, DM, DM, (bf16_t*)(ws + WS_WBR), DM, DM, lds, tid, bx, G);
            prep_w<0>(INP(12) + (size_t)L * DM * DM, DM, DM, (bf16_t*)(ws + WS_WOUT), DM, DM, lds, tid, bx, G);
            prep_w<2>(INP(14) + (size_t)L * DM * 2 * DFF, DM, 2 * DFF, (bf16_t*)(ws + WS_WGU), 2 * DFF, DM, lds, tid, bx, G);
            prep_w<0>(INP(15) + (size_t)L * DFF * DM, DFF, DM, (bf16_t*)(ws + WS_WDN), DM, DFF, lds, tid, bx, G);
            const float* cw1 = INP(9) + (size_t)L * 2 * 2048 * 256;
            prep_w<0>(cw1, 2048, 256, (bf16_t*)(ws + WS_WC1), 256, 2048, lds, tid, bx, G);
            prep_w<0>(cw1 + 2048 * 256, 2048, 256, (bf16_t*)(ws + WS_WC1) + 256 * 2048, 256, 2048, lds, tid, bx, G);
            rmsnorm_rows(L == 0 ? INP(0) : (const float*)POUT, INP(2) + L * DM, (bf16_t*)(ws + WS_H), gwave, nwaves, lane);
            if (gwave < 512) { const int kv = gwave >> 8, j = gwave & 255; const float* pp = INP(8) + (size_t)L * 2 * 2048 + kv * 2048; const float* ww = cw1 + (size_t)kv * 2048 * 256 + j; float a = 0.f;
#pragma unroll 8
                for (int i = lane; i < 2048; i += 64) a = fmaf(pp[i], ww[(size_t)i * 256], a);
                a = wave_sum(a);
                if (lane == 0) ((float*)(ws + WS_SMALL))[kv * 256 + j] = a; }
            if (bx == 1 && tid < 384) { float* nw = (float*)(ws + WS_SMALL + 2048); const float v = tid < 64 ? (INP(4) + L * 64)[tid] : (tid < 128 ? (INP(5) + L * 64)[tid - 64] : (tid < 192 ? (INP(6) + L * 64)[tid - 128] : (INP(7) + L * 192)[tid - 192])); nw[tid] = v; }
        }
        grid.sync();

        { PHASE_BEGIN
            pg8::Gemm g{(const bf16_t*)(ws + WS_H), (const bf16_t*)(ws + WS_WIN), MTOK, NINP, DM, DM, DM}; pg8::StaticOrder S; S.init(MTOK, NINP, G, bx);
            EpiInproj E{ws, (const float*)(ws + WS_SMALL + 2048)};
#ifndef SKIP_B
            pg8::gemm_phase<EpiInproj, pg8::StaticOrder, true, true>(lds, g, S, E, tid);
#endif
        }
        grid.sync();

        for (int repcd_ = 0; repcd_ < REP_CD; ++repcd_) {
        { PHASE_BEGIN
            if (bx < 128) { const int kv = bx >> 6, ks = (bx >> 4) & 3;
                pg8::Gemm g{(const bf16_t*)(ws + WS_B + (kv ? HB_VCR : HB_KCR) * MiB) + ks * 512, (const bf16_t*)(ws + WS_WC1) + (size_t)kv * 256 * 2048 + ks * 512, 4096, 256, 512, 1024, 2048};
                pg8::StaticOrder S; S.init(4096, 256, G, bx & 15);
                EpiStoreF32 E{(float*)(ws + WS_H) + (size_t)(kv * 4 + ks) * 4096 * 256};
#ifndef SKIP_C
                pg8::gemm_phase<EpiStoreF32, pg8::StaticOrder, true, true>(lds, g, S, E, tid);
#endif
            } else {
                const bf16_t* mbk = (const bf16_t*)(ws + WS_B + HB_MBK * MiB); float* KMEAN = (float*)(ws + WS_SMALL + 4096);
                for (int item = (bx - 128) * 8 + wave; item < 512; item += (G - 128) * 8) { const int bh = item >> 5, n = item & 31;
                    const bf16_t* kp = mbk + ((size_t)bh * SEQ + 256 * n) * 64 + lane; float a = 0.f;
#pragma unroll 8
                    for (int j = 0; j < 256; ++j) a += bf2f(kp[(size_t)j * 64]);
                    KMEAN[(size_t)item * 64 + lane] = a * (1.0f / 256.0f); }
            }
        }
        grid.sync();

        { PHASE_BEGIN
            const int gwave = bx * 8 + wave, nwaves = G * 8;
            const float* cw2 = INP(10) + (size_t)L * 2 * 256 * 64; const float* nkn = INP(7) + L * 192;
            bf16_t* KC = (bf16_t*)(ws + WS_KC); bf16_t* VCT = (bf16_t*)(ws + WS_VCT);
            for (int row = gwave; row < 8192; row += nwaves) { const int kv = row >> 12, rr = row & 4095, bg = rr >> 9, n = rr & 511;
                f32x4 hv = *(const f32x4*)((const float*)(ws + WS_SMALL) + kv * 256 + 4 * lane);
                { const float* pp = (const float*)(ws + WS_H) + ((size_t)(kv * 4) * 4096 + rr) * 256 + 4 * lane;
#pragma unroll
                    for (int ks = 0; ks < 4; ++ks) hv += *(const f32x4*)(pp + (size_t)ks * 4096 * 256);
#pragma unroll
                    for (int e = 0; e < 4; ++e) { const float t = hv[e], z = 0.7978845608028654f * (t + 0.044715f * t * t * t);
                        const float th = 1.0f - 2.0f * __builtin_amdgcn_rcpf(1.0f + __expf(2.0f * z)); hv[e] = 0.5f * t * (1.0f + th); } }
                const float* wp = cw2 + (size_t)kv * 256 * 64 + lane; float a = 0.f;
#pragma unroll
                for (int k = 0; k < 256; ++k) { const float hk = __uint_as_float(__builtin_amdgcn_readlane(__float_as_uint(hv[k & 3]), k >> 2)); a = fmaf(hk, wp[k * 64], a); }
                if (kv == 0) { const float ss = wave_sum(a * a); float y = a * __builtin_amdgcn_rsqf(ss * (1.0f / 64.0f) + 1e-6f) * nkn[lane]; if (n == 511) y = 0.f;
                    KC[((size_t)bg * 512 + n) * 64 + lane] = (bf16_t)(pk2(y, 0.f) & 0xffffu); }
                else { if (n == 511) a = 0.f; VCT[((size_t)bg * 64 + lane) * 512 + n] = (bf16_t)(pk2(a, 0.f) & 0xffffu); } }
        }
        grid.sync();

        }
        { PHASE_BEGIN
            LAS unsigned* misc = (LAS unsigned*)(lds + ATT_MISC); LAS float* btab = (LAS float*)(lds + ATT_BT);
            const float* rel_bias = INP(1);
            __syncthreads();
            if (wave == 0) { const float* mqn = INP(4) + L * 64; const float* mkn = INP(5) + L * 64; const float* nqn = INP(6) + L * 64; const float* nkn = INP(7) + L * 192;
                float gq = fmaxf(fabsf(mqn[lane]), fabsf(nqn[lane])); float gk = fmaxf(fmaxf(fabsf(mkn[lane]), fabsf(nkn[lane])), fmaxf(fabsf(nkn[64 + lane]), fabsf(nkn[128 + lane])));
                float bm = 0.f;
#pragma unroll
                for (int i = 0; i < 6; ++i) bm = fmaxf(bm, fabsf(rel_bias[lane + 64 * i]));
                gq = wave_max(gq); gk = wave_max(gk); bm = wave_max(bm);
                if (lane == 0) ((LAS float*)misc)[2] = 8.0f * gq * gk + bm; }
            __syncthreads();
            const float shift = ((LAS float*)misc)[2];
            for (int i = tid; i < 12 * BT_N; i += 512) { const int hd = i / BT_N, jx = i - hd * BT_N; const int d = jx - 64;
                float v = -3.0e38f;
                if (d >= 0) { int bk; if (d < 16) bk = d; else if (d >= 128) bk = 31; else { bk = 16 + (int)(__log2f((float)d * (1.0f / 16.0f)) * (16.0f / 3.0f)); bk = bk > 31 ? 31 : bk; }
                    v = (rel_bias[bk * 12 + hd] - shift) * L2E; }
                btab[i] = v; }
            __syncthreads();
#ifndef REP_E
#define REP_E 1
#endif
            for (int rep_ = 0; rep_ < REP_E; ++rep_) {
            unsigned* ctl = (unsigned*)(ws + WS_CTL) + L + 2 * rep_;
            unsigned char* HBUF = ws + WS_B; bf16_t* OMIX = (bf16_t*)(ws + WS_H);
            for (;;) {
                __syncthreads();
                if (tid == 0) misc[0] = atomicAdd(ctl, 1u);
                __syncthreads();
                const int u = (int)misc[0];
                if (u >= 2048) break;
                int tidu = tid; asm volatile("" : "+v"(tidu));
                if (u < 1024) { const int c = 127 - (u >> 3), bg = u & 7;
#ifndef SKIP_NSA
                    nsa_unit(lds, HBUF, (const bf16_t*)(ws + WS_KC), (const bf16_t*)(ws + WS_VCT), (const float*)(ws + WS_NSG), OMIX, bg >> 1, bg & 1, c, tidu);
#endif
                }
                else if (u < 1536) { const int v = u - 1024;
#ifndef SKIP_MOBA
                    moba_unit(lds, HBUF, (const float*)(ws + WS_SMALL + 4096), OMIX, (v & 15) >> 2, v & 3, 31 - (v >> 4), tidu);
#endif
                }
                else { const int v = u - 1536;
#ifndef SKIP_SB
                    sb_unit(lds, HBUF, OMIX, (v & 15) >> 2, v & 3, 31 - (v >> 4), tidu);
#endif
                }
            }
            }
        }
        grid.sync();

        { PHASE_BEGIN
            for (int tl = bx; tl < 1024; tl += G) { int tidu = tid; asm volatile("" : "+v"(tidu));
                branch_tile(lds, (const bf16_t*)(ws + WS_H), (const bf16_t*)(ws + WS_WBR), (const bf16_t*)(ws + WS_A), (bf16_t*)(ws + WS_B), tl >> 3, tl & 7, tidu); }
        }
        grid.sync();

        { PHASE_BEGIN
            pg8::Gemm g{(const bf16_t*)(ws + WS_B), (const bf16_t*)(ws + WS_WOUT), MTOK, DM, DM, DM, DM}; pg8::StaticOrder S; S.init(MTOK, DM, G, bx);
            EpiRes E{L == 0 ? INP(0) : (const float*)POUT, POUT};
#ifndef SKIP_GJ
            pg8::gemm_phase<EpiRes, pg8::StaticOrder, true, true>(lds, g, S, E, tid);
#endif
        }
        grid.sync();

        { PHASE_BEGIN
            rmsnorm_rows(POUT, INP(13) + L * DM, (bf16_t*)(ws + WS_H), bx * 8 + wave, G * 8, lane); }
        grid.sync();

        { PHASE_BEGIN
            pg8::Gemm g{(const bf16_t*)(ws + WS_H), (const bf16_t*)(ws + WS_WGU), MTOK, 2 * DFF, DM, DM, DM}; pg8::StaticOrder S; S.init(MTOK, 2 * DFF, G, bx); EpiSwiglu E{(bf16_t*)(ws + WS_A)};
#ifndef SKIP_I
            pg8::gemm_phase<EpiSwiglu, pg8::StaticOrder, true, true>(lds, g, S, E, tid);
#endif
        }
        grid.sync();

        { PHASE_BEGIN
            pg8::Gemm g{(const bf16_t*)(ws + WS_A), (const bf16_t*)(ws + WS_WDN), MTOK, DM, DFF, DFF, DFF}; pg8::StaticOrder S; S.init(MTOK, DM, G, bx); EpiRes E{POUT, POUT};
#ifndef SKIP_GJ
            pg8::gemm_phase<EpiRes, pg8::StaticOrder, true, true>(lds, g, S, E, tid);
#endif
        }
        if (layer == 0) grid.sync();
    }
}

extern "C" void kernel_launch(void* const* d_in, const int* in_sizes, int n_in, void* d_out, int out_size, void* d_ws, size_t ws_size, hipStream_t stream) {
    static int grid = 0;
    if (grid == 0) {
        if (n_in != 16 || out_size != MTOK * DM || ws_size < WS_END) { fprintf(stderr, "kernel_launch: unexpected shapes (n_in %d out %d ws %zu, need ws >= %zu)\n", n_in, out_size, ws_size, (size_t)WS_END); grid = -1; return; }
        int dev = 0, cus = 0, per_cu = 0;
        hipGetDevice(&dev); hipDeviceGetAttribute(&cus, hipDeviceAttributeMultiprocessorCount, dev);
        if (hipFuncSetAttribute((const void*)hybrid_fwd, hipFuncAttributeMaxDynamicSharedMemorySize, LDS_BYTES) != hipSuccess) { fprintf(stderr, "kernel_launch: hipFuncSetAttribute failed\n"); grid = -1; return; }
        if (hipOccupancyMaxActiveBlocksPerMultiprocessor(&per_cu, (const void*)hybrid_fwd, 512, LDS_BYTES) != hipSuccess || per_cu < 1) { fprintf(stderr, "kernel_launch: occupancy query gave %d\n", per_cu); per_cu = 1; }
        (void)hipGetLastError();
        grid = cus * 1;
    }
    if (grid < 0) return;
    hipMemsetAsync((char*)d_ws + WS_CTL, 0, 4096, stream);
    Params p{};
    for (int i = 0; i < 16; ++i) p.in[i] = (const float*)d_in[i];
    p.out = (float*)d_out; p.ws = (unsigned char*)d_ws;
    void* args[] = {&p};
    hipError_t e = hipLaunchCooperativeKernel((const void*)hybrid_fwd, dim3(grid), dim3(512), args, LDS_BYTES, stream);
    if (e != hipSuccess) fprintf(stderr, "cooperative launch failed: %s (grid %d)\n", hipGetErrorString(e), grid);
}
```

```cpp
#include <hip/hip_runtime.h>
#include <hip/hip_cooperative_groups.h>
#include <cstdio>
#include <cstdint>
namespace cg = cooperative_groups;
namespace pg8 {
#define PG8_LAS __attribute__((address_space(3)))
typedef unsigned short bf16_t;
typedef short bf16x8 __attribute__((ext_vector_type(8)));
typedef float f32x4 __attribute__((ext_vector_type(4)));
typedef unsigned u32x4 __attribute__((ext_vector_type(4)));
constexpr int BM = 256, BK = 64, HALF = 128, HTB = HALF * BK * 2  , STAGE_BYTES = 8 * HTB, NXCD = 8, WGM = 8;

__host__ __device__ __forceinline__ int lds_byte(int r, int c) { const int st = (r >> 4) * 2 + (c >> 5), rr = r & 15, cc = c & 31, ob = rr * 64 + cc * 2; return st * 1024 + (ob ^ (((ob >> 9) & 1) << 5)); }
__host__ __device__ __forceinline__ void stage_rc(int b, int& R, int& C) { const int st = b / 1024, sb = b % 1024, swz = sb ^ (((sb >> 9) & 1) << 5); R = (st >> 1) * 16 + swz / 64; C = (st & 1) * 32 + (swz % 64) / 2; }
__host__ __device__ __forceinline__ int perm32(int rho) { const int n = rho >> 4, i = rho & 15; return 8 * (i >> 2) + 4 * n + (i & 3); }

struct Unit { int pm, pn; };
struct Gemm { const bf16_t* A; const bf16_t* Bt; int M, N, K, lda, ldb; };

struct StaticOrder {
    int nM, nN, nwg, G, c;
    __host__ __device__ void init(int M, int N, int G_, int c_) { nM = M / BM; nN = N / BM; nwg = nM * nN; G = G_; c = c_; }
    __host__ __device__ bool next(int i, Unit& u) const {
        const long L = (long)i * G + c; if (L >= nwg) return false;
        int wgid = (int)L; { const int q = nwg / NXCD, r = nwg % NXCD, xcd = wgid % NXCD, off = wgid / NXCD; wgid = (xcd < r ? xcd * (q + 1) : r * (q + 1) + (xcd - r) * q) + off; }
        const int nig = WGM * nN, gid = wgid / nig, fm = gid * WGM, gsz = (nM - fm) < WGM ? (nM - fm) : WGM;
        u.pm = fm + ((wgid % nig) % gsz); u.pn = (wgid % nig) / gsz; return true;
    }
    __device__ __forceinline__ void a_ready(const Unit&) const {}
    __device__ __forceinline__ void done(const Unit&) const {}
};
template <class Epi, class Sched, bool ALIGN_EPI = false, bool SP2 = false>
__device__ __forceinline__ void gemm_phase(PG8_LAS unsigned char* lds, const Gemm g, const Sched& S, const Epi& E, int tid_in) {
    const int tid = tid_in, wid = __builtin_amdgcn_readfirstlane(tid >> 6), lane = tid & 63, wr = wid >> 2, wc = wid & 3, fr = lane & 15, fq = lane >> 4;
    const int K = g.K, nt = K / BK;
    unsigned voffA[2], voffB[2];
#pragma unroll
    for (int i = 0; i < 2; ++i) { int R, C; stage_rc(tid * 16 + i * 8192, R, C); const int Rb = Epi::PERM ? ((R & ~31) + perm32(R & 31)) : R;
        voffA[i] = (unsigned)(R * g.lda + C) * 2u; voffB[i] = (unsigned)(Rb * g.ldb + C) * 2u; }
    const size_t kstep = (size_t)(BK * 2);
    const size_t hstepA = (size_t)HALF * g.lda * 2, hstepB = (size_t)HALF * g.ldb * 2;
    const size_t tstepA = 2 * hstepA, tstepB = 2 * hstepB;
    const unsigned ldsw = (unsigned)wid * 1024u;
    const int aoff = lds_byte(wr * 64 + fr, fq * 8), boff = lds_byte(wc * 32 + fr, fq * 8);
#define PG8_SA(b, h) (((b) * 2 + (h)) * HTB)
#define PG8_SB(b, h) ((4 + (b) * 2 + (h)) * HTB)
#define PG8_STAGE(bufoff, gbase, voff) do { _Pragma("unroll") for (int _i = 0; _i < 2; ++_i) \
        __builtin_amdgcn_global_load_lds((const unsigned*)((const char*)(gbase) + (voff)[_i]), (PG8_LAS unsigned*)(lds + (bufoff) + ldsw + _i * 8192), 16, 0, 0); } while (0)
#define PG8_LDA(dst, b, h) do { _Pragma("unroll") for (int m = 0; m < 4; ++m) _Pragma("unroll") for (int k = 0; k < 2; ++k) dst[m][k] = *(const PG8_LAS bf16x8*)(lds + PG8_SA(b, h) + aoff + m * 2048 + k * 1024); } while (0)
#define PG8_LDB(dst, b, h) do { _Pragma("unroll") for (int n = 0; n < 2; ++n) _Pragma("unroll") for (int k = 0; k < 2; ++k) dst[n][k] = *(const PG8_LAS bf16x8*)(lds + PG8_SB(b, h) + boff + n * 2048 + k * 1024); } while (0)
#define PG8_MMA(ai, bj, At, Bt) do { __builtin_amdgcn_s_setprio(1); _Pragma("unroll") for (int m = 0; m < 4; ++m) _Pragma("unroll") for (int n = 0; n < 2; ++n) _Pragma("unroll") for (int k = 0; k < 2; ++k) \
        acc[ai][bj][m][n] = __builtin_amdgcn_mfma_f32_16x16x32_bf16(Bt[n][k], At[m][k], acc[ai][bj][m][n], 0, 0, 0); __builtin_amdgcn_s_setprio(0); } while (0)
#define PG8_WAIT_V(n) asm volatile("s_waitcnt vmcnt(" #n ")" ::: "memory")
#define PG8_WAIT_L(n) asm volatile("s_waitcnt lgkmcnt(" #n ")" ::: "memory")
#define PG8_BAR __builtin_amdgcn_s_barrier()
#define PG8_SCHED __builtin_amdgcn_sched_barrier(0)
    Unit cur, nxt; int ui = 0;
    if (!S.next(0, cur)) return;
    f32x4 acc[2][2][4][2];
#pragma unroll
    for (int a = 0; a < 2; ++a)
#pragma unroll
        for (int b = 0; b < 2; ++b)
#pragma unroll
            for (int m = 0; m < 4; ++m)
#pragma unroll
                for (int n = 0; n < 2; ++n) acc[a][b][m][n] = (f32x4){0.f, 0.f, 0.f, 0.f};
    bf16x8 At[4][2], B0[2][2], B1[2][2];
    const char* cA = (const char*)g.A + (size_t)cur.pm * tstepA; const char* cB = (const char*)g.Bt + (size_t)cur.pn * tstepB;
    S.a_ready(cur);
    if constexpr (SP2) {
        PG8_STAGE(PG8_SB(0, 0), cB, voffB); PG8_STAGE(PG8_SB(0, 1), cB + hstepB, voffB); PG8_STAGE(PG8_SA(0, 0), cA, voffA); PG8_STAGE(PG8_SA(0, 1), cA + hstepA, voffA);
        if (wr == 1) PG8_BAR;
        PG8_WAIT_V(2); PG8_BAR;
        PG8_STAGE(PG8_SB(1, 0), cB + kstep, voffB); PG8_STAGE(PG8_SA(1, 0), cA + kstep, voffA); PG8_STAGE(PG8_SB(1, 1), cB + hstepB + kstep, voffB);
        PG8_WAIT_V(6); PG8_BAR;
    } else {
        PG8_STAGE(PG8_SB(0, 0), cB, voffB); PG8_STAGE(PG8_SA(0, 0), cA, voffA); PG8_STAGE(PG8_SB(0, 1), cB + hstepB, voffB); PG8_STAGE(PG8_SA(0, 1), cA + hstepA, voffA);
        if (wr == 1) PG8_BAR;
        PG8_WAIT_V(4); PG8_BAR;
        PG8_STAGE(PG8_SB(1, 0), cB + kstep, voffB); PG8_STAGE(PG8_SA(1, 0), cA + kstep, voffA); PG8_STAGE(PG8_SB(1, 1), cB + hstepB + kstep, voffB);
        PG8_WAIT_V(6); PG8_BAR;
    }
    for (;;) {
        const bool has_next = S.next(ui + 1, nxt);
        const char* nA = has_next ? (const char*)g.A + (size_t)nxt.pm * tstepA : cA; const char* nB = has_next ? (const char*)g.Bt + (size_t)nxt.pn * tstepB : cB;
#pragma unroll 1
        for (int t = 0; t < nt; t += 2) {
            const bool last = (t == nt - 2);
            const char* a1 = cA + (size_t)(t + 1) * kstep;
            const char* a2 = last ? nA : cA + (size_t)(t + 2) * kstep; const char* b2 = last ? nB : cB + (size_t)(t + 2) * kstep;
            const char* a3 = a2 + kstep; const char* b3 = b2 + kstep;
            if (last && has_next) S.a_ready(nxt);
            if constexpr (SP2) {
            PG8_LDB(B0, 0, 0); PG8_LDB(B1, 0, 1); PG8_SCHED; PG8_LDA(At, 0, 0); PG8_STAGE(PG8_SA(1, 1), a1 + hstepA, voffA);
            PG8_WAIT_V(8); PG8_WAIT_L(0); PG8_BAR; PG8_MMA(0, 0, At, B0); PG8_MMA(0, 1, At, B1); PG8_BAR; PG8_SCHED;
            PG8_LDA(At, 0, 1); PG8_STAGE(PG8_SB(0, 0), b2, voffB); PG8_STAGE(PG8_SB(0, 1), b2 + hstepB, voffB); PG8_STAGE(PG8_SA(0, 0), a2, voffA);
            PG8_WAIT_V(8); PG8_WAIT_L(0); PG8_BAR; PG8_MMA(1, 0, At, B0); PG8_MMA(1, 1, At, B1); PG8_BAR; PG8_SCHED;
            PG8_LDB(B0, 1, 0); PG8_LDB(B1, 1, 1); PG8_SCHED; PG8_LDA(At, 1, 0); PG8_STAGE(PG8_SA(0, 1), a2 + hstepA, voffA);
            PG8_WAIT_V(8); PG8_WAIT_L(0); PG8_BAR; PG8_MMA(0, 0, At, B0); PG8_MMA(0, 1, At, B1); PG8_BAR; PG8_SCHED;
            PG8_LDA(At, 1, 1); PG8_STAGE(PG8_SB(1, 0), b3, voffB); PG8_STAGE(PG8_SB(1, 1), b3 + hstepB, voffB); PG8_STAGE(PG8_SA(1, 0), a3, voffA);
            PG8_WAIT_V(8); PG8_WAIT_L(0); PG8_BAR; PG8_MMA(1, 0, At, B0); PG8_MMA(1, 1, At, B1); PG8_BAR; PG8_SCHED;
            } else {
            PG8_LDB(B0, 0, 0); PG8_SCHED; PG8_LDA(At, 0, 0); PG8_STAGE(PG8_SA(1, 1), a1 + hstepA, voffA);
            PG8_WAIT_L(8); PG8_BAR; PG8_WAIT_L(0); PG8_MMA(0, 0, At, B0); PG8_BAR; PG8_SCHED;
            PG8_LDB(B1, 0, 1); PG8_STAGE(PG8_SB(0, 0), b2, voffB);
            PG8_BAR; PG8_WAIT_L(0); PG8_MMA(0, 1, At, B1); PG8_BAR;
            PG8_LDA(At, 0, 1); PG8_STAGE(PG8_SA(0, 0), a2, voffA);
            PG8_BAR; PG8_WAIT_L(0); PG8_MMA(1, 0, At, B0); PG8_BAR; PG8_SCHED;
            PG8_STAGE(PG8_SB(0, 1), b2 + hstepB, voffB);
            PG8_WAIT_V(6); PG8_BAR; PG8_MMA(1, 1, At, B1); PG8_BAR;
            PG8_LDB(B0, 1, 0); PG8_SCHED; PG8_LDA(At, 1, 0); PG8_STAGE(PG8_SA(0, 1), a2 + hstepA, voffA);
            PG8_WAIT_L(8); PG8_BAR; PG8_WAIT_L(0); PG8_MMA(0, 0, At, B0); PG8_BAR; PG8_SCHED;
            PG8_LDB(B1, 1, 1); PG8_STAGE(PG8_SB(1, 0), b3, voffB);
            PG8_BAR; PG8_WAIT_L(0); PG8_MMA(0, 1, At, B1); PG8_BAR;
            PG8_LDA(At, 1, 1); PG8_STAGE(PG8_SA(1, 0), a3, voffA);
            PG8_BAR; PG8_WAIT_L(0); PG8_MMA(1, 0, At, B0); PG8_BAR; PG8_SCHED;
            PG8_STAGE(PG8_SB(1, 1), b3 + hstepB, voffB);
            PG8_WAIT_V(6); PG8_BAR; PG8_MMA(1, 1, At, B1); PG8_BAR;
            }
        }
        if constexpr (ALIGN_EPI) { if (wr == 0) PG8_BAR; }
        if constexpr (!Epi::AFTER_DRAIN) { E(acc, cur, wr, wc, fr, fq); S.done(cur); }
        if (!has_next) break;
#pragma unroll
        for (int a = 0; a < 2; ++a)
#pragma unroll
            for (int b = 0; b < 2; ++b)
#pragma unroll
                for (int m = 0; m < 4; ++m)
#pragma unroll
                    for (int n = 0; n < 2; ++n) acc[a][b][m][n] = (f32x4){0.f, 0.f, 0.f, 0.f};
        cur = nxt; cA = nA; cB = nB; ++ui;
        if constexpr (ALIGN_EPI) { if (wr == 1) PG8_BAR; }
    }
    PG8_WAIT_V(0);
    if constexpr (!ALIGN_EPI) { if (wr == 0) PG8_BAR; }
    PG8_BAR;
    if constexpr (Epi::AFTER_DRAIN) { E.fused(acc, cur, wr, wc, fr, fq, lds, wid, lane); S.done(cur); }
#undef PG8_SA
#undef PG8_SB
#undef PG8_STAGE
#undef PG8_LDA
#undef PG8_LDB
#undef PG8_MMA
#undef PG8_WAIT_V
#undef PG8_WAIT_L
#undef PG8_BAR
#undef PG8_SCHED
}
}

#define LAS __attribute__((address_space(3)))
typedef unsigned short bf16_t;
typedef short bf16x8 __attribute__((ext_vector_type(8)));
typedef float f32x4 __attribute__((ext_vector_type(4)));
typedef float f32x16 __attribute__((ext_vector_type(16)));
typedef unsigned u32x4 __attribute__((ext_vector_type(4)));
typedef unsigned u32x2 __attribute__((ext_vector_type(2)));
typedef float f32x2_t __attribute__((ext_vector_type(2)));
typedef __bf16 bf16x2_t __attribute__((ext_vector_type(2)));

constexpr int MTOK = 32768, DM = 1024, SEQ = 8192;
constexpr int NIN = 5912, NINP = 6144, DFF = 2816;
constexpr float L2E = 1.4426950408889634f;
constexpr size_t MiB = 1048576;
constexpr size_t WS_CTL = 0, WS_WIN = 1 * MiB, WS_WBR = 13 * MiB, WS_WOUT = 15 * MiB, WS_WGU = 17 * MiB, WS_WDN = 28 * MiB, WS_WC1 = 34 * MiB,
                 WS_SMALL = 36 * MiB, WS_CMPH = 37 * MiB, WS_KC = 45 * MiB, WS_VCT = 45 * MiB + 512 * 1024, WS_NSG = 46 * MiB,
                 WS_H = 49 * MiB  , WS_A = 113 * MiB  ,
                 WS_B = 305 * MiB  , WS_END = 481 * MiB;
constexpr size_t HB_SBQ = 0, HB_SBK = 16, HB_SBVT = 32, HB_MBQ = 48, HB_MBK = 64, HB_MBVT = 80, HB_NSQ = 96, HB_KCR = 128, HB_VCR = 136,
                 HB_KS = 144, HB_VST = 152, HB_KW = 160, HB_VWT = 168;
constexpr int LDS_BYTES = 147456;
constexpr int ATT_BT = 36864, ATT_MISC = 50688, ATT_SEL = 50944, ATT_X = 51968, ATT_OA = 93952;

struct Params { const float* in[16]; float* out; unsigned char* ws; };

__device__ __forceinline__ unsigned pk2(float lo, float hi) { f32x2_t v = {lo, hi}; bf16x2_t b = __builtin_convertvector(v, bf16x2_t); return __builtin_bit_cast(unsigned, b); }
__device__ __forceinline__ float bf2f(unsigned v16) { return __uint_as_float(v16 << 16); }
__device__ __forceinline__ float bflo(unsigned w) { return __uint_as_float(w << 16); }
__device__ __forceinline__ float bfhi(unsigned w) { return __uint_as_float(w & 0xffff0000u); }
__device__ __forceinline__ float wave_sum(float v) { v += __shfl_xor(v, 1); v += __shfl_xor(v, 2); v += __shfl_xor(v, 4); v += __shfl_xor(v, 8); v += __shfl_xor(v, 16); v += __shfl_xor(v, 32); return v; }
__device__ __forceinline__ float wave_max(float v) { v = fmaxf(v, __shfl_xor(v, 1)); v = fmaxf(v, __shfl_xor(v, 2)); v = fmaxf(v, __shfl_xor(v, 4)); v = fmaxf(v, __shfl_xor(v, 8)); v = fmaxf(v, __shfl_xor(v, 16)); v = fmaxf(v, __shfl_xor(v, 32)); return v; }
__device__ __forceinline__ float sigmoidf_(float x) { return __builtin_amdgcn_rcpf(1.0f + __expf(-x)); }
__device__ __forceinline__ float ex2(float x) { return __builtin_amdgcn_exp2f(x); }
__device__ __forceinline__ float lg2(float x) { return __builtin_amdgcn_logf(x); }

template <int MAP> __device__ __forceinline__ int mapcol(int p) {
    const int pn = p >> 8, q = p & 255, bj = q >> 7, wc = (q >> 5) & 3, n = (q >> 4) & 1, fq = (q >> 2) & 3, e = q & 3;
    const int lc = 64 * wc + 32 * bj + 8 * fq + 4 * n + e;
    if (MAP == 3) return p;
    if (MAP == 0) return 256 * pn + lc;
    if (MAP == 1) { if (pn <= 10) return 256 * pn + lc; if (pn == 11) return lc < 24 ? 2816 + lc : -1; return 2840 + 256 * (pn - 12) + lc; }
    const int j = 128 * pn + 32 * wc + 8 * fq + 4 * n + e; return bj ? DFF + j : j;
}

struct EpiRes {
    static constexpr bool PERM = false, AFTER_DRAIN = false;
    const float* res; float* out;
    __device__ __forceinline__ void operator()(const f32x4 (&acc)[2][2][4][2], const pg8::Unit& u, int wr, int wc, int fr_, int fq_) const {
        int fr = fr_, fq = fq_; asm volatile("" : "+v"(fr), "+v"(fq));
#pragma unroll
        for (int ai = 0; ai < 2; ++ai)
#pragma unroll
            for (int m = 0; m < 4; ++m) { const unsigned row = (unsigned)(u.pm * 256 + 128 * ai + 64 * wr + 16 * m + fr);
#pragma unroll
                for (int bj = 0; bj < 2; ++bj)
#pragma unroll
                    for (int n = 0; n < 2; ++n) { const unsigned o = row * 1024u + (unsigned)(u.pn * 256 + 64 * wc + 32 * bj + 8 * fq + 4 * n);
                        const f32x4 r = *(const f32x4*)(res + o); *(f32x4*)(out + o) = r + acc[ai][bj][m][n]; }
                __builtin_amdgcn_sched_barrier(0); }
    }
};
struct EpiSwiglu {
    static constexpr bool PERM = false, AFTER_DRAIN = false;
    bf16_t* act;
    __device__ __forceinline__ void operator()(const f32x4 (&acc)[2][2][4][2], const pg8::Unit& u, int wr, int wc, int fr_, int fq_) const {
        int fr = fr_, fq = fq_; asm volatile("" : "+v"(fr), "+v"(fq));
#pragma unroll
        for (int ai = 0; ai < 2; ++ai)
#pragma unroll
            for (int m = 0; m < 4; ++m) { const unsigned row = (unsigned)(u.pm * 256 + 128 * ai + 64 * wr + 16 * m + fr);
                float v[8];
#pragma unroll
                for (int n = 0; n < 2; ++n)
#pragma unroll
                    for (int e = 0; e < 4; ++e) { const float g = acc[ai][0][m][n][e], up = acc[ai][1][m][n][e]; v[4 * n + e] = g * sigmoidf_(g) * up; }
                u32x4 w; w.x = pk2(v[0], v[1]); w.y = pk2(v[2], v[3]); w.z = pk2(v[4], v[5]); w.w = pk2(v[6], v[7]);
                *(u32x4*)(act + (row * 2816u + (unsigned)(u.pn * 128 + 32 * wc + 8 * fq))) = w; }
    }
};
template <int MODE> struct EpiBranch {
    static constexpr bool PERM = false, AFTER_DRAIN = false;
    const bf16_t* brg; bf16_t* mix; int s;
    __device__ __forceinline__ void operator()(const f32x4 (&acc)[2][2][4][2], const pg8::Unit& u, int wr, int wc, int fr_, int fq_) const {
        int fr = fr_, fq = fq_; asm volatile("" : "+v"(fr), "+v"(fq));
#pragma unroll
        for (int ai = 0; ai < 2; ++ai)
#pragma unroll
            for (int m = 0; m < 4; ++m) { const unsigned row = (unsigned)(u.pm * 256 + 128 * ai + 64 * wr + 16 * m + fr);
#pragma unroll
                for (int bj = 0; bj < 2; ++bj)
#pragma unroll
                    for (int n = 0; n < 2; ++n) { const unsigned c = (unsigned)(u.pn * 256 + 64 * wc + 32 * bj + 8 * fq + 4 * n);
                        const u32x2 g = *(const u32x2*)(brg + (row * 3072u + 1024u * (unsigned)s + c));
                        u32x2 o = {0u, 0u}; if (MODE) o = *(const u32x2*)(mix + (row * 1024u + c));
                        const f32x4 a = acc[ai][bj][m][n];
                        u32x2 w;
                        w.x = pk2(bflo(o.x) + bflo(g.x) * a[0], bfhi(o.x) + bfhi(g.x) * a[1]);
                        w.y = pk2(bflo(o.y) + bflo(g.y) * a[2], bfhi(o.y) + bfhi(g.y) * a[3]);
                        *(u32x2*)(mix + (row * 1024u + c)) = w; }
                __builtin_amdgcn_sched_barrier(0); }
    }
};
struct EpiCmp1 {
    static constexpr bool PERM = false, AFTER_DRAIN = false;
    const float* bias; float* hid;
    __device__ __forceinline__ void operator()(const f32x4 (&acc)[2][2][4][2], const pg8::Unit& u, int wr, int wc, int fr_, int fq_) const {
        int fr = fr_, fq = fq_; asm volatile("" : "+v"(fr), "+v"(fq));
#pragma unroll
        for (int ai = 0; ai < 2; ++ai)
#pragma unroll
            for (int m = 0; m < 4; ++m) { const unsigned row = (unsigned)(u.pm * 256 + 128 * ai + 64 * wr + 16 * m + fr);
#pragma unroll
                for (int bj = 0; bj < 2; ++bj)
#pragma unroll
                    for (int n = 0; n < 2; ++n) { const int c = 64 * wc + 32 * bj + 8 * fq + 4 * n;
                        const f32x4 b = *(const f32x4*)(bias + c); f32x4 x = acc[ai][bj][m][n] + b, y;
#pragma unroll
                        for (int e = 0; e < 4; ++e) { const float t = x[e], z = 0.7978845608028654f * (t + 0.044715f * t * t * t);
                            const float th = 1.0f - 2.0f * __builtin_amdgcn_rcpf(1.0f + __expf(2.0f * z)); y[e] = 0.5f * t * (1.0f + th); }
                        *(f32x4*)(hid + (row * 256u + (unsigned)c)) = y; } }
    }
};
struct EpiStoreF32 {
    static constexpr bool PERM = false, AFTER_DRAIN = false;
    float* hid;
    __device__ __forceinline__ void operator()(const f32x4 (&acc)[2][2][4][2], const pg8::Unit& u, int wr, int wc, int fr_, int fq_) const {
        int fr = fr_, fq = fq_; asm volatile("" : "+v"(fr), "+v"(fq));
#pragma unroll
        for (int ai = 0; ai < 2; ++ai)
#pragma unroll
            for (int m = 0; m < 4; ++m) { const unsigned row = (unsigned)(u.pm * 256 + 128 * ai + 64 * wr + 16 * m + fr);
#pragma unroll
                for (int bj = 0; bj < 2; ++bj)
#pragma unroll
                    for (int n = 0; n < 2; ++n) *(f32x4*)(hid + (row * 256u + (unsigned)(64 * wc + 32 * bj + 8 * fq + 4 * n))) = acc[ai][bj][m][n]; }
    }
};
__device__ __forceinline__ unsigned gq8(float x) { return (unsigned)(sigmoidf_(x) * 255.0f + 0.5f); }
struct EpiInproj {
    static constexpr bool PERM = false, AFTER_DRAIN = false;
    unsigned char* wsb; const float* nwb;
    __device__ __forceinline__ void operator()(const f32x4 (&acc)[2][2][4][2], const pg8::Unit& u, int wr, int wc, int fr_, int fq_) const {
        int fr = fr_, fq = fq_; asm volatile("" : "+v"(fr), "+v"(fq));
        const int t = u.pn; unsigned char* hb = wsb + WS_B; float* nsg = (float*)(wsb + WS_NSG); bf16_t* brg = (bf16_t*)(wsb + WS_A);
        const float* mqn = nwb; const float* mkn = nwb + 64; const float* nqn = nwb + 128; const float* nkn = nwb + 192;
        if (t <= 10) {
            const int hd = 4 * t + wc;
            const int grp = hd < 24 ? (hd >> 2) : (hd < 32 ? 6 : 7 + ((hd - 32) >> 1));
            const int hh = hd < 24 ? (hd & 3) : (hd < 32 ? hd - 24 : (hd & 1));
            const int H = grp < 6 ? 4 : (grp == 6 ? 8 : 2);
            bf16_t* base = (bf16_t*)(hb + (grp <= 6 ? (size_t)16 * grp : (size_t)(128 + 8 * (grp - 7))) * MiB);
            const bool trans = (grp == 2) | (grp == 5) | (grp == 10) | (grp == 12);
            const bool norm = (grp == 3) | (grp == 4) | (grp == 6) | (grp == 9) | (grp == 11);
            const float qs = ((grp == 0) | (grp == 3) | (grp == 6)) ? 0.125f * L2E : 1.0f;
            const float* nw = grp == 3 ? mqn : (grp == 4 ? mkn : (grp == 6 ? nqn : (grp == 9 ? nkn + 64 : nkn + 128)));
#pragma unroll
            for (int ai = 0; ai < 2; ++ai)
#pragma unroll
                for (int m = 0; m < 4; ++m) { const int row = u.pm * 256 + 128 * ai + 64 * wr + 16 * m + fr; const int b = row >> 13, s = row & 8191;
                    float v[2][8];
#pragma unroll
                    for (int bj = 0; bj < 2; ++bj)
#pragma unroll
                        for (int n = 0; n < 2; ++n)
#pragma unroll
                            for (int e = 0; e < 4; ++e) v[bj][4 * n + e] = acc[ai][bj][m][n][e];
                    float sc = qs;
                    if (norm) { float ss = 0.f;
#pragma unroll
                        for (int bj = 0; bj < 2; ++bj)
#pragma unroll
                            for (int j = 0; j < 8; ++j) ss += v[bj][j] * v[bj][j];
                        ss += __shfl_xor(ss, 16); ss += __shfl_xor(ss, 32);
                        sc = qs * __builtin_amdgcn_rsqf(ss * (1.0f / 64.0f) + 1e-6f);
#pragma unroll
                        for (int bj = 0; bj < 2; ++bj) { const f32x4 w0 = *(const f32x4*)(nw + 32 * bj + 8 * fq), w1 = *(const f32x4*)(nw + 32 * bj + 8 * fq + 4);
#pragma unroll
                            for (int e = 0; e < 4; ++e) { v[bj][e] *= w0[e]; v[bj][4 + e] *= w1[e]; } } }
                    if (!trans) {
#pragma unroll
                        for (int bj = 0; bj < 2; ++bj) { u32x4 w; w.x = pk2(v[bj][0] * sc, v[bj][1] * sc); w.y = pk2(v[bj][2] * sc, v[bj][3] * sc); w.z = pk2(v[bj][4] * sc, v[bj][5] * sc); w.w = pk2(v[bj][6] * sc, v[bj][7] * sc);
                            *(u32x4*)(base + (unsigned)(((b * H + hh) * SEQ + s) * 64 + 32 * bj + 8 * fq)) = w; }
                    } else {
#pragma unroll
                        for (int bj = 0; bj < 2; ++bj)
#pragma unroll
                            for (int j = 0; j < 8; j += 2) { const unsigned w = pk2(v[bj][j], v[bj][j + 1]); bf16_t* d = base + (unsigned)(((b * H + hh) * 64 + 32 * bj + 8 * fq + j) * SEQ + s);
                                d[0] = (bf16_t)(w & 0xffffu); d[SEQ] = (bf16_t)(w >> 16); }
                    } }
        } else if (t == 11) {
            if (wc == 0 && fq < 3) {
#pragma unroll
                for (int ai = 0; ai < 2; ++ai)
#pragma unroll
                    for (int m = 0; m < 4; ++m) { const unsigned row = (unsigned)(u.pm * 256 + 128 * ai + 64 * wr + 16 * m + fr);
#pragma unroll
                        for (int n = 0; n < 2; ++n) { f32x4 y;
#pragma unroll
                            for (int e = 0; e < 4; ++e) y[e] = sigmoidf_(acc[ai][0][m][n][e]);
                            *(f32x4*)(nsg + (row * 24u + (unsigned)(8 * fq + 4 * n))) = y; } }
            }
        } else {
#pragma unroll
            for (int ai = 0; ai < 2; ++ai)
#pragma unroll
                for (int m = 0; m < 4; ++m) { const unsigned row = (unsigned)(u.pm * 256 + 128 * ai + 64 * wr + 16 * m + fr);
#pragma unroll
                    for (int bj = 0; bj < 2; ++bj) { const f32x4 a0 = acc[ai][bj][m][0], a1 = acc[ai][bj][m][1]; u32x2 w;
                        w.x = gq8(a0[0]) | (gq8(a0[1]) << 8) | (gq8(a0[2]) << 16) | (gq8(a0[3]) << 24);
                        w.y = gq8(a1[0]) | (gq8(a1[1]) << 8) | (gq8(a1[2]) << 16) | (gq8(a1[3]) << 24);
                        *(u32x2*)((unsigned char*)brg + (row * 3072u + (unsigned)((t - 12) * 256 + 64 * wc + 32 * bj + 8 * fq))) = w; } }
        }
    }
};

template <int MAP> __device__ __forceinline__ void prep_w(const float* __restrict__ W, int K, int ldw, bf16_t* __restrict__ Bt, int Np, int ldb, LAS unsigned char* lds, int tid, int bx, int G) {
    const int ntp = Np >> 6, ntiles = ntp * (K >> 6), w = tid >> 6, lane = tid & 63;
    float v[8];
    int tile = bx;
    if (tile < ntiles) { const int tk = tile / ntp, tp = tile - tk * ntp; const int col = mapcol<MAP>(tp * 64 + lane); const float* s = W + (size_t)(tk * 64 + 8 * w) * ldw + (col < 0 ? 0 : col);
#pragma unroll
        for (int i = 0; i < 8; ++i) v[i] = col >= 0 ? s[(size_t)i * ldw] : 0.f; }
    for (; tile < ntiles; tile += G) {
        const int tk = tile / ntp, tp = tile - tk * ntp;
        u32x4 pw; pw.x = pk2(v[0], v[1]); pw.y = pk2(v[2], v[3]); pw.z = pk2(v[4], v[5]); pw.w = pk2(v[6], v[7]);
        *(LAS u32x4*)(lds + lane * 144 + w * 16) = pw;
        __syncthreads();
        const int nx = tile + G;
        if (nx < ntiles) { const int tk2 = nx / ntp, tp2 = nx - tk2 * ntp; const int col = mapcol<MAP>(tp2 * 64 + lane); const float* s = W + (size_t)(tk2 * 64 + 8 * w) * ldw + (col < 0 ? 0 : col);
#pragma unroll
            for (int i = 0; i < 8; ++i) v[i] = col >= 0 ? s[(size_t)i * ldw] : 0.f; }
        { const int p = tid >> 3, pc = tid & 7; const u32x4 o = *(LAS const u32x4*)(lds + p * 144 + pc * 16);
            *(u32x4*)(Bt + (size_t)(tp * 64 + p) * ldb + tk * 64 + pc * 8) = o; }
        __syncthreads();
    }
}
__device__ __forceinline__ void rmsnorm_rows(const float* __restrict__ x, const float* __restrict__ g, bf16_t* __restrict__ h, int gwave, int nwaves, int lane) {
    for (int row = gwave; row < MTOK; row += nwaves) {
        const f32x4* xr = (const f32x4*)(x + (size_t)row * DM); f32x4 v[4]; float ss = 0.f;
#pragma unroll
        for (int i = 0; i < 4; ++i) { v[i] = xr[lane + 64 * i]; ss += v[i][0] * v[i][0] + v[i][1] * v[i][1] + v[i][2] * v[i][2] + v[i][3] * v[i][3]; }
        ss = wave_sum(ss); const float rs = __builtin_amdgcn_rsqf(ss * (1.0f / DM) + 1e-6f);
#pragma unroll
        for (int i = 0; i < 4; ++i) { const f32x4 gv = ((const f32x4*)g)[lane + 64 * i]; u32x2 w; w.x = pk2(v[i][0] * rs * gv[0], v[i][1] * rs * gv[1]); w.y = pk2(v[i][2] * rs * gv[2], v[i][3] * rs * gv[3]);
            *(u32x2*)(h + (size_t)row * DM + (lane + 64 * i) * 4) = w; }
    }
}

#define MFMA32(a, b, c) __builtin_amdgcn_mfma_f32_32x32x16_bf16((a), (b), (c), 0, 0, 0)
__device__ __forceinline__ void stage_ld(const bf16_t* K, const bf16_t* Vt, int ldvt, int key0, int tid, u32x4& rk, u32x4& rv) {
    const int row = tid >> 3, pc = tid & 7;
    rk = *(const u32x4*)(K + (size_t)(key0 + row) * 64 + pc * 8);
    rv = *(const u32x4*)(Vt + (size_t)row * ldvt + key0 + pc * 8);
}
__device__ __forceinline__ void stage_st(LAS unsigned char* lds, int buf, int tid, const u32x4& rk, const u32x4& rv) {
    const int row = tid >> 3, pc = tid & 7; LAS unsigned char* p = lds + buf * 18432 + row * 144 + pc * 16;
    *(LAS u32x4*)p = rk; *(LAS u32x4*)(p + 9216) = rv;
}
__device__ __forceinline__ void load_q(const bf16_t* qrow, int h, bf16x8 (&qf)[4]) {
#pragma unroll
    for (int kk = 0; kk < 4; ++kk) qf[kk] = *(const bf16x8*)(qrow + 16 * kk + 8 * h);
}
__device__ __forceinline__ f32x16 qk_sub(LAS const unsigned char* ks, int sub, const bf16x8 (&qf)[4], int r, int h, float init = 0.f) {
    const int pr = (r & 0x13) | ((r & 4) << 1) | ((r & 8) >> 1);
    LAS const unsigned char* p = ks + (32 * sub + pr) * 144 + h * 16;
    f32x16 st;
#pragma unroll
    for (int i = 0; i < 16; ++i) st[i] = init;
#pragma unroll
    for (int kk = 0; kk < 4; ++kk) { const bf16x8 kf = *(LAS const bf16x8*)(p + kk * 32); st = MFMA32(kf, qf[kk], st); }
    return st;
}
__device__ __forceinline__ void pv_sub(LAS const unsigned char* vs, int sub, const f32x16& p, f32x16 (&ot)[2], int r, int h) {
#pragma unroll
    for (int j = 0; j < 2; ++j) {
        u32x4 w; w.x = pk2(p[8 * j], p[8 * j + 1]); w.y = pk2(p[8 * j + 2], p[8 * j + 3]); w.z = pk2(p[8 * j + 4], p[8 * j + 5]); w.w = pk2(p[8 * j + 6], p[8 * j + 7]);
        const bf16x8 pf = __builtin_bit_cast(bf16x8, w);
#pragma unroll
        for (int mt = 0; mt < 2; ++mt) { const bf16x8 vf = *(LAS const bf16x8*)(vs + (32 * mt + r) * 144 + (32 * sub + 16 * j + 8 * h) * 2); ot[mt] = MFMA32(vf, pf, ot[mt]); }
    }
}
constexpr int BT_N = 288, BT_FAR = 64 + 223;
template <int MODE> __device__ __forceinline__ void soft_sub(f32x16& st, float& lsum, bool lane_valid, int dist0, int dmax, LAS const float* bt) {
    if (MODE == 0) {
#pragma unroll
        for (int i = 0; i < 16; ++i) { const float p = ex2(st[i]); lsum += p; st[i] = p; }
    } else if (MODE == 2) {
        const float cf = lane_valid ? bt[BT_FAR] : -3.0e38f;
#pragma unroll
        for (int i = 0; i < 16; ++i) { const int dist = dist0 - (16 * (i >> 3) + (i & 7)); const float b = dist < dmax ? cf : -3.0e38f;
            const float p = ex2(st[i] + b); lsum += p; st[i] = p; }
    } else if (MODE == 1) {
        float bb[16];
#pragma unroll
        for (int j = 0; j < 2; ++j) { int db = dist0 - 16 * j; db = db < -57 ? -57 : (db > 223 ? 223 : db); if (!lane_valid) db = -57;
            LAS const float* p = bt + (db + 64);
#pragma unroll
            for (int k = 0; k < 8; ++k) bb[8 * j + k] = p[-k]; }
#pragma unroll
        for (int i = 0; i < 16; ++i) { const float p = ex2(st[i] + bb[i]); lsum += p; st[i] = p; }
    } else {
        float bb[16];
#pragma unroll
        for (int i = 0; i < 16; ++i) { int d = dist0 - 16 * (16 * (i >> 3) + (i & 7)); d = d < -64 ? -64 : (d > 223 ? 223 : d); bb[i] = bt[d + 64]; }
#pragma unroll
        for (int i = 0; i < 16; ++i) { const float p = ex2(st[i] + bb[i]); lsum += p; st[i] = p; }
    }
}
__device__ __forceinline__ bf16x8 pack_p(const f32x16& p, int j) {
    u32x4 w; w.x = pk2(p[8 * j], p[8 * j + 1]); w.y = pk2(p[8 * j + 2], p[8 * j + 3]); w.z = pk2(p[8 * j + 4], p[8 * j + 5]); w.w = pk2(p[8 * j + 6], p[8 * j + 7]);
    return __builtin_bit_cast(bf16x8, w);
}
template <int MODE> __device__ __forceinline__ void tile_soft_gen(LAS const unsigned char* ks, LAS const unsigned char* vs, const bf16x8 (&qf)[4], f32x16 (&ot)[2], float& lsum,
                                                              bool lane_valid, int dist00, int dmax, LAS const float* bt, int r, int h) {
    const float init = MODE == 0 ? (lane_valid ? bt[BT_FAR] : -3.0e38f) : 0.f;
    const int pr = (r & 0x13) | ((r & 4) << 1) | ((r & 8) >> 1);
    LAS const unsigned char* kp = ks + pr * 144 + h * 16; LAS const unsigned char* vp = vs + r * 144 + h * 16;
    bf16x8 k0[4], k1[4], v0[2][2], v1[2][2];
#pragma unroll
    for (int kk = 0; kk < 4; ++kk) { k0[kk] = *(LAS const bf16x8*)(kp + kk * 32); k1[kk] = *(LAS const bf16x8*)(kp + 32 * 144 + kk * 32); }
    __builtin_amdgcn_sched_barrier(0);
    f32x16 s0, s1;
#pragma unroll
    for (int i = 0; i < 16; ++i) { s0[i] = init; s1[i] = init; }
#pragma unroll
    for (int kk = 0; kk < 4; ++kk) s0 = MFMA32(k0[kk], qf[kk], s0);
#pragma unroll
    for (int mt = 0; mt < 2; ++mt)
#pragma unroll
        for (int j = 0; j < 2; ++j) v0[mt][j] = *(LAS const bf16x8*)(vp + 32 * mt * 144 + 32 * j);
    __builtin_amdgcn_sched_barrier(0);
#pragma unroll
    for (int kk = 0; kk < 4; ++kk) s1 = MFMA32(k1[kk], qf[kk], s1);
#pragma unroll
    for (int mt = 0; mt < 2; ++mt)
#pragma unroll
        for (int j = 0; j < 2; ++j) v1[mt][j] = *(LAS const bf16x8*)(vp + 32 * mt * 144 + 64 + 32 * j);
    soft_sub<MODE>(s0, lsum, lane_valid, dist00, dmax, bt);
    __builtin_amdgcn_sched_barrier(0);
#pragma unroll
    for (int j = 0; j < 2; ++j) { const bf16x8 pf = pack_p(s0, j); ot[0] = MFMA32(v0[0][j], pf, ot[0]); ot[1] = MFMA32(v0[1][j], pf, ot[1]); }
    soft_sub<MODE>(s1, lsum, lane_valid, dist00 - (MODE == 3 ? 512 : 32), dmax, bt);
    __builtin_amdgcn_sched_barrier(0);
#pragma unroll
    for (int j = 0; j < 2; ++j) { const bf16x8 pf = pack_p(s1, j); ot[0] = MFMA32(v1[0][j], pf, ot[0]); ot[1] = MFMA32(v1[1][j], pf, ot[1]); }
}
#define SOFT4(st_, i0_) { _Pragma("unroll") for (int i_ = (i0_); i_ < (i0_) + 4; ++i_) { const float p_ = ex2(st_[i_]); lsum += p_; st_[i_] = p_; } }
__device__ __forceinline__ void tile_soft_far(LAS const unsigned char* ks, LAS const unsigned char* vs, const bf16x8 (&qf)[4], f32x16 (&ot)[2], float& lsum, bool lane_valid, LAS const float* bt, int r, int h) {
    const float init = lane_valid ? bt[BT_FAR] : -3.0e38f;
    const int pr = (r & 0x13) | ((r & 4) << 1) | ((r & 8) >> 1);
    LAS const unsigned char* kp = ks + pr * 144 + h * 16; LAS const unsigned char* vp = vs + r * 144 + h * 16;
    bf16x8 k0[4], k1[4], v0[2][2], v1[2][2];
#pragma unroll
    for (int kk = 0; kk < 4; ++kk) { k0[kk] = *(LAS const bf16x8*)(kp + kk * 32); k1[kk] = *(LAS const bf16x8*)(kp + 32 * 144 + kk * 32); }
    __builtin_amdgcn_sched_barrier(0);
    f32x16 s0, s1;
#pragma unroll
    for (int i = 0; i < 16; ++i) { s0[i] = init; s1[i] = init; }
#pragma unroll
    for (int kk = 0; kk < 4; ++kk) s0 = MFMA32(k0[kk], qf[kk], s0);
#pragma unroll
    for (int mt = 0; mt < 2; ++mt)
#pragma unroll
        for (int j = 0; j < 2; ++j) { v0[mt][j] = *(LAS const bf16x8*)(vp + 32 * mt * 144 + 32 * j); v1[mt][j] = *(LAS const bf16x8*)(vp + 32 * mt * 144 + 64 + 32 * j); }
    __builtin_amdgcn_sched_barrier(0);
    s1 = MFMA32(k1[0], qf[0], s1); SOFT4(s0, 0);  __builtin_amdgcn_sched_barrier(0);
    s1 = MFMA32(k1[1], qf[1], s1); SOFT4(s0, 4);  __builtin_amdgcn_sched_barrier(0);
    s1 = MFMA32(k1[2], qf[2], s1); SOFT4(s0, 8);  __builtin_amdgcn_sched_barrier(0);
    s1 = MFMA32(k1[3], qf[3], s1); SOFT4(s0, 12); __builtin_amdgcn_sched_barrier(0);
    const bf16x8 pa = pack_p(s0, 0);
    ot[0] = MFMA32(v0[0][0], pa, ot[0]); SOFT4(s1, 0);  __builtin_amdgcn_sched_barrier(0);
    ot[1] = MFMA32(v0[1][0], pa, ot[1]); SOFT4(s1, 4);  const bf16x8 pb = pack_p(s0, 1); __builtin_amdgcn_sched_barrier(0);
    ot[0] = MFMA32(v0[0][1], pb, ot[0]); SOFT4(s1, 8);  __builtin_amdgcn_sched_barrier(0);
    ot[1] = MFMA32(v0[1][1], pb, ot[1]); SOFT4(s1, 12); __builtin_amdgcn_sched_barrier(0);
#pragma unroll
    for (int j = 0; j < 2; ++j) { const bf16x8 pf = pack_p(s1, j); ot[0] = MFMA32(v1[0][j], pf, ot[0]); ot[1] = MFMA32(v1[1][j], pf, ot[1]); }
}
template <int MODE> __device__ __forceinline__ void tile_soft(LAS const unsigned char* ks, LAS const unsigned char* vs, const bf16x8 (&qf)[4], f32x16 (&ot)[2], float& lsum,
                                                              bool lane_valid, int dist00, int dmax, LAS const float* bt, int r, int h) {
    if (MODE == 0) tile_soft_far(ks, vs, qf, ot, lsum, lane_valid, bt, r, h);
    else tile_soft_gen<MODE>(ks, vs, qf, ot, lsum, lane_valid, dist00, dmax, bt, r, h);
}
__device__ __forceinline__ void zero_ot(f32x16 (&ot)[2]) {
#pragma unroll
    for (int i = 0; i < 16; ++i) { ot[0][i] = 0.f; ot[1][i] = 0.f; }
}
__device__ __forceinline__ void store_ot(bf16_t* orow, const f32x16 (&ot)[2], int h) {
#pragma unroll
    for (int mt = 0; mt < 2; ++mt)
#pragma unroll
        for (int g = 0; g < 4; ++g) { u32x2 w; w.x = pk2(ot[mt][4 * g], ot[mt][4 * g + 1]); w.y = pk2(ot[mt][4 * g + 2], ot[mt][4 * g + 3]);
            *(u32x2*)(orow + 32 * mt + 8 * g + 4 * h) = w; }
}

#define TILE_LOOP(KP, VP, LDV, KEY_FIRST, NT, BODY) do { \
    int key0 = (KEY_FIRST); const int nt_ = (NT); u32x4 rkA_, rvA_, rkB_, rvB_; \
    __syncthreads(); \
    stage_ld((KP), (VP), (LDV), key0, tid, rkA_, rvA_); stage_st(lds, 0, tid, rkA_, rvA_); \
    if (nt_ > 1) stage_ld((KP), (VP), (LDV), key0 + 64, tid, rkA_, rvA_); \
    __syncthreads(); \
    for (int it_ = 0; it_ < nt_; ++it_) { const int buf_ = it_ & 1; \
        if (it_ + 2 < nt_) stage_ld((KP), (VP), (LDV), key0 + 128, tid, rkB_, rvB_); \
        { LAS const unsigned char* ks = lds + buf_ * 18432; LAS const unsigned char* vs = ks + 9216; BODY } \
        if (it_ + 1 < nt_) stage_st(lds, buf_ ^ 1, tid, rkA_, rvA_); \
        __syncthreads(); key0 += 64; rkA_ = rkB_; rvA_ = rvB_; } } while (0)

__device__ __forceinline__ void sb_sub(LAS const unsigned char* vs, int sb, f32x16& st, f32x16 (&ot)[2], float& C, int key0, int t, int r, int h) {
    float ls[16]; float Rlo = 0.f, Rhi = 0.f;
#pragma unroll
    for (int i = 0; i < 16; ++i) { const int s = key0 + 32 * sb + 16 * (i >> 3) + 8 * h + (i & 7); const bool causal = s < t;
        const float u = st[i]; const float sp = fmaxf(u, 0.f) + lg2(1.0f + ex2(-fabsf(u)));
        ls[i] = causal ? -sp : 0.f; st[i] = causal ? (u - sp) : -3.0e38f;
        if (i < 8) Rlo += ls[i]; else Rhi += ls[i]; }
    const float Plo = __shfl_xor(Rlo, 32), Phi = __shfl_xor(Rhi, 32);
    float la = C + (h == 0 ? Phi : 0.f);
#pragma unroll
    for (int i = 15; i >= 8; --i) { const float a = ex2(st[i] + la); la += ls[i]; st[i] = a; }
    la = C + Rhi + Phi + (h == 0 ? Plo : 0.f);
#pragma unroll
    for (int i = 7; i >= 0; --i) { const float a = ex2(st[i] + la); la += ls[i]; st[i] = a; }
    C += (Rlo + Rhi) + (Plo + Phi);
    pv_sub(vs, sb, st, ot, r, h);
}
__device__ __forceinline__ void sb_unit(LAS unsigned char* lds, const unsigned char* hb, bf16_t* omix, int b, int hd, int qblk, int tid) {
    const int lane = tid & 63, w = tid >> 6, r = lane & 31, h = lane >> 5;
    const int bh = b * 4 + hd, q0 = qblk * 256, t = q0 + 32 * w + r;
    const bf16_t* Q = (const bf16_t*)(hb + HB_SBQ * MiB) + ((size_t)bh * SEQ + t) * 64;
    const bf16_t* K = (const bf16_t*)(hb + HB_SBK * MiB) + (size_t)bh * SEQ * 64;
    const bf16_t* Vt = (const bf16_t*)(hb + HB_SBVT * MiB) + (size_t)bh * 64 * SEQ;
    bf16x8 qf[4]; load_q(Q, h, qf);
    f32x16 ot[2]; zero_ot(ot);
    float C = 0.f;
    int key0 = q0 + 192; u32x4 rkA_, rvA_, rkB_, rvB_;
    __syncthreads();
    stage_ld(K, Vt, SEQ, key0, tid, rkA_, rvA_); stage_st(lds, 0, tid, rkA_, rvA_);
    if (key0 >= 64) stage_ld(K, Vt, SEQ, key0 - 64, tid, rkA_, rvA_);
    __syncthreads();
    int buf = 0;
    for (;;) {
        const bool has_next = key0 >= 64;
        if (key0 >= 128) stage_ld(K, Vt, SEQ, key0 - 128, tid, rkB_, rvB_);
        if (key0 <= q0 + 32 * w + 31) {
            LAS const unsigned char* ks = lds + buf * 18432; LAS const unsigned char* vs = ks + 9216;
            f32x16 s1 = qk_sub(ks, 1, qf, r, h); f32x16 s0 = qk_sub(ks, 0, qf, r, h);
            if (key0 + 32 <= q0 + 32 * w + 31) sb_sub(vs, 1, s1, ot, C, key0, t, r, h);
            sb_sub(vs, 0, s0, ot, C, key0, t, r, h);
        }
        const int alive = __syncthreads_or(C > -150.0f ? 1 : 0);
        if (!(has_next && alive)) break;
        stage_st(lds, buf ^ 1, tid, rkA_, rvA_);
        __syncthreads(); buf ^= 1; key0 -= 64; rkA_ = rkB_; rvA_ = rvB_;
    }
    store_ot(omix + ((size_t)b * SEQ + t) * DM + hd * 64, ot, h);
}

__device__ __forceinline__ void moba_unit(LAS unsigned char* lds, const unsigned char* hb, const float* kmean, bf16_t* omix, int b, int hd, int blk, int tid) {
    const int lane = tid & 63, w = tid >> 6, r = lane & 31, h = lane >> 5;
    const int bh = b * 4 + hd, q0 = blk * 256, t = q0 + 32 * w + r;
    const bf16_t* Qb = (const bf16_t*)(hb + HB_MBQ * MiB) + ((size_t)bh * SEQ + q0) * 64;
    const bf16_t* K = (const bf16_t*)(hb + HB_MBK * MiB) + (size_t)bh * SEQ * 64;
    const bf16_t* Vt = (const bf16_t*)(hb + HB_MBVT * MiB) + (size_t)bh * 64 * SEQ;
    LAS unsigned* misc = (LAS unsigned*)(lds + ATT_MISC); LAS unsigned* selm = (LAS unsigned*)(lds + ATT_SEL);
    LAS float* km = (LAS float*)(lds + ATT_X); LAS float* sc = km + 32 * 64;
    LAS const float* bt = (LAS const float*)(lds + ATT_BT) + hd * BT_N;
    __syncthreads();
    if (tid == 0) misc[1] = 0u;
    if (blk > 3) {
        for (int i = tid; i < blk * 64; i += 512) km[i] = kmean[(size_t)bh * 32 * 64 + i];
        __syncthreads();
        { const int qi = tid & 255, part = tid >> 8; float q[64];
            const u32x4* qp = (const u32x4*)(Qb + (size_t)qi * 64);
#pragma unroll
            for (int c = 0; c < 8; ++c) { const u32x4 v = qp[c]; q[8 * c] = bflo(v.x); q[8 * c + 1] = bfhi(v.x); q[8 * c + 2] = bflo(v.y); q[8 * c + 3] = bfhi(v.y); q[8 * c + 4] = bflo(v.z); q[8 * c + 5] = bfhi(v.z); q[8 * c + 6] = bflo(v.w); q[8 * c + 7] = bfhi(v.w); }
            for (int n = part; n < blk; n += 2) { float a = 0.f;
#pragma unroll
                for (int d = 0; d < 64; ++d) a = fmaf(q[d], km[n * 64 + d], a);
                sc[qi * 33 + n] = a; } }
        __syncthreads();
        if (tid < 256) { unsigned m = 0u; float sv[32];
#pragma unroll
            for (int n = 0; n < 32; ++n) sv[n] = n < blk ? sc[tid * 33 + n] : -3.0e38f;
#pragma unroll
            for (int k = 0; k < 3; ++k) { float best = -3.0e38f; int bi = 0;
#pragma unroll
                for (int n = 0; n < 32; ++n) { const bool take = !((m >> n) & 1u) && sv[n] > best; best = take ? sv[n] : best; bi = take ? n : bi; }
                m |= 1u << bi; }
            selm[tid] = m; atomicOr((unsigned*)&misc[1], m); }
    } else {
        const unsigned m = (1u << blk) - 1u; if (tid < 256) selm[tid] = m; if (tid == 0) misc[1] = m;
    }
    __syncthreads();
    const unsigned uni = misc[1], sel = selm[32 * w + r];
    bf16x8 qf[4]; load_q(Qb + (size_t)(32 * w + r) * 64, h, qf);
    f32x16 ot[2]; zero_ot(ot); float lsum = 0.f;
    const int kend = q0 + 256;
#define MOBA_NEXT(k_, out_) do { int kk_ = (k_) + 64; while (kk_ < q0 && !((uni >> (kk_ >> 8)) & 1u)) kk_ = (kk_ | 255) + 1; (out_) = kk_; } while (0)
    int key0, knext, knext2; MOBA_NEXT(-64, key0); MOBA_NEXT(key0, knext);
    u32x4 rkA_, rvA_, rkB_, rvB_;
    stage_ld(K, Vt, SEQ, key0, tid, rkA_, rvA_); stage_st(lds, 0, tid, rkA_, rvA_);
    if (knext < kend) stage_ld(K, Vt, SEQ, knext, tid, rkA_, rvA_);
    __syncthreads();
    int buf = 0;
    while (key0 < kend) {
        MOBA_NEXT(knext, knext2);
        if (knext < kend && knext2 < kend) stage_ld(K, Vt, SEQ, knext2, tid, rkB_, rvB_);
        {
            LAS const unsigned char* ks = lds + buf * 18432; LAS const unsigned char* vs = ks + 9216;
            const int n = key0 >> 8; const bool own = (n == blk);
            const bool lane_valid = own ? true : (((sel >> n) & 1u) != 0u);
            const bool skip = own ? (key0 > q0 + 32 * w + 31) : (__ballot(lane_valid) == 0ull);
            if (!skip) {
                const bool near = (q0 + 32 * w) - (key0 + 63) < 128;
                const int dist00 = t - (key0 + 8 * h);
                if (near) tile_soft<1>(ks, vs, qf, ot, lsum, lane_valid, dist00, 0, bt, r, h);
                else tile_soft<0>(ks, vs, qf, ot, lsum, lane_valid, dist00, 0, bt, r, h);
            }
        }
        if (knext < kend) stage_st(lds, buf ^ 1, tid, rkA_, rvA_);
        __syncthreads(); buf ^= 1; key0 = knext; knext = knext2; rkA_ = rkB_; rvA_ = rvB_;
    }
#undef MOBA_NEXT
    const float l = lsum + __shfl_xor(lsum, 32); const float inv = 1.0f / fmaxf(l, 1e-30f);
#pragma unroll
    for (int i = 0; i < 16; ++i) { ot[0][i] *= inv; ot[1][i] *= inv; }
    store_ot(omix + ((size_t)b * SEQ + t) * DM + 256 + hd * 64, ot, h);
}

__device__ __forceinline__ void imp_sub(f32x16& st, float invc, int nbase, LAS float* improw, int r) {
#pragma unroll
    for (int j = 0; j < 2; ++j) { const int a = (nbase + 16 * j) >> 3;
        float s0 = ((st[8 * j] + st[8 * j + 1]) + (st[8 * j + 2] + st[8 * j + 3])) * invc;
        float s1 = ((st[8 * j + 3] + st[8 * j + 4]) + (st[8 * j + 5] + st[8 * j + 6]) + st[8 * j + 7]) * invc;
        float s2 = st[8 * j + 7] * invc;
        s0 += __shfl_xor(s0, 8); s0 += __shfl_xor(s0, 16); s1 += __shfl_xor(s1, 8); s1 += __shfl_xor(s1, 16); s2 += __shfl_xor(s2, 8); s2 += __shfl_xor(s2, 16);
        if (r < 8) { LAS float* ip = improw + 2 * a; ip[0] += s0; ip[1] += s1; if (2 * a + 2 < 128) ip[2] += s2; } }
}
__device__ __forceinline__ void nsa_unit(LAS unsigned char* lds, const unsigned char* hb, const bf16_t* kc, const bf16_t* vct, const float* nsg, bf16_t* omix, int b, int g, int c, int tid) {
    const int lane = tid & 63, w = tid >> 6, r = lane & 31, h = lane >> 5;
    const int bg = b * 2 + g, q0 = c * 64, ql = 8 * w + (r & 7), t = q0 + ql, hq = 4 * g + (r >> 3);
    const bf16_t* Q = (const bf16_t*)(hb + HB_NSQ * MiB) + ((size_t)(b * 8 + hq) * SEQ + t) * 64;
    LAS unsigned* selm = (LAS unsigned*)(lds + ATT_SEL); LAS float* imp = (LAS float*)(lds + ATT_X);
    LAS const float* bt = (LAS const float*)(lds + ATT_BT) + (4 + hq) * BT_N;
    const float* gate = nsg + ((size_t)b * SEQ + t) * 24 + hq;
    bf16x8 qf[4]; load_q(Q, h, qf);
    f32x16 ot[2]; zero_ot(ot);
    LAS unsigned* oal = (LAS unsigned*)(lds + ATT_OA) + (w * 16) * 64 + lane;
    const bf16_t* Kc = kc + (size_t)bg * 512 * 64; const bf16_t* Vc = vct + (size_t)bg * 64 * 512;
    const int ntc = (4 * c + 3 + 63) >> 6;
    float lsum = 0.f;
    TILE_LOOP(Kc, Vc, 512, 0, ntc, {
        tile_soft<3>(ks, vs, qf, ot, lsum, true, t - 31 - 16 * (key0 + 8 * h), 0, bt, r, h); });
    const float lc = lsum + __shfl_xor(lsum, 32); const float invc = 1.0f / fmaxf(lc, 1e-30f);
    { const float gc = gate[0] * invc;
#pragma unroll
        for (int i = 0; i < 8; ++i) { oal[i * 64] = pk2(ot[0][2 * i] * gc, ot[0][2 * i + 1] * gc); oal[(8 + i) * 64] = pk2(ot[1][2 * i] * gc, ot[1][2 * i + 1] * gc); } }
    for (int i = tid; i < 64 * 129; i += 512) imp[i] = 0.f;
    if (tid < 256) selm[tid] = 0u;
    TILE_LOOP(Kc, Vc, 512, 0, ntc, {
        f32x16 s0 = qk_sub(ks, 0, qf, r, h); f32x16 s1 = qk_sub(ks, 1, qf, r, h); float dummy = 0.f;
        const int dist00 = t - 31 - 16 * (key0 + 8 * h);
        soft_sub<3>(s0, dummy, true, dist00, 0, bt); imp_sub(s0, invc, key0 + 8 * h, imp + ql * 129, r);
        soft_sub<3>(s1, dummy, true, dist00 - 512, 0, bt); imp_sub(s1, invc, key0 + 32 + 8 * h, imp + ql * 129, r); });
    { const int qi = tid >> 3, sub = tid & 7;
        if (c >= 16) {
            { LAS const float* row = imp + qi * 129; unsigned long long kv[16]; int cnt[16];
#pragma unroll
                for (int k = 0; k < 16; ++k) { const int m = 1 + sub + 8 * k; const int mi = m <= 128 ? m : 128; kv[k] = ((unsigned long long)__float_as_uint(row[mi]) << 8) | (unsigned long long)(255 - m); cnt[k] = 0; }
                for (int m2 = 1; m2 <= c - 2; m2 += 8) { unsigned long long kx[8];
#pragma unroll
                    for (int j = 0; j < 8; ++j) { const int mm = m2 + j; const int mi = mm <= 128 ? mm : 128; const float x = row[mi]; kx[j] = mm <= c - 2 ? (((unsigned long long)__float_as_uint(x) << 8) | (unsigned long long)(255 - mm)) : 0ull; }
#pragma unroll
                    for (int j = 0; j < 8; ++j)
#pragma unroll
                        for (int k = 0; k < 16; ++k) cnt[k] += kx[j] > kv[k] ? 1 : 0; }
#pragma unroll
                for (int k = 0; k < 16; ++k) { const int m = 1 + sub + 8 * k; if (m <= c - 2 && cnt[k] < 13) atomicOr((unsigned*)&selm[qi * 4 + (m >> 5)], 1u << (m & 31)); } }
            if (sub == 0) { atomicOr((unsigned*)&selm[qi * 4], 1u); atomicOr((unsigned*)&selm[qi * 4 + ((c - 1) >> 5)], 1u << ((c - 1) & 31)); atomicOr((unsigned*)&selm[qi * 4 + (c >> 5)], 1u << (c & 31)); }
        } else if (sub == 0) selm[qi * 4] = (1u << (c + 1)) - 1u;
    }
    __syncthreads();
    const unsigned sel0 = selm[ql * 4], sel1 = selm[ql * 4 + 1], sel2 = selm[ql * 4 + 2], sel3 = selm[ql * 4 + 3];
    { const bf16_t* Ks = (const bf16_t*)(hb + HB_KS * MiB) + (size_t)bg * SEQ * 64; const bf16_t* Vs = (const bf16_t*)(hb + HB_VST * MiB) + (size_t)bg * 64 * SEQ;
        zero_ot(ot); lsum = 0.f;
        TILE_LOOP(Ks, Vs, SEQ, 0, c + 1, {
            const int m = key0 >> 6; const unsigned sw = m < 32 ? sel0 : (m < 64 ? sel1 : (m < 96 ? sel2 : sel3));
            const bool lane_valid = ((sw >> (m & 31)) & 1u) != 0u;
            if (__ballot(lane_valid) != 0ull) { const int dist00 = t - (key0 + 8 * h);
                if ((c - m) < 3) tile_soft<1>(ks, vs, qf, ot, lsum, lane_valid, dist00, 0, bt, r, h);
                else tile_soft<0>(ks, vs, qf, ot, lsum, lane_valid, dist00, 0, bt, r, h); } });
        const float l = lsum + __shfl_xor(lsum, 32); const float gs = gate[8] / fmaxf(l, 1e-30f);
#pragma unroll
        for (int i = 0; i < 8; ++i) { const unsigned a0 = oal[i * 64], a1 = oal[(8 + i) * 64];
            oal[i * 64] = pk2(bflo(a0) + ot[0][2 * i] * gs, bfhi(a0) + ot[0][2 * i + 1] * gs); oal[(8 + i) * 64] = pk2(bflo(a1) + ot[1][2 * i] * gs, bfhi(a1) + ot[1][2 * i + 1] * gs); } }
    { const bf16_t* Kw = (const bf16_t*)(hb + HB_KW * MiB) + (size_t)bg * SEQ * 64; const bf16_t* Vw = (const bf16_t*)(hb + HB_VWT * MiB) + (size_t)bg * 64 * SEQ;
        zero_ot(ot); lsum = 0.f;
        const int kfirst = q0 >= 512 ? q0 - 512 : 0; const int ntw = ((q0 - kfirst) >> 6) + 1;
        TILE_LOOP(Kw, Vw, SEQ, kfirst, ntw, {
            const int dist00 = t - (key0 + 8 * h);
            if (key0 >= q0 - 128) tile_soft<1>(ks, vs, qf, ot, lsum, true, dist00, 0, bt, r, h);
            else if (key0 == q0 - 512) tile_soft<2>(ks, vs, qf, ot, lsum, true, dist00, 512, bt, r, h);
            else tile_soft<0>(ks, vs, qf, ot, lsum, true, dist00, 0, bt, r, h); });
        const float l = lsum + __shfl_xor(lsum, 32); const float gw = gate[16] / fmaxf(l, 1e-30f);
#pragma unroll
        for (int i = 0; i < 8; ++i) { const unsigned a0 = oal[i * 64], a1 = oal[(8 + i) * 64];
            ot[0][2 * i] = bflo(a0) + ot[0][2 * i] * gw; ot[0][2 * i + 1] = bfhi(a0) + ot[0][2 * i + 1] * gw; ot[1][2 * i] = bflo(a1) + ot[1][2 * i] * gw; ot[1][2 * i + 1] = bfhi(a1) + ot[1][2 * i + 1] * gw; } }
    store_ot(omix + ((size_t)b * SEQ + t) * DM + 512 + hq * 64, ot, h);
}

constexpr int FG_STAGE = 55296, FG_B = 36864, FG_PATCH = 110592;
__device__ __forceinline__ void fg_ld(const bf16_t* A, const bf16_t* Bt, int kt, int tid, u32x4 (&ra)[4], u32x4 (&rb)[2]) {
#pragma unroll
    for (int i = 0; i < 4; ++i) { const unsigned p = (unsigned)(tid + 512 * i); ra[i] = *(const u32x4*)(A + 64 * kt + ((p >> 3) * 1024u + 8u * (p & 7u))); }
#pragma unroll
    for (int i = 0; i < 2; ++i) { const unsigned p = (unsigned)(tid + 512 * i); rb[i] = *(const u32x4*)(Bt + 64 * kt + ((p >> 3) * 1024u + 8u * (p & 7u))); }
}
__device__ __forceinline__ void fg_st(LAS unsigned char* st, int tid, const u32x4 (&ra)[4], const u32x4 (&rb)[2]) {
#pragma unroll
    for (int i = 0; i < 4; ++i) { const int p = tid + 512 * i; *(LAS u32x4*)(st + (p >> 3) * 144 + (p & 7) * 16) = ra[i]; }
#pragma unroll
    for (int i = 0; i < 2; ++i) { const int p = tid + 512 * i; *(LAS u32x4*)(st + FG_B + (p >> 3) * 144 + (p & 7) * 16) = rb[i]; }
}
__device__ __forceinline__ void branch_tile(LAS unsigned char* lds, const bf16_t* omix, const bf16_t* wbr, const bf16_t* brg, bf16_t* mix, int pm, int pn, int tid) {
    const int lane = tid & 63, w = tid >> 6, r = lane & 31, h = lane >> 5, wr = w >> 1, wc = w & 1;
    const bf16_t* A = omix + (size_t)pm * 256 * DM; const bf16_t* Bt = wbr + (size_t)pn * 128 * DM;
    LAS unsigned char* patch = lds + FG_PATCH + w * 2560;
    f32x16 seg[2][2]; unsigned tot[2][2][8];
#pragma unroll
    for (int a = 0; a < 2; ++a)
#pragma unroll
        for (int c = 0; c < 2; ++c)
#pragma unroll
            for (int i = 0; i < 16; ++i) { seg[a][c][i] = 0.f; tot[a][c][i >> 1] = 0u; }
    u32x4 ra0[4], rb0[2], ra1[4], rb1[2];
    __syncthreads();
    fg_ld(A, Bt, 0, tid, ra0, rb0); fg_st(lds, tid, ra0, rb0);
    fg_ld(A, Bt, 1, tid, ra1, rb1);
    __syncthreads();
#define FG_COMPUTE(BUF) { LAS const unsigned char* sa = lds + (BUF) * FG_STAGE + (64 * wr + r) * 144 + h * 16; LAS const unsigned char* sb = lds + (BUF) * FG_STAGE + FG_B + (64 * wc + r) * 144 + h * 16; \
        _Pragma("unroll") for (int kk = 0; kk < 4; ++kk) { const bf16x8 a0 = *(LAS const bf16x8*)(sa + kk * 32), a1 = *(LAS const bf16x8*)(sa + 32 * 144 + kk * 32); \
            const bf16x8 b0 = *(LAS const bf16x8*)(sb + kk * 32), b1 = *(LAS const bf16x8*)(sb + 32 * 144 + kk * 32); \
            seg[0][0] = MFMA32(a0, b0, seg[0][0]); seg[0][1] = MFMA32(a0, b1, seg[0][1]); seg[1][0] = MFMA32(a1, b0, seg[1][0]); seg[1][1] = MFMA32(a1, b1, seg[1][1]); } }
#define FG_BAR() do { asm volatile("s_waitcnt lgkmcnt(0)" ::: "memory"); __builtin_amdgcn_s_barrier(); asm volatile("" ::: "memory"); } while (0)
#pragma unroll 1
    for (int kt = 0; kt < 16; kt += 2) {
        fg_ld(A, Bt, (kt + 2 < 16 ? kt + 2 : 15), tid, ra0, rb0);
        FG_COMPUTE(0);
        fg_st(lds + FG_STAGE, tid, ra1, rb1);
        FG_BAR();
        fg_ld(A, Bt, (kt + 3 < 16 ? kt + 3 : 15), tid, ra1, rb1);
        const bool segend = (kt == 2) || (kt == 6) || (kt == 14);
        const int s = kt == 2 ? 0 : (kt == 6 ? 1 : 2);
        u32x4 g0, g1;
#define FG_GLD(dst, rt_, ct_) { dst = *(const u32x4*)((const unsigned char*)brg + ((unsigned)(pm * 256 + 64 * wr + 32 * (rt_) + (lane >> 1)) * 3072u + (unsigned)(1024 * s + pn * 128 + 64 * wc + 32 * (ct_) + 16 * (lane & 1)))); }
#define FG_GATE(src, rt_, ct_) { *(LAS u32x4*)(patch + (lane >> 1) * 48 + (lane & 1) * 16) = src; }
#define FG_ACC(rt_, ct_) { float gg[16]; \
            _Pragma("unroll") for (int i = 0; i < 16; ++i) { const int tr = 8 * (i >> 2) + 4 * h + (i & 3); gg[i] = (float)(*(LAS const unsigned char*)(patch + tr * 48 + r)) * (1.0f / 255.0f); } \
            _Pragma("unroll") for (int p2 = 0; p2 < 8; ++p2) { const unsigned tv = tot[rt_][ct_][p2]; \
                tot[rt_][ct_][p2] = pk2(fmaf(gg[2 * p2], seg[rt_][ct_][2 * p2], bflo(tv)), fmaf(gg[2 * p2 + 1], seg[rt_][ct_][2 * p2 + 1], bfhi(tv))); seg[rt_][ct_][2 * p2] = 0.f; seg[rt_][ct_][2 * p2 + 1] = 0.f; } }
        if (segend) { FG_GLD(g0, 0, 0); FG_GLD(g1, 0, 1); }
        FG_COMPUTE(1);
        if (segend) {
            FG_GATE(g0, 0, 0); FG_GLD(g0, 1, 0); FG_ACC(0, 0);
            FG_GATE(g1, 0, 1); FG_GLD(g1, 1, 1); FG_ACC(0, 1);
            FG_GATE(g0, 1, 0); FG_ACC(1, 0);
            FG_GATE(g1, 1, 1); FG_ACC(1, 1);
        }
#undef FG_GLD
#undef FG_GATE
#undef FG_ACC
        fg_st(lds, tid, ra0, rb0);
        FG_BAR();
    }
#undef FG_COMPUTE
#undef FG_BAR
#pragma unroll
    for (int rt = 0; rt < 2; ++rt)
#pragma unroll
        for (int ct = 0; ct < 2; ++ct) { const int tok0 = pm * 256 + 64 * wr + 32 * rt, n0 = pn * 128 + 64 * wc + 32 * ct;
#pragma unroll
            for (int p2 = 0; p2 < 8; ++p2) { const int tr = 8 * (p2 >> 1) + 4 * h + 2 * (p2 & 1); const unsigned tv = tot[rt][ct][p2];
                *(LAS unsigned short*)(patch + tr * 80 + r * 2) = (unsigned short)(tv & 0xffffu); *(LAS unsigned short*)(patch + (tr + 1) * 80 + r * 2) = (unsigned short)(tv >> 16); }
#pragma unroll
            for (int j = 0; j < 2; ++j) { const int p = lane + 64 * j; const u32x4 ov = *(LAS const u32x4*)(patch + (p >> 2) * 80 + (p & 3) * 16);
                *(u32x4*)(mix + ((unsigned)(tok0 + (p >> 2)) * 1024u + (unsigned)(n0 + 8 * (p & 3)))) = ov; } }
}

#define LAUNDER_S(x) asm volatile("" : "+s"(x))
#define GAS __attribute__((address_space(1)))
#define INP(k) ({ int k_ = (k); LAUNDER_S(k_); (const float*)(const GAS float*)P.in[k_]; })
#define POUT ((float*)(GAS float*)P.out)
#define PHASE_BEGIN int L = layer; LAUNDER_S(L); GAS unsigned char* wsg_ = (GAS unsigned char*)P.ws; LAUNDER_S(wsg_); unsigned char* ws = (unsigned char*)wsg_; int G = gridDim.x, bx = blockIdx.x; LAUNDER_S(G); LAUNDER_S(bx); int tid = threadIdx.x; asm volatile("" : "+v"(tid)); const int lane = tid & 63, wave = __builtin_amdgcn_readfirstlane(tid >> 6); (void)lane; (void)wave; (void)G; (void)bx; (void)L; (void)ws;
__global__ void __launch_bounds__(512, 2) hybrid_fwd(Params P) {
    extern __shared__ __attribute__((aligned(16))) unsigned char lds_raw[];
    LAS unsigned char* lds = (LAS unsigned char*)lds_raw;
    cg::grid_group grid = cg::this_grid();
#pragma unroll 1
    for (int layer = 0; layer < 2; ++layer) {
#ifndef REP_A
#define REP_A 1
#endif
#ifndef REP_CD
#define REP_CD 1
#endif
        for (int repa_ = 0; repa_ < REP_A; ++repa_)
        { PHASE_BEGIN
            const int gtid = bx * 512 + tid, gthreads = G * 512, gwave = bx * 8 + wave, nwaves = G * 8;
            prep_w<1>(INP(3) + (size_t)L * DM * NIN, DM, NIN, (bf16_t*)(ws + WS_WIN), NINP, DM, lds, tid, bx, G);
            prep_w<3>(INP(11) + (size_t)L * DM * DM, DM, DM, (bf16_t*)(ws + WS_WBR), DM, DM, lds, tid, bx, G);
            prep_w<0>(INP(12) + (size_t)L * DM * DM, DM, DM, (bf16_t*)(ws + WS_WOUT), DM, DM, lds, tid, bx, G);
            prep_w<2>(INP(14) + (size_t)L * DM * 2 * DFF, DM, 2 * DFF, (bf16_t*)(ws + WS_WGU), 2 * DFF, DM, lds, tid, bx, G);
            prep_w<0>(INP(15) + (size_t)L * DFF * DM, DFF, DM, (bf16_t*)(ws + WS_WDN), DM, DFF, lds, tid, bx, G);
            const float* cw1 = INP(9) + (size_t)L * 2 * 2048 * 256;
            prep_w<0>(cw1, 2048, 256, (bf16_t*)(ws + WS_WC1), 256, 2048, lds, tid, bx, G);
            prep_w<0>(cw1 + 2048 * 256, 2048, 256, (bf16_t*)(ws + WS_WC1) + 256 * 2048, 256, 2048, lds, tid, bx, G);
            rmsnorm_rows(L == 0 ? INP(0) : (const float*)POUT, INP(2) + L * DM, (bf16_t*)(ws + WS_H), gwave, nwaves, lane);
            if (gwave < 512) { const int kv = gwave >> 8, j = gwave & 255; const float* pp = INP(8) + (size_t)L * 2 * 2048 + kv * 2048; const float* ww = cw1 + (size_t)kv * 2048 * 256 + j; float a = 0.f;
#pragma unroll 8
                for (int i = lane; i < 2048; i += 64) a = fmaf(pp[i], ww[(size_t)i * 256], a);
                a = wave_sum(a);
                if (lane == 0) ((float*)(ws + WS_SMALL))[kv * 256 + j] = a; }
            if (bx == 1 && tid < 384) { float* nw = (float*)(ws + WS_SMALL + 2048); const float v = tid < 64 ? (INP(4) + L * 64)[tid] : (tid < 128 ? (INP(5) + L * 64)[tid - 64] : (tid < 192 ? (INP(6) + L * 64)[tid - 128] : (INP(7) + L * 192)[tid - 192])); nw[tid] = v; }
        }
        grid.sync();

        { PHASE_BEGIN
            pg8::Gemm g{(const bf16_t*)(ws + WS_H), (const bf16_t*)(ws + WS_WIN), MTOK, NINP, DM, DM, DM}; pg8::StaticOrder S; S.init(MTOK, NINP, G, bx);
            EpiInproj E{ws, (const float*)(ws + WS_SMALL + 2048)};
#ifndef SKIP_B
            pg8::gemm_phase<EpiInproj, pg8::StaticOrder, true, true>(lds, g, S, E, tid);
#endif
        }
        grid.sync();

        for (int repcd_ = 0; repcd_ < REP_CD; ++repcd_) {
        { PHASE_BEGIN
            if (bx < 128) { const int kv = bx >> 6, ks = (bx >> 4) & 3;
                pg8::Gemm g{(const bf16_t*)(ws + WS_B + (kv ? HB_VCR : HB_KCR) * MiB) + ks * 512, (const bf16_t*)(ws + WS_WC1) + (size_t)kv * 256 * 2048 + ks * 512, 4096, 256, 512, 1024, 2048};
                pg8::StaticOrder S; S.init(4096, 256, G, bx & 15);
                EpiStoreF32 E{(float*)(ws + WS_H) + (size_t)(kv * 4 + ks) * 4096 * 256};
#ifndef SKIP_C
                pg8::gemm_phase<EpiStoreF32, pg8::StaticOrder, true, true>(lds, g, S, E, tid);
#endif
            } else {
                const bf16_t* mbk = (const bf16_t*)(ws + WS_B + HB_MBK * MiB); float* KMEAN = (float*)(ws + WS_SMALL + 4096);
                for (int item = (bx - 128) * 8 + wave; item < 512; item += (G - 128) * 8) { const int bh = item >> 5, n = item & 31;
                    const bf16_t* kp = mbk + ((size_t)bh * SEQ + 256 * n) * 64 + lane; float a = 0.f;
#pragma unroll 8
                    for (int j = 0; j < 256; ++j) a += bf2f(kp[(size_t)j * 64]);
                    KMEAN[(size_t)item * 64 + lane] = a * (1.0f / 256.0f); }
            }
        }
        grid.sync();

        { PHASE_BEGIN
            const int gwave = bx * 8 + wave, nwaves = G * 8;
            const float* cw2 = INP(10) + (size_t)L * 2 * 256 * 64; const float* nkn = INP(7) + L * 192;
            bf16_t* KC = (bf16_t*)(ws + WS_KC); bf16_t* VCT = (bf16_t*)(ws + WS_VCT);
            for (int row = gwave; row < 8192; row += nwaves) { const int kv = row >> 12, rr = row & 4095, bg = rr >> 9, n = rr & 511;
                f32x4 hv = *(const f32x4*)((const float*)(ws + WS_SMALL) + kv * 256 + 4 * lane);
                { const float* pp = (const float*)(ws + WS_H) + ((size_t)(kv * 4) * 4096 + rr) * 256 + 4 * lane;
#pragma unroll
                    for (int ks = 0; ks < 4; ++ks) hv += *(const f32x4*)(pp + (size_t)ks * 4096 * 256);
#pragma unroll
                    for (int e = 0; e < 4; ++e) { const float t = hv[e], z = 0.7978845608028654f * (t + 0.044715f * t * t * t);
                        const float th = 1.0f - 2.0f * __builtin_amdgcn_rcpf(1.0f + __expf(2.0f * z)); hv[e] = 0.5f * t * (1.0f + th); } }
                const float* wp = cw2 + (size_t)kv * 256 * 64 + lane; float a = 0.f;
#pragma unroll
                for (int k = 0; k < 256; ++k) { const float hk = __uint_as_float(__builtin_amdgcn_readlane(__float_as_uint(hv[k & 3]), k >> 2)); a = fmaf(hk, wp[k * 64], a); }
                if (kv == 0) { const float ss = wave_sum(a * a); float y = a * __builtin_amdgcn_rsqf(ss * (1.0f / 64.0f) + 1e-6f) * nkn[lane]; if (n == 511) y = 0.f;
                    KC[((size_t)bg * 512 + n) * 64 + lane] = (bf16_t)(pk2(y, 0.f) & 0xffffu); }
                else { if (n == 511) a = 0.f; VCT[((size_t)bg * 64 + lane) * 512 + n] = (bf16_t)(pk2(a, 0.f) & 0xffffu); } }
        }
        grid.sync();

        }
        { PHASE_BEGIN
            LAS unsigned* misc = (LAS unsigned*)(lds + ATT_MISC); LAS float* btab = (LAS float*)(lds + ATT_BT);
            const float* rel_bias = INP(1);
            __syncthreads();
            if (wave == 0) { const float* mqn = INP(4) + L * 64; const float* mkn = INP(5) + L * 64; const float* nqn = INP(6) + L * 64; const float* nkn = INP(7) + L * 192;
                float gq = fmaxf(fabsf(mqn[lane]), fabsf(nqn[lane])); float gk = fmaxf(fmaxf(fabsf(mkn[lane]), fabsf(nkn[lane])), fmaxf(fabsf(nkn[64 + lane]), fabsf(nkn[128 + lane])));
                float bm = 0.f;
#pragma unroll
                for (int i = 0; i < 6; ++i) bm = fmaxf(bm, fabsf(rel_bias[lane + 64 * i]));
                gq = wave_max(gq); gk = wave_max(gk); bm = wave_max(bm);
                if (lane == 0) ((LAS float*)misc)[2] = 8.0f * gq * gk + bm; }
            __syncthreads();
            const float shift = ((LAS float*)misc)[2];
            for (int i = tid; i < 12 * BT_N; i += 512) { const int hd = i / BT_N, jx = i - hd * BT_N; const int d = jx - 64;
                float v = -3.0e38f;
                if (d >= 0) { int bk; if (d < 16) bk = d; else if (d >= 128) bk = 31; else { bk = 16 + (int)(__log2f((float)d * (1.0f / 16.0f)) * (16.0f / 3.0f)); bk = bk > 31 ? 31 : bk; }
                    v = (rel_bias[bk * 12 + hd] - shift) * L2E; }
                btab[i] = v; }
            __syncthreads();
#ifndef REP_E
#define REP_E 1
#endif
            for (int rep_ = 0; rep_ < REP_E; ++rep_) {
            unsigned* ctl = (unsigned*)(ws + WS_CTL) + L + 2 * rep_;
            unsigned char* HBUF = ws + WS_B; bf16_t* OMIX = (bf16_t*)(ws + WS_H);
            for (;;) {
                __syncthreads();
                if (tid == 0) misc[0] = atomicAdd(ctl, 1u);
                __syncthreads();
                const int u = (int)misc[0];
                if (u >= 2048) break;
                int tidu = tid; asm volatile("" : "+v"(tidu));
                if (u < 1024) { const int c = 127 - (u >> 3), bg = u & 7;
#ifndef SKIP_NSA
                    nsa_unit(lds, HBUF, (const bf16_t*)(ws + WS_KC), (const bf16_t*)(ws + WS_VCT), (const float*)(ws + WS_NSG), OMIX, bg >> 1, bg & 1, c, tidu);
#endif
                }
                else if (u < 1536) { const int v = u - 1024;
#ifndef SKIP_MOBA
                    moba_unit(lds, HBUF, (const float*)(ws + WS_SMALL + 4096), OMIX, (v & 15) >> 2, v & 3, 31 - (v >> 4), tidu);
#endif
                }
                else { const int v = u - 1536;
#ifndef SKIP_SB
                    sb_unit(lds, HBUF, OMIX, (v & 15) >> 2, v & 3, 31 - (v >> 4), tidu);
#endif
                }
            }
            }
        }
        grid.sync();

        { PHASE_BEGIN
            for (int it = bx; it < 256; it += G)
                for (int i = 0; i < 4; ++i) { int tidu = tid; asm volatile("" : "+v"(tidu));
                    branch_tile(lds, (const bf16_t*)(ws + WS_H), (const bf16_t*)(ws + WS_WBR), (const bf16_t*)(ws + WS_A), (bf16_t*)(ws + WS_B), it >> 1, 4 * (it & 1) + i, tidu); }
        }
        grid.sync();

        { PHASE_BEGIN
            pg8::Gemm g{(const bf16_t*)(ws + WS_B), (const bf16_t*)(ws + WS_WOUT), MTOK, DM, DM, DM, DM}; pg8::StaticOrder S; S.init(MTOK, DM, G, bx);
            EpiRes E{L == 0 ? INP(0) : (const float*)POUT, POUT};
#ifndef SKIP_GJ
            pg8::gemm_phase<EpiRes, pg8::StaticOrder, true, true>(lds, g, S, E, tid);
#endif
        }
        grid.sync();

        { PHASE_BEGIN
            rmsnorm_rows(POUT, INP(13) + L * DM, (bf16_t*)(ws + WS_H), bx * 8 + wave, G * 8, lane); }
        grid.sync();

        { PHASE_BEGIN
            pg8::Gemm g{(const bf16_t*)(ws + WS_H), (const bf16_t*)(ws + WS_WGU), MTOK, 2 * DFF, DM, DM, DM}; pg8::StaticOrder S; S.init(MTOK, 2 * DFF, G, bx); EpiSwiglu E{(bf16_t*)(ws + WS_A)};
#ifndef SKIP_I
            pg8::gemm_phase<EpiSwiglu, pg8::StaticOrder, true, true>(lds, g, S, E, tid);
#endif
        }
        grid.sync();

        { PHASE_BEGIN
            pg8::Gemm g{(const bf16_t*)(ws + WS_A), (const bf16_t*)(ws + WS_WDN), MTOK, DM, DFF, DFF, DFF}; pg8::StaticOrder S; S.init(MTOK, DM, G, bx); EpiRes E{POUT, POUT};
#ifndef SKIP_GJ
            pg8::gemm_phase<EpiRes, pg8::StaticOrder, true, true>(lds, g, S, E, tid);
#endif
        }
        if (layer == 0) grid.sync();
    }
}

extern "C" void kernel_launch(void* const* d_in, const int* in_sizes, int n_in, void* d_out, int out_size, void* d_ws, size_t ws_size, hipStream_t stream) {
    static int grid = 0;
    if (grid == 0) {
        if (n_in != 16 || out_size != MTOK * DM || ws_size < WS_END) { fprintf(stderr, "kernel_launch: unexpected shapes (n_in %d out %d ws %zu, need ws >= %zu)\n", n_in, out_size, ws_size, (size_t)WS_END); grid = -1; return; }
        int dev = 0, cus = 0, per_cu = 0;
        hipGetDevice(&dev); hipDeviceGetAttribute(&cus, hipDeviceAttributeMultiprocessorCount, dev);
        if (hipFuncSetAttribute((const void*)hybrid_fwd, hipFuncAttributeMaxDynamicSharedMemorySize, LDS_BYTES) != hipSuccess) { fprintf(stderr, "kernel_launch: hipFuncSetAttribute failed\n"); grid = -1; return; }
        if (hipOccupancyMaxActiveBlocksPerMultiprocessor(&per_cu, (const void*)hybrid_fwd, 512, LDS_BYTES) != hipSuccess || per_cu < 1) { fprintf(stderr, "kernel_launch: occupancy query gave %d\n", per_cu); per_cu = 1; }
        (void)hipGetLastError();
        grid = cus * 1;
    }
    if (grid < 0) return;
    hipMemsetAsync((char*)d_ws + WS_CTL, 0, 4096, stream);
    Params p{};
    for (int i = 0; i < 16; ++i) p.in[i] = (const float*)d_in[i];
    p.out = (float*)d_out; p.ws = (unsigned char*)d_ws;
    void* args[] = {&p};
    hipError_t e = hipLaunchCooperativeKernel((const void*)hybrid_fwd, dim3(grid), dim3(512), args, LDS_BYTES, stream);
    if (e != hipSuccess) fprintf(stderr, "cooperative launch failed: %s (grid %d)\n", hipGetErrorString(e), grid);
}
```

```cpp
#include <hip/hip_runtime.h>
#include <hip/hip_cooperative_groups.h>
#include <cstdio>
#include <cstdint>
namespace cg = cooperative_groups;
namespace pg8 {
#define PG8_LAS __attribute__((address_space(3)))
typedef unsigned short bf16_t;
typedef short bf16x8 __attribute__((ext_vector_type(8)));
typedef float f32x4 __attribute__((ext_vector_type(4)));
typedef unsigned u32x4 __attribute__((ext_vector_type(4)));
constexpr int BM = 256, BK = 64, HALF = 128, HTB = HALF * BK * 2  , STAGE_BYTES = 8 * HTB, NXCD = 8, WGM = 8;

__host__ __device__ __forceinline__ int lds_byte(int r, int c) { const int st = (r >> 4) * 2 + (c >> 5), rr = r & 15, cc = c & 31, ob = rr * 64 + cc * 2; return st * 1024 + (ob ^ (((ob >> 9) & 1) << 5)); }
__host__ __device__ __forceinline__ void stage_rc(int b, int& R, int& C) { const int st = b / 1024, sb = b % 1024, swz = sb ^ (((sb >> 9) & 1) << 5); R = (st >> 1) * 16 + swz / 64; C = (st & 1) * 32 + (swz % 64) / 2; }
__host__ __device__ __forceinline__ int perm32(int rho) { const int n = rho >> 4, i = rho & 15; return 8 * (i >> 2) + 4 * n + (i & 3); }

struct Unit { int pm, pn; };
struct Gemm { const bf16_t* A; const bf16_t* Bt; int M, N, K, lda, ldb; };

struct StaticOrder {
    int nM, nN, nwg, G, c;
    __host__ __device__ void init(int M, int N, int G_, int c_) { nM = M / BM; nN = N / BM; nwg = nM * nN; G = G_; c = c_; }
    __host__ __device__ bool next(int i, Unit& u) const {
        const long L = (long)i * G + c; if (L >= nwg) return false;
        int wgid = (int)L; { const int q = nwg / NXCD, r = nwg % NXCD, xcd = wgid % NXCD, off = wgid / NXCD; wgid = (xcd < r ? xcd * (q + 1) : r * (q + 1) + (xcd - r) * q) + off; }
        const int nig = WGM * nN, gid = wgid / nig, fm = gid * WGM, gsz = (nM - fm) < WGM ? (nM - fm) : WGM;
        u.pm = fm + ((wgid % nig) % gsz); u.pn = (wgid % nig) / gsz; return true;
    }
    __device__ __forceinline__ void a_ready(const Unit&) const {}
    __device__ __forceinline__ void done(const Unit&) const {}
};
template <class Epi, class Sched, bool ALIGN_EPI = false, bool SP2 = false>
__device__ __forceinline__ void gemm_phase(PG8_LAS unsigned char* lds, const Gemm g, const Sched& S, const Epi& E, int tid_in) {
    const int tid = tid_in, wid = __builtin_amdgcn_readfirstlane(tid >> 6), lane = tid & 63, wr = wid >> 2, wc = wid & 3, fr = lane & 15, fq = lane >> 4;
    const int K = g.K, nt = K / BK;
    unsigned voffA[2], voffB[2];
#pragma unroll
    for (int i = 0; i < 2; ++i) { int R, C; stage_rc(tid * 16 + i * 8192, R, C); const int Rb = Epi::PERM ? ((R & ~31) + perm32(R & 31)) : R;
        voffA[i] = (unsigned)(R * g.lda + C) * 2u; voffB[i] = (unsigned)(Rb * g.ldb + C) * 2u; }
    const size_t kstep = (size_t)(BK * 2);
    const size_t hstepA = (size_t)HALF * g.lda * 2, hstepB = (size_t)HALF * g.ldb * 2;
    const size_t tstepA = 2 * hstepA, tstepB = 2 * hstepB;
    const unsigned ldsw = (unsigned)wid * 1024u;
    const int aoff = lds_byte(wr * 64 + fr, fq * 8), boff = lds_byte(wc * 32 + fr, fq * 8);
#define PG8_SA(b, h) (((b) * 2 + (h)) * HTB)
#define PG8_SB(b, h) ((4 + (b) * 2 + (h)) * HTB)
#define PG8_STAGE(bufoff, gbase, voff) do { _Pragma("unroll") for (int _i = 0; _i < 2; ++_i) \
        __builtin_amdgcn_global_load_lds((const unsigned*)((const char*)(gbase) + (voff)[_i]), (PG8_LAS unsigned*)(lds + (bufoff) + ldsw + _i * 8192), 16, 0, 0); } while (0)
#define PG8_LDA(dst, b, h) do { _Pragma("unroll") for (int m = 0; m < 4; ++m) _Pragma("unroll") for (int k = 0; k < 2; ++k) dst[m][k] = *(const PG8_LAS bf16x8*)(lds + PG8_SA(b, h) + aoff + m * 2048 + k * 1024); } while (0)
#define PG8_LDB(dst, b, h) do { _Pragma("unroll") for (int n = 0; n < 2; ++n) _Pragma("unroll") for (int k = 0; k < 2; ++k) dst[n][k] = *(const PG8_LAS bf16x8*)(lds + PG8_SB(b, h) + boff + n * 2048 + k * 1024); } while (0)
#define PG8_MMA(ai, bj, At, Bt) do { __builtin_amdgcn_s_setprio(1); _Pragma("unroll") for (int m = 0; m < 4; ++m) _Pragma("unroll") for (int n = 0; n < 2; ++n) _Pragma("unroll") for (int k = 0; k < 2; ++k) \
        acc[ai][bj][m][n] = __builtin_amdgcn_mfma_f32_16x16x32_bf16(Bt[n][k], At[m][k], acc[ai][bj][m][n], 0, 0, 0); __builtin_amdgcn_s_setprio(0); } while (0)
#define PG8_WAIT_V(n) asm volatile("s_waitcnt vmcnt(" #n ")" ::: "memory")
#define PG8_WAIT_L(n) asm volatile("s_waitcnt lgkmcnt(" #n ")" ::: "memory")
#define PG8_BAR __builtin_amdgcn_s_barrier()
#define PG8_SCHED __builtin_amdgcn_sched_barrier(0)
    Unit cur, nxt; int ui = 0;
    if (!S.next(0, cur)) return;
    f32x4 acc[2][2][4][2];
#pragma unroll
    for (int a = 0; a < 2; ++a)
#pragma unroll
        for (int b = 0; b < 2; ++b)
#pragma unroll
            for (int m = 0; m < 4; ++m)
#pragma unroll
                for (int n = 0; n < 2; ++n) acc[a][b][m][n] = (f32x4){0.f, 0.f, 0.f, 0.f};
    bf16x8 At[4][2], B0[2][2], B1[2][2];
    const char* cA = (const char*)g.A + (size_t)cur.pm * tstepA; const char* cB = (const char*)g.Bt + (size_t)cur.pn * tstepB;
    S.a_ready(cur);
    if constexpr (SP2) {
        PG8_STAGE(PG8_SB(0, 0), cB, voffB); PG8_STAGE(PG8_SB(0, 1), cB + hstepB, voffB); PG8_STAGE(PG8_SA(0, 0), cA, voffA); PG8_STAGE(PG8_SA(0, 1), cA + hstepA, voffA);
        if (wr == 1) PG8_BAR;
        PG8_WAIT_V(2); PG8_BAR;
        PG8_STAGE(PG8_SB(1, 0), cB + kstep, voffB); PG8_STAGE(PG8_SA(1, 0), cA + kstep, voffA); PG8_STAGE(PG8_SB(1, 1), cB + hstepB + kstep, voffB);
        PG8_WAIT_V(6); PG8_BAR;
    } else {
        PG8_STAGE(PG8_SB(0, 0), cB, voffB); PG8_STAGE(PG8_SA(0, 0), cA, voffA); PG8_STAGE(PG8_SB(0, 1), cB + hstepB, voffB); PG8_STAGE(PG8_SA(0, 1), cA + hstepA, voffA);
        if (wr == 1) PG8_BAR;
        PG8_WAIT_V(4); PG8_BAR;
        PG8_STAGE(PG8_SB(1, 0), cB + kstep, voffB); PG8_STAGE(PG8_SA(1, 0), cA + kstep, voffA); PG8_STAGE(PG8_SB(1, 1), cB + hstepB + kstep, voffB);
        PG8_WAIT_V(6); PG8_BAR;
    }
    for (;;) {
        const bool has_next = S.next(ui + 1, nxt);
        const char* nA = has_next ? (const char*)g.A + (size_t)nxt.pm * tstepA : cA; const char* nB = has_next ? (const char*)g.Bt + (size_t)nxt.pn * tstepB : cB;
#pragma unroll 1
        for (int t = 0; t < nt; t += 2) {
            const bool last = (t == nt - 2);
            const char* a1 = cA + (size_t)(t + 1) * kstep;
            const char* a2 = last ? nA : cA + (size_t)(t + 2) * kstep; const char* b2 = last ? nB : cB + (size_t)(t + 2) * kstep;
            const char* a3 = a2 + kstep; const char* b3 = b2 + kstep;
            if (last && has_next) S.a_ready(nxt);
            if constexpr (SP2) {
            PG8_LDB(B0, 0, 0); PG8_LDB(B1, 0, 1); PG8_SCHED; PG8_LDA(At, 0, 0); PG8_STAGE(PG8_SA(1, 1), a1 + hstepA, voffA);
            PG8_WAIT_V(8); PG8_WAIT_L(0); PG8_BAR; PG8_MMA(0, 0, At, B0); PG8_MMA(0, 1, At, B1); PG8_BAR; PG8_SCHED;
            PG8_LDA(At, 0, 1); PG8_STAGE(PG8_SB(0, 0), b2, voffB); PG8_STAGE(PG8_SB(0, 1), b2 + hstepB, voffB); PG8_STAGE(PG8_SA(0, 0), a2, voffA);
            PG8_WAIT_V(8); PG8_WAIT_L(0); PG8_BAR; PG8_MMA(1, 0, At, B0); PG8_MMA(1, 1, At, B1); PG8_BAR; PG8_SCHED;
            PG8_LDB(B0, 1, 0); PG8_LDB(B1, 1, 1); PG8_SCHED; PG8_LDA(At, 1, 0); PG8_STAGE(PG8_SA(0, 1), a2 + hstepA, voffA);
            PG8_WAIT_V(8); PG8_WAIT_L(0); PG8_BAR; PG8_MMA(0, 0, At, B0); PG8_MMA(0, 1, At, B1); PG8_BAR; PG8_SCHED;
            PG8_LDA(At, 1, 1); PG8_STAGE(PG8_SB(1, 0), b3, voffB); PG8_STAGE(PG8_SB(1, 1), b3 + hstepB, voffB); PG8_STAGE(PG8_SA(1, 0), a3, voffA);
            PG8_WAIT_V(8); PG8_WAIT_L(0); PG8_BAR; PG8_MMA(1, 0, At, B0); PG8_MMA(1, 1, At, B1); PG8_BAR; PG8_SCHED;
            } else {
            PG8_LDB(B0, 0, 0); PG8_SCHED; PG8_LDA(At, 0, 0); PG8_STAGE(PG8_SA(1, 1), a1 + hstepA, voffA);
            PG8_WAIT_L(8); PG8_BAR; PG8_WAIT_L(0); PG8_MMA(0, 0, At, B0); PG8_BAR; PG8_SCHED;
            PG8_LDB(B1, 0, 1); PG8_STAGE(PG8_SB(0, 0), b2, voffB);
            PG8_BAR; PG8_WAIT_L(0); PG8_MMA(0, 1, At, B1); PG8_BAR;
            PG8_LDA(At, 0, 1); PG8_STAGE(PG8_SA(0, 0), a2, voffA);
            PG8_BAR; PG8_WAIT_L(0); PG8_MMA(1, 0, At, B0); PG8_BAR; PG8_SCHED;
            PG8_STAGE(PG8_SB(0, 1), b2 + hstepB, voffB);
            PG8_WAIT_V(6); PG8_BAR; PG8_MMA(1, 1, At, B1); PG8_BAR;
            PG8_LDB(B0, 1, 0); PG8_SCHED; PG8_LDA(At, 1, 0); PG8_STAGE(PG8_SA(0, 1), a2 + hstepA, voffA);
            PG8_WAIT_L(8); PG8_BAR; PG8_WAIT_L(0); PG8_MMA(0, 0, At, B0); PG8_BAR; PG8_SCHED;
            PG8_LDB(B1, 1, 1); PG8_STAGE(PG8_SB(1, 0), b3, voffB);
            PG8_BAR; PG8_WAIT_L(0); PG8_MMA(0, 1, At, B1); PG8_BAR;
            PG8_LDA(At, 1, 1); PG8_STAGE(PG8_SA(1, 0), a3, voffA);
            PG8_BAR; PG8_WAIT_L(0); PG8_MMA(1, 0, At, B0); PG8_BAR; PG8_SCHED;
            PG8_STAGE(PG8_SB(1, 1), b3 + hstepB, voffB);
            PG8_WAIT_V(6); PG8_BAR; PG8_MMA(1, 1, At, B1); PG8_BAR;
            }
        }
        if constexpr (ALIGN_EPI) { if (wr == 0) PG8_BAR; }
        if constexpr (!Epi::AFTER_DRAIN) { E(acc, cur, wr, wc, fr, fq); S.done(cur); }
        if (!has_next) break;
#pragma unroll
        for (int a = 0; a < 2; ++a)
#pragma unroll
            for (int b = 0; b < 2; ++b)
#pragma unroll
                for (int m = 0; m < 4; ++m)
#pragma unroll
                    for (int n = 0; n < 2; ++n) acc[a][b][m][n] = (f32x4){0.f, 0.f, 0.f, 0.f};
        cur = nxt; cA = nA; cB = nB; ++ui;
        if constexpr (ALIGN_EPI) { if (wr == 1) PG8_BAR; }
    }
    PG8_WAIT_V(0);
    if constexpr (!ALIGN_EPI) { if (wr == 0) PG8_BAR; }
    PG8_BAR;
    if constexpr (Epi::AFTER_DRAIN) { E.fused(acc, cur, wr, wc, fr, fq, lds, wid, lane); S.done(cur); }
#undef PG8_SA
#undef PG8_SB
#undef PG8_STAGE
#undef PG8_LDA
#undef PG8_LDB
#undef PG8_MMA
#undef PG8_WAIT_V
#undef PG8_WAIT_L
#undef PG8_BAR
#undef PG8_SCHED
}
}

#define LAS __attribute__((address_space(3)))
typedef unsigned short bf16_t;
typedef short bf16x8 __attribute__((ext_vector_type(8)));
typedef float f32x4 __attribute__((ext_vector_type(4)));
typedef float f32x16 __attribute__((ext_vector_type(16)));
typedef unsigned u32x4 __attribute__((ext_vector_type(4)));
typedef unsigned u32x2 __attribute__((ext_vector_type(2)));
typedef float f32x2_t __attribute__((ext_vector_type(2)));
typedef __bf16 bf16x2_t __attribute__((ext_vector_type(2)));

constexpr int MTOK = 32768, DM = 1024, SEQ = 8192;
constexpr int NIN = 5912, NINP = 6144, DFF = 2816;
constexpr float L2E = 1.4426950408889634f;
constexpr size_t MiB = 1048576;
constexpr size_t WS_CTL = 0, WS_WIN = 1 * MiB, WS_WBR = 13 * MiB, WS_WOUT = 15 * MiB, WS_WGU = 17 * MiB, WS_WDN = 28 * MiB, WS_WC1 = 34 * MiB,
                 WS_SMALL = 36 * MiB, WS_CMPH = 37 * MiB, WS_KC = 45 * MiB, WS_VCT = 45 * MiB + 512 * 1024, WS_NSG = 46 * MiB,
                 WS_H = 49 * MiB  , WS_A = 113 * MiB  ,
                 WS_B = 305 * MiB  , WS_END = 481 * MiB;
constexpr size_t HB_SBQ = 0, HB_SBK = 16, HB_SBVT = 32, HB_MBQ = 48, HB_MBK = 64, HB_MBVT = 80, HB_NSQ = 96, HB_KCR = 128, HB_VCR = 136,
                 HB_KS = 144, HB_VST = 152, HB_KW = 160, HB_VWT = 168;
constexpr int LDS_BYTES = 147456;
constexpr int ATT_BT = 36864, ATT_MISC = 50688, ATT_SEL = 50944, ATT_X = 51968, ATT_OA = 93952;

struct Params { const float* in[16]; float* out; unsigned char* ws; };

__device__ __forceinline__ unsigned pk2(float lo, float hi) { f32x2_t v = {lo, hi}; bf16x2_t b = __builtin_convertvector(v, bf16x2_t); return __builtin_bit_cast(unsigned, b); }
__device__ __forceinline__ float bf2f(unsigned v16) { return __uint_as_float(v16 << 16); }
__device__ __forceinline__ float bflo(unsigned w) { return __uint_as_float(w << 16); }
__device__ __forceinline__ float bfhi(unsigned w) { return __uint_as_float(w & 0xffff0000u); }
__device__ __forceinline__ float wave_sum(float v) { v += __shfl_xor(v, 1); v += __shfl_xor(v, 2); v += __shfl_xor(v, 4); v += __shfl_xor(v, 8); v += __shfl_xor(v, 16); v += __shfl_xor(v, 32); return v; }
__device__ __forceinline__ float wave_max(float v) { v = fmaxf(v, __shfl_xor(v, 1)); v = fmaxf(v, __shfl_xor(v, 2)); v = fmaxf(v, __shfl_xor(v, 4)); v = fmaxf(v, __shfl_xor(v, 8)); v = fmaxf(v, __shfl_xor(v, 16)); v = fmaxf(v, __shfl_xor(v, 32)); return v; }
__device__ __forceinline__ float sigmoidf_(float x) { return __builtin_amdgcn_rcpf(1.0f + __expf(-x)); }
__device__ __forceinline__ float ex2(float x) { return __builtin_amdgcn_exp2f(x); }
__device__ __forceinline__ float lg2(float x) { return __builtin_amdgcn_logf(x); }

template <int MAP> __device__ __forceinline__ int mapcol(int p) {
    const int pn = p >> 8, q = p & 255, bj = q >> 7, wc = (q >> 5) & 3, n = (q >> 4) & 1, fq = (q >> 2) & 3, e = q & 3;
    const int lc = 64 * wc + 32 * bj + 8 * fq + 4 * n + e;
    if (MAP == 3) return p;
    if (MAP == 0) return 256 * pn + lc;
    if (MAP == 1) { if (pn <= 10) return 256 * pn + lc; if (pn == 11) return lc < 24 ? 2816 + lc : -1; return 2840 + 256 * (pn - 12) + lc; }
    const int j = 128 * pn + 32 * wc + 8 * fq + 4 * n + e; return bj ? DFF + j : j;
}

struct EpiRes {
    static constexpr bool PERM = false, AFTER_DRAIN = false;
    const float* res; float* out;
    __device__ __forceinline__ void operator()(const f32x4 (&acc)[2][2][4][2], const pg8::Unit& u, int wr, int wc, int fr_, int fq_) const {
        int fr = fr_, fq = fq_; asm volatile("" : "+v"(fr), "+v"(fq));
#pragma unroll
        for (int ai = 0; ai < 2; ++ai)
#pragma unroll
            for (int m = 0; m < 4; ++m) { const unsigned row = (unsigned)(u.pm * 256 + 128 * ai + 64 * wr + 16 * m + fr);
#pragma unroll
                for (int bj = 0; bj < 2; ++bj)
#pragma unroll
                    for (int n = 0; n < 2; ++n) { const unsigned o = row * 1024u + (unsigned)(u.pn * 256 + 64 * wc + 32 * bj + 8 * fq + 4 * n);
                        const f32x4 r = *(const f32x4*)(res + o); *(f32x4*)(out + o) = r + acc[ai][bj][m][n]; }
                __builtin_amdgcn_sched_barrier(0); }
    }
};
struct EpiResNormB {
    static constexpr bool PERM = false, AFTER_DRAIN = false;
    const float* res; bf16_t* xb; float* ssq;
    __device__ __forceinline__ void operator()(const f32x4 (&acc)[2][2][4][2], const pg8::Unit& u, int wr, int wc, int fr_, int fq_) const {
        int fr = fr_, fq = fq_; asm volatile("" : "+v"(fr), "+v"(fq));
#pragma unroll
        for (int ai = 0; ai < 2; ++ai)
#pragma unroll
            for (int m = 0; m < 4; ++m) { const unsigned row = (unsigned)(u.pm * 256 + 128 * ai + 64 * wr + 16 * m + fr); float ss = 0.f;
#pragma unroll
                for (int bj = 0; bj < 2; ++bj) { const unsigned o = row * 1024u + (unsigned)(u.pn * 256 + 64 * wc + 32 * bj + 8 * fq);
                    const f32x4 r0 = *(const f32x4*)(res + o), r1 = *(const f32x4*)(res + o + 4);
                    const f32x4 x0 = r0 + acc[ai][bj][m][0], x1 = r1 + acc[ai][bj][m][1];
                    u32x4 w; w.x = pk2(x0[0], x0[1]); w.y = pk2(x0[2], x0[3]); w.z = pk2(x1[0], x1[1]); w.w = pk2(x1[2], x1[3]);
                    *(u32x4*)(xb + o) = w;
                    ss += (x0[0] * x0[0] + x0[1] * x0[1]) + (x0[2] * x0[2] + x0[3] * x0[3]) + (x1[0] * x1[0] + x1[1] * x1[1]) + (x1[2] * x1[2] + x1[3] * x1[3]); }
                ss += __shfl_xor(ss, 16); ss += __shfl_xor(ss, 32);
                if (fq == 0) atomicAdd(ssq + row, ss);
                __builtin_amdgcn_sched_barrier(0); }
    }
};
struct EpiResB {
    static constexpr bool PERM = false, AFTER_DRAIN = false;
    const bf16_t* resb; float* out;
    __device__ __forceinline__ void operator()(const f32x4 (&acc)[2][2][4][2], const pg8::Unit& u, int wr, int wc, int fr_, int fq_) const {
        int fr = fr_, fq = fq_; asm volatile("" : "+v"(fr), "+v"(fq));
#pragma unroll
        for (int ai = 0; ai < 2; ++ai)
#pragma unroll
            for (int m = 0; m < 4; ++m) { const unsigned row = (unsigned)(u.pm * 256 + 128 * ai + 64 * wr + 16 * m + fr);
#pragma unroll
                for (int bj = 0; bj < 2; ++bj) { const unsigned o = row * 1024u + (unsigned)(u.pn * 256 + 64 * wc + 32 * bj + 8 * fq);
                    const u32x4 rb = *(const u32x4*)(resb + o); const f32x4 a0 = acc[ai][bj][m][0], a1 = acc[ai][bj][m][1];
                    f32x4 y0, y1; y0[0] = bflo(rb.x) + a0[0]; y0[1] = bfhi(rb.x) + a0[1]; y0[2] = bflo(rb.y) + a0[2]; y0[3] = bfhi(rb.y) + a0[3];
                    y1[0] = bflo(rb.z) + a1[0]; y1[1] = bfhi(rb.z) + a1[1]; y1[2] = bflo(rb.w) + a1[2]; y1[3] = bfhi(rb.w) + a1[3];
                    *(f32x4*)(out + o) = y0; *(f32x4*)(out + o + 4) = y1; }
                __builtin_amdgcn_sched_barrier(0); }
    }
};
struct EpiSwiglu {
    static constexpr bool PERM = false, AFTER_DRAIN = false;
    bf16_t* act; const float* ssq;
    __device__ __forceinline__ void operator()(const f32x4 (&acc)[2][2][4][2], const pg8::Unit& u, int wr, int wc, int fr_, int fq_) const {
        int fr = fr_, fq = fq_; asm volatile("" : "+v"(fr), "+v"(fq));
#pragma unroll
        for (int ai = 0; ai < 2; ++ai)
#pragma unroll
            for (int m = 0; m < 4; ++m) { const unsigned row = (unsigned)(u.pm * 256 + 128 * ai + 64 * wr + 16 * m + fr);
                float v[8]; const float rs = __builtin_amdgcn_rsqf(ssq[row] * (1.0f / DM) + 1e-6f);
#pragma unroll
                for (int n = 0; n < 2; ++n)
#pragma unroll
                    for (int e = 0; e < 4; ++e) { const float g = acc[ai][0][m][n][e] * rs, up = acc[ai][1][m][n][e] * rs; v[4 * n + e] = g * sigmoidf_(g) * up; }
                u32x4 w; w.x = pk2(v[0], v[1]); w.y = pk2(v[2], v[3]); w.z = pk2(v[4], v[5]); w.w = pk2(v[6], v[7]);
                *(u32x4*)(act + (row * 2816u + (unsigned)(u.pn * 128 + 32 * wc + 8 * fq))) = w; }
    }
};
template <int MODE> struct EpiBranch {
    static constexpr bool PERM = false, AFTER_DRAIN = false;
    const bf16_t* brg; bf16_t* mix; int s;
    __device__ __forceinline__ void operator()(const f32x4 (&acc)[2][2][4][2], const pg8::Unit& u, int wr, int wc, int fr_, int fq_) const {
        int fr = fr_, fq = fq_; asm volatile("" : "+v"(fr), "+v"(fq));
#pragma unroll
        for (int ai = 0; ai < 2; ++ai)
#pragma unroll
            for (int m = 0; m < 4; ++m) { const unsigned row = (unsigned)(u.pm * 256 + 128 * ai + 64 * wr + 16 * m + fr);
#pragma unroll
                for (int bj = 0; bj < 2; ++bj)
#pragma unroll
                    for (int n = 0; n < 2; ++n) { const unsigned c = (unsigned)(u.pn * 256 + 64 * wc + 32 * bj + 8 * fq + 4 * n);
                        const u32x2 g = *(const u32x2*)(brg + (row * 3072u + 1024u * (unsigned)s + c));
                        u32x2 o = {0u, 0u}; if (MODE) o = *(const u32x2*)(mix + (row * 1024u + c));
                        const f32x4 a = acc[ai][bj][m][n];
                        u32x2 w;
                        w.x = pk2(bflo(o.x) + bflo(g.x) * a[0], bfhi(o.x) + bfhi(g.x) * a[1]);
                        w.y = pk2(bflo(o.y) + bflo(g.y) * a[2], bfhi(o.y) + bfhi(g.y) * a[3]);
                        *(u32x2*)(mix + (row * 1024u + c)) = w; }
                __builtin_amdgcn_sched_barrier(0); }
    }
};
struct EpiCmp1 {
    static constexpr bool PERM = false, AFTER_DRAIN = false;
    const float* bias; float* hid;
    __device__ __forceinline__ void operator()(const f32x4 (&acc)[2][2][4][2], const pg8::Unit& u, int wr, int wc, int fr_, int fq_) const {
        int fr = fr_, fq = fq_; asm volatile("" : "+v"(fr), "+v"(fq));
#pragma unroll
        for (int ai = 0; ai < 2; ++ai)
#pragma unroll
            for (int m = 0; m < 4; ++m) { const unsigned row = (unsigned)(u.pm * 256 + 128 * ai + 64 * wr + 16 * m + fr);
#pragma unroll
                for (int bj = 0; bj < 2; ++bj)
#pragma unroll
                    for (int n = 0; n < 2; ++n) { const int c = 64 * wc + 32 * bj + 8 * fq + 4 * n;
                        const f32x4 b = *(const f32x4*)(bias + c); f32x4 x = acc[ai][bj][m][n] + b, y;
#pragma unroll
                        for (int e = 0; e < 4; ++e) { const float t = x[e], z = 0.7978845608028654f * (t + 0.044715f * t * t * t);
                            const float th = 1.0f - 2.0f * __builtin_amdgcn_rcpf(1.0f + __expf(2.0f * z)); y[e] = 0.5f * t * (1.0f + th); }
                        *(f32x4*)(hid + (row * 256u + (unsigned)c)) = y; } }
    }
};
struct EpiStoreF32 {
    static constexpr bool PERM = false, AFTER_DRAIN = false;
    float* hid;
    __device__ __forceinline__ void operator()(const f32x4 (&acc)[2][2][4][2], const pg8::Unit& u, int wr, int wc, int fr_, int fq_) const {
        int fr = fr_, fq = fq_; asm volatile("" : "+v"(fr), "+v"(fq));
#pragma unroll
        for (int ai = 0; ai < 2; ++ai)
#pragma unroll
            for (int m = 0; m < 4; ++m) { const unsigned row = (unsigned)(u.pm * 256 + 128 * ai + 64 * wr + 16 * m + fr);
#pragma unroll
                for (int bj = 0; bj < 2; ++bj)
#pragma unroll
                    for (int n = 0; n < 2; ++n) *(f32x4*)(hid + (row * 256u + (unsigned)(64 * wc + 32 * bj + 8 * fq + 4 * n))) = acc[ai][bj][m][n]; }
    }
};
__device__ __forceinline__ unsigned gq8(float x) { return (unsigned)(sigmoidf_(x) * 255.0f + 0.5f); }
struct EpiInproj {
    static constexpr bool PERM = false, AFTER_DRAIN = false;
    unsigned char* wsb; const float* nwb;
    __device__ __forceinline__ void operator()(const f32x4 (&acc)[2][2][4][2], const pg8::Unit& u, int wr, int wc, int fr_, int fq_) const {
        int fr = fr_, fq = fq_; asm volatile("" : "+v"(fr), "+v"(fq));
        const int t = u.pn; unsigned char* hb = wsb + WS_B; float* nsg = (float*)(wsb + WS_NSG); bf16_t* brg = (bf16_t*)(wsb + WS_A);
        const float* mqn = nwb; const float* mkn = nwb + 64; const float* nqn = nwb + 128; const float* nkn = nwb + 192;
        if (t <= 10) {
            const int hd = 4 * t + wc;
            const int grp = hd < 24 ? (hd >> 2) : (hd < 32 ? 6 : 7 + ((hd - 32) >> 1));
            const int hh = hd < 24 ? (hd & 3) : (hd < 32 ? hd - 24 : (hd & 1));
            const int H = grp < 6 ? 4 : (grp == 6 ? 8 : 2);
            bf16_t* base = (bf16_t*)(hb + (grp <= 6 ? (size_t)16 * grp : (size_t)(128 + 8 * (grp - 7))) * MiB);
            const bool trans = (grp == 2) | (grp == 5) | (grp == 10) | (grp == 12);
            const bool norm = (grp == 3) | (grp == 4) | (grp == 6) | (grp == 9) | (grp == 11);
            const float qs = ((grp == 0) | (grp == 3) | (grp == 6)) ? 0.125f * L2E : 1.0f;
            const float* nw = grp == 3 ? mqn : (grp == 4 ? mkn : (grp == 6 ? nqn : (grp == 9 ? nkn + 64 : nkn + 128)));
#pragma unroll
            for (int ai = 0; ai < 2; ++ai)
#pragma unroll
                for (int m = 0; m < 4; ++m) { const int row = u.pm * 256 + 128 * ai + 64 * wr + 16 * m + fr; const int b = row >> 13, s = row & 8191;
                    float v[2][8];
#pragma unroll
                    for (int bj = 0; bj < 2; ++bj)
#pragma unroll
                        for (int n = 0; n < 2; ++n)
#pragma unroll
                            for (int e = 0; e < 4; ++e) v[bj][4 * n + e] = acc[ai][bj][m][n][e];
                    float sc = qs;
                    if (norm) { float ss = 0.f;
#pragma unroll
                        for (int bj = 0; bj < 2; ++bj)
#pragma unroll
                            for (int j = 0; j < 8; ++j) ss += v[bj][j] * v[bj][j];
                        ss += __shfl_xor(ss, 16); ss += __shfl_xor(ss, 32);
                        sc = qs * __builtin_amdgcn_rsqf(ss * (1.0f / 64.0f) + 1e-6f);
#pragma unroll
                        for (int bj = 0; bj < 2; ++bj) { const f32x4 w0 = *(const f32x4*)(nw + 32 * bj + 8 * fq), w1 = *(const f32x4*)(nw + 32 * bj + 8 * fq + 4);
#pragma unroll
                            for (int e = 0; e < 4; ++e) { v[bj][e] *= w0[e]; v[bj][4 + e] *= w1[e]; } } }
                    if (!trans) {
#pragma unroll
                        for (int bj = 0; bj < 2; ++bj) { u32x4 w; w.x = pk2(v[bj][0] * sc, v[bj][1] * sc); w.y = pk2(v[bj][2] * sc, v[bj][3] * sc); w.z = pk2(v[bj][4] * sc, v[bj][5] * sc); w.w = pk2(v[bj][6] * sc, v[bj][7] * sc);
                            *(u32x4*)(base + (unsigned)(((b * H + hh) * SEQ + s) * 64 + 32 * bj + 8 * fq)) = w; }
                    } else {
#pragma unroll
                        for (int bj = 0; bj < 2; ++bj)
#pragma unroll
                            for (int j = 0; j < 8; j += 2) { const unsigned w = pk2(v[bj][j], v[bj][j + 1]); bf16_t* d = base + (unsigned)(((b * H + hh) * 64 + 32 * bj + 8 * fq + j) * SEQ + s);
                                d[0] = (bf16_t)(w & 0xffffu); d[SEQ] = (bf16_t)(w >> 16); }
                    } }
        } else if (t == 11) {
            if (wc == 0 && fq < 3) {
#pragma unroll
                for (int ai = 0; ai < 2; ++ai)
#pragma unroll
                    for (int m = 0; m < 4; ++m) { const unsigned row = (unsigned)(u.pm * 256 + 128 * ai + 64 * wr + 16 * m + fr);
#pragma unroll
                        for (int n = 0; n < 2; ++n) { f32x4 y;
#pragma unroll
                            for (int e = 0; e < 4; ++e) y[e] = sigmoidf_(acc[ai][0][m][n][e]);
                            *(f32x4*)(nsg + (row * 24u + (unsigned)(8 * fq + 4 * n))) = y; } }
            }
        } else {
#pragma unroll
            for (int ai = 0; ai < 2; ++ai)
#pragma unroll
                for (int m = 0; m < 4; ++m) { const unsigned row = (unsigned)(u.pm * 256 + 128 * ai + 64 * wr + 16 * m + fr);
#pragma unroll
                    for (int bj = 0; bj < 2; ++bj) { const f32x4 a0 = acc[ai][bj][m][0], a1 = acc[ai][bj][m][1]; u32x2 w;
                        w.x = gq8(a0[0]) | (gq8(a0[1]) << 8) | (gq8(a0[2]) << 16) | (gq8(a0[3]) << 24);
                        w.y = gq8(a1[0]) | (gq8(a1[1]) << 8) | (gq8(a1[2]) << 16) | (gq8(a1[3]) << 24);
                        *(u32x2*)((unsigned char*)brg + (row * 3072u + (unsigned)((t - 12) * 256 + 64 * wc + 32 * bj + 8 * fq))) = w; } }
        }
    }
};

template <int MAP> __device__ __forceinline__ void prep_w(const float* __restrict__ W, int K, int ldw, bf16_t* __restrict__ Bt, int Np, int ldb, LAS unsigned char* lds, int tid, int bx, int G, const float* kscale = nullptr) {
    const int ntp = Np >> 6, ntiles = ntp * (K >> 6), w = tid >> 6, lane = tid & 63;
    float v[8];
    int tile = bx;
    if (tile < ntiles) { const int tk = tile / ntp, tp = tile - tk * ntp; const int col = mapcol<MAP>(tp * 64 + lane); const float* s = W + (size_t)(tk * 64 + 8 * w) * ldw + (col < 0 ? 0 : col);
#pragma unroll
        for (int i = 0; i < 8; ++i) v[i] = col >= 0 ? s[(size_t)i * ldw] * (kscale ? kscale[tk * 64 + 8 * w + i] : 1.0f) : 0.f; }
    for (; tile < ntiles; tile += G) {
        const int tk = tile / ntp, tp = tile - tk * ntp;
        u32x4 pw; pw.x = pk2(v[0], v[1]); pw.y = pk2(v[2], v[3]); pw.z = pk2(v[4], v[5]); pw.w = pk2(v[6], v[7]);
        *(LAS u32x4*)(lds + lane * 144 + w * 16) = pw;
        __syncthreads();
        const int nx = tile + G;
        if (nx < ntiles) { const int tk2 = nx / ntp, tp2 = nx - tk2 * ntp; const int col = mapcol<MAP>(tp2 * 64 + lane); const float* s = W + (size_t)(tk2 * 64 + 8 * w) * ldw + (col < 0 ? 0 : col);
#pragma unroll
            for (int i = 0; i < 8; ++i) v[i] = col >= 0 ? s[(size_t)i * ldw] * (kscale ? kscale[tk2 * 64 + 8 * w + i] : 1.0f) : 0.f; }
        { const int p = tid >> 3, pc = tid & 7; const u32x4 o = *(LAS const u32x4*)(lds + p * 144 + pc * 16);
            *(u32x4*)(Bt + (size_t)(tp * 64 + p) * ldb + tk * 64 + pc * 8) = o; }
        __syncthreads();
    }
}
__device__ __forceinline__ void rmsnorm_rows(const float* __restrict__ x, const float* __restrict__ g, bf16_t* __restrict__ h, int gwave, int nwaves, int lane) {
    for (int row = gwave; row < MTOK; row += nwaves) {
        const f32x4* xr = (const f32x4*)(x + (size_t)row * DM); f32x4 v[4]; float ss = 0.f;
#pragma unroll
        for (int i = 0; i < 4; ++i) { v[i] = xr[lane + 64 * i]; ss += v[i][0] * v[i][0] + v[i][1] * v[i][1] + v[i][2] * v[i][2] + v[i][3] * v[i][3]; }
        ss = wave_sum(ss); const float rs = __builtin_amdgcn_rsqf(ss * (1.0f / DM) + 1e-6f);
#pragma unroll
        for (int i = 0; i < 4; ++i) { const f32x4 gv = ((const f32x4*)g)[lane + 64 * i]; u32x2 w; w.x = pk2(v[i][0] * rs * gv[0], v[i][1] * rs * gv[1]); w.y = pk2(v[i][2] * rs * gv[2], v[i][3] * rs * gv[3]);
            *(u32x2*)(h + (size_t)row * DM + (lane + 64 * i) * 4) = w; }
    }
}

#define MFMA32(a, b, c) __builtin_amdgcn_mfma_f32_32x32x16_bf16((a), (b), (c), 0, 0, 0)
__device__ __forceinline__ void stage_ld(const bf16_t* K, const bf16_t* Vt, int ldvt, int key0, int tid, u32x4& rk, u32x4& rv) {
    const int row = tid >> 3, pc = tid & 7;
    rk = *(const u32x4*)(K + (size_t)(key0 + row) * 64 + pc * 8);
    rv = *(const u32x4*)(Vt + (size_t)row * ldvt + key0 + pc * 8);
}
__device__ __forceinline__ void stage_st(LAS unsigned char* lds, int buf, int tid, const u32x4& rk, const u32x4& rv) {
    const int row = tid >> 3, pc = tid & 7; LAS unsigned char* p = lds + buf * 18432 + row * 144 + pc * 16;
    *(LAS u32x4*)p = rk; *(LAS u32x4*)(p + 9216) = rv;
}
__device__ __forceinline__ void load_q(const bf16_t* qrow, int h, bf16x8 (&qf)[4]) {
#pragma unroll
    for (int kk = 0; kk < 4; ++kk) qf[kk] = *(const bf16x8*)(qrow + 16 * kk + 8 * h);
}
__device__ __forceinline__ f32x16 qk_sub(LAS const unsigned char* ks, int sub, const bf16x8 (&qf)[4], int r, int h, float init = 0.f) {
    const int pr = (r & 0x13) | ((r & 4) << 1) | ((r & 8) >> 1);
    LAS const unsigned char* p = ks + (32 * sub + pr) * 144 + h * 16;
    f32x16 st;
#pragma unroll
    for (int i = 0; i < 16; ++i) st[i] = init;
#pragma unroll
    for (int kk = 0; kk < 4; ++kk) { const bf16x8 kf = *(LAS const bf16x8*)(p + kk * 32); st = MFMA32(kf, qf[kk], st); }
    return st;
}
__device__ __forceinline__ void pv_sub(LAS const unsigned char* vs, int sub, const f32x16& p, f32x16 (&ot)[2], int r, int h) {
#pragma unroll
    for (int j = 0; j < 2; ++j) {
        u32x4 w; w.x = pk2(p[8 * j], p[8 * j + 1]); w.y = pk2(p[8 * j + 2], p[8 * j + 3]); w.z = pk2(p[8 * j + 4], p[8 * j + 5]); w.w = pk2(p[8 * j + 6], p[8 * j + 7]);
        const bf16x8 pf = __builtin_bit_cast(bf16x8, w);
#pragma unroll
        for (int mt = 0; mt < 2; ++mt) { const bf16x8 vf = *(LAS const bf16x8*)(vs + (32 * mt + r) * 144 + (32 * sub + 16 * j + 8 * h) * 2); ot[mt] = MFMA32(vf, pf, ot[mt]); }
    }
}
constexpr int BT_N = 288, BT_FAR = 64 + 223;
template <int MODE> __device__ __forceinline__ void soft_sub(f32x16& st, float& lsum, bool lane_valid, int dist0, int dmax, LAS const float* bt) {
    if (MODE == 0) {
#pragma unroll
        for (int i = 0; i < 16; ++i) { const float p = ex2(st[i]); lsum += p; st[i] = p; }
    } else if (MODE == 2) {
        const float cf = lane_valid ? bt[BT_FAR] : -3.0e38f;
#pragma unroll
        for (int i = 0; i < 16; ++i) { const int dist = dist0 - (16 * (i >> 3) + (i & 7)); const float b = dist < dmax ? cf : -3.0e38f;
            const float p = ex2(st[i] + b); lsum += p; st[i] = p; }
    } else if (MODE == 1) {
        float bb[16];
#pragma unroll
        for (int j = 0; j < 2; ++j) { int db = dist0 - 16 * j; db = db < -57 ? -57 : (db > 223 ? 223 : db); if (!lane_valid) db = -57;
            LAS const float* p = bt + (db + 64);
#pragma unroll
            for (int k = 0; k < 8; ++k) bb[8 * j + k] = p[-k]; }
#pragma unroll
        for (int i = 0; i < 16; ++i) { const float p = ex2(st[i] + bb[i]); lsum += p; st[i] = p; }
    } else {
        float bb[16];
#pragma unroll
        for (int i = 0; i < 16; ++i) { int d = dist0 - 16 * (16 * (i >> 3) + (i & 7)); d = d < -64 ? -64 : (d > 223 ? 223 : d); bb[i] = bt[d + 64]; }
#pragma unroll
        for (int i = 0; i < 16; ++i) { const float p = ex2(st[i] + bb[i]); lsum += p; st[i] = p; }
    }
}
__device__ __forceinline__ bf16x8 pack_p(const f32x16& p, int j) {
    u32x4 w; w.x = pk2(p[8 * j], p[8 * j + 1]); w.y = pk2(p[8 * j + 2], p[8 * j + 3]); w.z = pk2(p[8 * j + 4], p[8 * j + 5]); w.w = pk2(p[8 * j + 6], p[8 * j + 7]);
    return __builtin_bit_cast(bf16x8, w);
}
template <int MODE> __device__ __forceinline__ void tile_soft_gen(LAS const unsigned char* ks, LAS const unsigned char* vs, const bf16x8 (&qf)[4], f32x16 (&ot)[2], float& lsum,
                                                              bool lane_valid, int dist00, int dmax, LAS const float* bt, int r, int h) {
    const float init = MODE == 0 ? (lane_valid ? bt[BT_FAR] : -3.0e38f) : 0.f;
    const int pr = (r & 0x13) | ((r & 4) << 1) | ((r & 8) >> 1);
    LAS const unsigned char* kp = ks + pr * 144 + h * 16; LAS const unsigned char* vp = vs + r * 144 + h * 16;
    bf16x8 k0[4], k1[4], v0[2][2], v1[2][2];
#pragma unroll
    for (int kk = 0; kk < 4; ++kk) { k0[kk] = *(LAS const bf16x8*)(kp + kk * 32); k1[kk] = *(LAS const bf16x8*)(kp + 32 * 144 + kk * 32); }
    __builtin_amdgcn_sched_barrier(0);
    f32x16 s0, s1;
#pragma unroll
    for (int i = 0; i < 16; ++i) { s0[i] = init; s1[i] = init; }
#pragma unroll
    for (int kk = 0; kk < 4; ++kk) s0 = MFMA32(k0[kk], qf[kk], s0);
#pragma unroll
    for (int mt = 0; mt < 2; ++mt)
#pragma unroll
        for (int j = 0; j < 2; ++j) v0[mt][j] = *(LAS const bf16x8*)(vp + 32 * mt * 144 + 32 * j);
    __builtin_amdgcn_sched_barrier(0);
#pragma unroll
    for (int kk = 0; kk < 4; ++kk) s1 = MFMA32(k1[kk], qf[kk], s1);
#pragma unroll
    for (int mt = 0; mt < 2; ++mt)
#pragma unroll
        for (int j = 0; j < 2; ++j) v1[mt][j] = *(LAS const bf16x8*)(vp + 32 * mt * 144 + 64 + 32 * j);
    soft_sub<MODE>(s0, lsum, lane_valid, dist00, dmax, bt);
    __builtin_amdgcn_sched_barrier(0);
#pragma unroll
    for (int j = 0; j < 2; ++j) { const bf16x8 pf = pack_p(s0, j); ot[0] = MFMA32(v0[0][j], pf, ot[0]); ot[1] = MFMA32(v0[1][j], pf, ot[1]); }
    soft_sub<MODE>(s1, lsum, lane_valid, dist00 - (MODE == 3 ? 512 : 32), dmax, bt);
    __builtin_amdgcn_sched_barrier(0);
#pragma unroll
    for (int j = 0; j < 2; ++j) { const bf16x8 pf = pack_p(s1, j); ot[0] = MFMA32(v1[0][j], pf, ot[0]); ot[1] = MFMA32(v1[1][j], pf, ot[1]); }
}
#define SOFT4(st_, i0_) { _Pragma("unroll") for (int i_ = (i0_); i_ < (i0_) + 4; ++i_) { const float p_ = ex2(st_[i_]); lsum += p_; st_[i_] = p_; } }
__device__ __forceinline__ void tile_soft_far(LAS const unsigned char* ks, LAS const unsigned char* vs, const bf16x8 (&qf)[4], f32x16 (&ot)[2], float& lsum, bool lane_valid, LAS const float* bt, int r, int h) {
    const float init = lane_valid ? bt[BT_FAR] : -3.0e38f;
    const int pr = (r & 0x13) | ((r & 4) << 1) | ((r & 8) >> 1);
    LAS const unsigned char* kp = ks + pr * 144 + h * 16; LAS const unsigned char* vp = vs + r * 144 + h * 16;
    bf16x8 k0[4], k1[4], v0[2][2], v1[2][2];
#pragma unroll
    for (int kk = 0; kk < 4; ++kk) { k0[kk] = *(LAS const bf16x8*)(kp + kk * 32); k1[kk] = *(LAS const bf16x8*)(kp + 32 * 144 + kk * 32); }
    __builtin_amdgcn_sched_barrier(0);
    f32x16 s0, s1;
#pragma unroll
    for (int i = 0; i < 16; ++i) { s0[i] = init; s1[i] = init; }
#pragma unroll
    for (int kk = 0; kk < 4; ++kk) s0 = MFMA32(k0[kk], qf[kk], s0);
#pragma unroll
    for (int mt = 0; mt < 2; ++mt)
#pragma unroll
        for (int j = 0; j < 2; ++j) { v0[mt][j] = *(LAS const bf16x8*)(vp + 32 * mt * 144 + 32 * j); v1[mt][j] = *(LAS const bf16x8*)(vp + 32 * mt * 144 + 64 + 32 * j); }
    __builtin_amdgcn_sched_barrier(0);
    s1 = MFMA32(k1[0], qf[0], s1); SOFT4(s0, 0);  __builtin_amdgcn_sched_barrier(0);
    s1 = MFMA32(k1[1], qf[1], s1); SOFT4(s0, 4);  __builtin_amdgcn_sched_barrier(0);
    s1 = MFMA32(k1[2], qf[2], s1); SOFT4(s0, 8);  __builtin_amdgcn_sched_barrier(0);
    s1 = MFMA32(k1[3], qf[3], s1); SOFT4(s0, 12); __builtin_amdgcn_sched_barrier(0);
    const bf16x8 pa = pack_p(s0, 0);
    ot[0] = MFMA32(v0[0][0], pa, ot[0]); SOFT4(s1, 0);  __builtin_amdgcn_sched_barrier(0);
    ot[1] = MFMA32(v0[1][0], pa, ot[1]); SOFT4(s1, 4);  const bf16x8 pb = pack_p(s0, 1); __builtin_amdgcn_sched_barrier(0);
    ot[0] = MFMA32(v0[0][1], pb, ot[0]); SOFT4(s1, 8);  __builtin_amdgcn_sched_barrier(0);
    ot[1] = MFMA32(v0[1][1], pb, ot[1]); SOFT4(s1, 12); __builtin_amdgcn_sched_barrier(0);
#pragma unroll
    for (int j = 0; j < 2; ++j) { const bf16x8 pf = pack_p(s1, j); ot[0] = MFMA32(v1[0][j], pf, ot[0]); ot[1] = MFMA32(v1[1][j], pf, ot[1]); }
}
template <int MODE> __device__ __forceinline__ void tile_soft(LAS const unsigned char* ks, LAS const unsigned char* vs, const bf16x8 (&qf)[4], f32x16 (&ot)[2], float& lsum,
                                                              bool lane_valid, int dist00, int dmax, LAS const float* bt, int r, int h) {
    if (MODE == 0) tile_soft_far(ks, vs, qf, ot, lsum, lane_valid, bt, r, h);
    else tile_soft_gen<MODE>(ks, vs, qf, ot, lsum, lane_valid, dist00, dmax, bt, r, h);
}
__device__ __forceinline__ void zero_ot(f32x16 (&ot)[2]) {
#pragma unroll
    for (int i = 0; i < 16; ++i) { ot[0][i] = 0.f; ot[1][i] = 0.f; }
}
__device__ __forceinline__ void store_ot(bf16_t* orow, const f32x16 (&ot)[2], int h) {
#pragma unroll
    for (int mt = 0; mt < 2; ++mt)
#pragma unroll
        for (int g = 0; g < 4; ++g) { u32x2 w; w.x = pk2(ot[mt][4 * g], ot[mt][4 * g + 1]); w.y = pk2(ot[mt][4 * g + 2], ot[mt][4 * g + 3]);
            *(u32x2*)(orow + 32 * mt + 8 * g + 4 * h) = w; }
}

#define TILE_LOOP(KP, VP, LDV, KEY_FIRST, NT, BODY) do { \
    int key0 = (KEY_FIRST); const int nt_ = (NT); u32x4 rkA_, rvA_, rkB_, rvB_; \
    __syncthreads(); \
    stage_ld((KP), (VP), (LDV), key0, tid, rkA_, rvA_); stage_st(lds, 0, tid, rkA_, rvA_); \
    if (nt_ > 1) stage_ld((KP), (VP), (LDV), key0 + 64, tid, rkA_, rvA_); \
    __syncthreads(); \
    for (int it_ = 0; it_ < nt_; ++it_) { const int buf_ = it_ & 1; \
        if (it_ + 2 < nt_) stage_ld((KP), (VP), (LDV), key0 + 128, tid, rkB_, rvB_); \
        { LAS const unsigned char* ks = lds + buf_ * 18432; LAS const unsigned char* vs = ks + 9216; BODY } \
        if (it_ + 1 < nt_) stage_st(lds, buf_ ^ 1, tid, rkA_, rvA_); \
        __syncthreads(); key0 += 64; rkA_ = rkB_; rvA_ = rvB_; } } while (0)

__device__ __forceinline__ void sb_sub(LAS const unsigned char* vs, int sb, f32x16& st, f32x16 (&ot)[2], float& C, int key0, int t, int r, int h) {
    float ls[16]; float Rlo = 0.f, Rhi = 0.f;
#pragma unroll
    for (int i = 0; i < 16; ++i) { const int s = key0 + 32 * sb + 16 * (i >> 3) + 8 * h + (i & 7); const bool causal = s < t;
        const float u = st[i]; const float sp = fmaxf(u, 0.f) + lg2(1.0f + ex2(-fabsf(u)));
        ls[i] = causal ? -sp : 0.f; st[i] = causal ? (u - sp) : -3.0e38f;
        if (i < 8) Rlo += ls[i]; else Rhi += ls[i]; }
    const float Plo = __shfl_xor(Rlo, 32), Phi = __shfl_xor(Rhi, 32);
    float la = C + (h == 0 ? Phi : 0.f);
#pragma unroll
    for (int i = 15; i >= 8; --i) { const float a = ex2(st[i] + la); la += ls[i]; st[i] = a; }
    la = C + Rhi + Phi + (h == 0 ? Plo : 0.f);
#pragma unroll
    for (int i = 7; i >= 0; --i) { const float a = ex2(st[i] + la); la += ls[i]; st[i] = a; }
    C += (Rlo + Rhi) + (Plo + Phi);
    pv_sub(vs, sb, st, ot, r, h);
}
__device__ __forceinline__ void sb_unit(LAS unsigned char* lds, const unsigned char* hb, bf16_t* omix, int b, int hd, int qblk, int tid) {
    const int lane = tid & 63, w = tid >> 6, r = lane & 31, h = lane >> 5;
    const int bh = b * 4 + hd, q0 = qblk * 256, t = q0 + 32 * w + r;
    const bf16_t* Q = (const bf16_t*)(hb + HB_SBQ * MiB) + ((size_t)bh * SEQ + t) * 64;
    const bf16_t* K = (const bf16_t*)(hb + HB_SBK * MiB) + (size_t)bh * SEQ * 64;
    const bf16_t* Vt = (const bf16_t*)(hb + HB_SBVT * MiB) + (size_t)bh * 64 * SEQ;
    bf16x8 qf[4]; load_q(Q, h, qf);
    f32x16 ot[2]; zero_ot(ot);
    float C = 0.f;
    int key0 = q0 + 192; u32x4 rkA_, rvA_, rkB_, rvB_;
    __syncthreads();
    stage_ld(K, Vt, SEQ, key0, tid, rkA_, rvA_); stage_st(lds, 0, tid, rkA_, rvA_);
    if (key0 >= 64) stage_ld(K, Vt, SEQ, key0 - 64, tid, rkA_, rvA_);
    __syncthreads();
    int buf = 0;
    for (;;) {
        const bool has_next = key0 >= 64;
        if (key0 >= 128) stage_ld(K, Vt, SEQ, key0 - 128, tid, rkB_, rvB_);
        if (key0 <= q0 + 32 * w + 31) {
            LAS const unsigned char* ks = lds + buf * 18432; LAS const unsigned char* vs = ks + 9216;
            f32x16 s1 = qk_sub(ks, 1, qf, r, h); f32x16 s0 = qk_sub(ks, 0, qf, r, h);
            if (key0 + 32 <= q0 + 32 * w + 31) sb_sub(vs, 1, s1, ot, C, key0, t, r, h);
            sb_sub(vs, 0, s0, ot, C, key0, t, r, h);
        }
        const int alive = __syncthreads_or(C > -150.0f ? 1 : 0);
        if (!(has_next && alive)) break;
        stage_st(lds, buf ^ 1, tid, rkA_, rvA_);
        __syncthreads(); buf ^= 1; key0 -= 64; rkA_ = rkB_; rvA_ = rvB_;
    }
    store_ot(omix + ((size_t)b * SEQ + t) * DM + hd * 64, ot, h);
}

__device__ __forceinline__ void moba_unit(LAS unsigned char* lds, const unsigned char* hb, const float* kmean, bf16_t* omix, int b, int hd, int blk, int tid) {
    const int lane = tid & 63, w = tid >> 6, r = lane & 31, h = lane >> 5;
    const int bh = b * 4 + hd, q0 = blk * 256, t = q0 + 32 * w + r;
    const bf16_t* Qb = (const bf16_t*)(hb + HB_MBQ * MiB) + ((size_t)bh * SEQ + q0) * 64;
    const bf16_t* K = (const bf16_t*)(hb + HB_MBK * MiB) + (size_t)bh * SEQ * 64;
    const bf16_t* Vt = (const bf16_t*)(hb + HB_MBVT * MiB) + (size_t)bh * 64 * SEQ;
    LAS unsigned* misc = (LAS unsigned*)(lds + ATT_MISC); LAS unsigned* selm = (LAS unsigned*)(lds + ATT_SEL);
    LAS float* km = (LAS float*)(lds + ATT_X); LAS float* sc = km + 32 * 64;
    LAS const float* bt = (LAS const float*)(lds + ATT_BT) + hd * BT_N;
    __syncthreads();
    if (tid == 0) misc[1] = 0u;
    if (blk > 3) {
        for (int i = tid; i < blk * 64; i += 512) km[i] = kmean[(size_t)bh * 32 * 64 + i];
        __syncthreads();
        { const int qi = tid & 255, part = tid >> 8; float q[64];
            const u32x4* qp = (const u32x4*)(Qb + (size_t)qi * 64);
#pragma unroll
            for (int c = 0; c < 8; ++c) { const u32x4 v = qp[c]; q[8 * c] = bflo(v.x); q[8 * c + 1] = bfhi(v.x); q[8 * c + 2] = bflo(v.y); q[8 * c + 3] = bfhi(v.y); q[8 * c + 4] = bflo(v.z); q[8 * c + 5] = bfhi(v.z); q[8 * c + 6] = bflo(v.w); q[8 * c + 7] = bfhi(v.w); }
            for (int n = part; n < blk; n += 2) { float a = 0.f;
#pragma unroll
                for (int d = 0; d < 64; ++d) a = fmaf(q[d], km[n * 64 + d], a);
                sc[qi * 33 + n] = a; } }
        __syncthreads();
        if (tid < 256) { unsigned m = 0u; float sv[32];
#pragma unroll
            for (int n = 0; n < 32; ++n) sv[n] = n < blk ? sc[tid * 33 + n] : -3.0e38f;
#pragma unroll
            for (int k = 0; k < 3; ++k) { float best = -3.0e38f; int bi = 0;
#pragma unroll
                for (int n = 0; n < 32; ++n) { const bool take = !((m >> n) & 1u) && sv[n] > best; best = take ? sv[n] : best; bi = take ? n : bi; }
                m |= 1u << bi; }
            selm[tid] = m; atomicOr((unsigned*)&misc[1], m); }
    } else {
        const unsigned m = (1u << blk) - 1u; if (tid < 256) selm[tid] = m; if (tid == 0) misc[1] = m;
    }
    __syncthreads();
    const unsigned uni = misc[1], sel = selm[32 * w + r];
    bf16x8 qf[4]; load_q(Qb + (size_t)(32 * w + r) * 64, h, qf);
    f32x16 ot[2]; zero_ot(ot); float lsum = 0.f;
    const int kend = q0 + 256;
#define MOBA_NEXT(k_, out_) do { int kk_ = (k_) + 64; while (kk_ < q0 && !((uni >> (kk_ >> 8)) & 1u)) kk_ = (kk_ | 255) + 1; (out_) = kk_; } while (0)
    int key0, knext, knext2; MOBA_NEXT(-64, key0); MOBA_NEXT(key0, knext);
    u32x4 rkA_, rvA_, rkB_, rvB_;
    stage_ld(K, Vt, SEQ, key0, tid, rkA_, rvA_); stage_st(lds, 0, tid, rkA_, rvA_);
    if (knext < kend) stage_ld(K, Vt, SEQ, knext, tid, rkA_, rvA_);
    __syncthreads();
    int buf = 0;
    while (key0 < kend) {
        MOBA_NEXT(knext, knext2);
        if (knext < kend && knext2 < kend) stage_ld(K, Vt, SEQ, knext2, tid, rkB_, rvB_);
        {
            LAS const unsigned char* ks = lds + buf * 18432; LAS const unsigned char* vs = ks + 9216;
            const int n = key0 >> 8; const bool own = (n == blk);
            const bool lane_valid = own ? true : (((sel >> n) & 1u) != 0u);
            const bool skip = own ? (key0 > q0 + 32 * w + 31) : (__ballot(lane_valid) == 0ull);
            if (!skip) {
                const bool near = (q0 + 32 * w) - (key0 + 63) < 128;
                const int dist00 = t - (key0 + 8 * h);
                if (near) tile_soft<1>(ks, vs, qf, ot, lsum, lane_valid, dist00, 0, bt, r, h);
                else tile_soft<0>(ks, vs, qf, ot, lsum, lane_valid, dist00, 0, bt, r, h);
            }
        }
        if (knext < kend) stage_st(lds, buf ^ 1, tid, rkA_, rvA_);
        __syncthreads(); buf ^= 1; key0 = knext; knext = knext2; rkA_ = rkB_; rvA_ = rvB_;
    }
#undef MOBA_NEXT
    const float l = lsum + __shfl_xor(lsum, 32); const float inv = 1.0f / fmaxf(l, 1e-30f);
#pragma unroll
    for (int i = 0; i < 16; ++i) { ot[0][i] *= inv; ot[1][i] *= inv; }
    store_ot(omix + ((size_t)b * SEQ + t) * DM + 256 + hd * 64, ot, h);
}

__device__ __forceinline__ void imp_sub(f32x16& st, float invc, int nbase, LAS float* improw, int r) {
#pragma unroll
    for (int j = 0; j < 2; ++j) { const int a = (nbase + 16 * j) >> 3;
        float s0 = ((st[8 * j] + st[8 * j + 1]) + (st[8 * j + 2] + st[8 * j + 3])) * invc;
        float s1 = ((st[8 * j + 3] + st[8 * j + 4]) + (st[8 * j + 5] + st[8 * j + 6]) + st[8 * j + 7]) * invc;
        float s2 = st[8 * j + 7] * invc;
        s0 += __shfl_xor(s0, 8); s0 += __shfl_xor(s0, 16); s1 += __shfl_xor(s1, 8); s1 += __shfl_xor(s1, 16); s2 += __shfl_xor(s2, 8); s2 += __shfl_xor(s2, 16);
        if (r < 8) { LAS float* ip = improw + 2 * a; ip[0] += s0; ip[1] += s1; if (2 * a + 2 < 128) ip[2] += s2; } }
}
__device__ __forceinline__ void nsa_unit(LAS unsigned char* lds, const unsigned char* hb, const bf16_t* kc, const bf16_t* vct, const float* nsg, bf16_t* omix, int b, int g, int c, int tid) {
    const int lane = tid & 63, w = tid >> 6, r = lane & 31, h = lane >> 5;
    const int bg = b * 2 + g, q0 = c * 64, ql = 8 * w + (r & 7), t = q0 + ql, hq = 4 * g + (r >> 3);
    const bf16_t* Q = (const bf16_t*)(hb + HB_NSQ * MiB) + ((size_t)(b * 8 + hq) * SEQ + t) * 64;
    LAS unsigned* selm = (LAS unsigned*)(lds + ATT_SEL); LAS float* imp = (LAS float*)(lds + ATT_X);
    LAS const float* bt = (LAS const float*)(lds + ATT_BT) + (4 + hq) * BT_N;
    const float* gate = nsg + ((size_t)b * SEQ + t) * 24 + hq;
    bf16x8 qf[4]; load_q(Q, h, qf);
    f32x16 ot[2]; zero_ot(ot);
    LAS unsigned* oal = (LAS unsigned*)(lds + ATT_OA) + (w * 16) * 64 + lane;
    const bf16_t* Kc = kc + (size_t)bg * 512 * 64; const bf16_t* Vc = vct + (size_t)bg * 64 * 512;
    const int ntc = (4 * c + 3 + 63) >> 6;
    float lsum = 0.f;
    TILE_LOOP(Kc, Vc, 512, 0, ntc, {
        tile_soft<3>(ks, vs, qf, ot, lsum, true, t - 31 - 16 * (key0 + 8 * h), 0, bt, r, h); });
    const float lc = lsum + __shfl_xor(lsum, 32); const float invc = 1.0f / fmaxf(lc, 1e-30f);
    { const float gc = gate[0] * invc;
#pragma unroll
        for (int i = 0; i < 8; ++i) { oal[i * 64] = pk2(ot[0][2 * i] * gc, ot[0][2 * i + 1] * gc); oal[(8 + i) * 64] = pk2(ot[1][2 * i] * gc, ot[1][2 * i + 1] * gc); } }
    for (int i = tid; i < 64 * 129; i += 512) imp[i] = 0.f;
    if (tid < 256) selm[tid] = 0u;
    TILE_LOOP(Kc, Vc, 512, 0, ntc, {
        f32x16 s0 = qk_sub(ks, 0, qf, r, h); f32x16 s1 = qk_sub(ks, 1, qf, r, h); float dummy = 0.f;
        const int dist00 = t - 31 - 16 * (key0 + 8 * h);
        soft_sub<3>(s0, dummy, true, dist00, 0, bt); imp_sub(s0, invc, key0 + 8 * h, imp + ql * 129, r);
        soft_sub<3>(s1, dummy, true, dist00 - 512, 0, bt); imp_sub(s1, invc, key0 + 32 + 8 * h, imp + ql * 129, r); });
    { const int qi = tid >> 3, sub = tid & 7;
        if (c >= 16) {
            { LAS const float* row = imp + qi * 129; unsigned long long kv[16]; int cnt[16];
#pragma unroll
                for (int k = 0; k < 16; ++k) { const int m = 1 + sub + 8 * k; const int mi = m <= 128 ? m : 128; kv[k] = ((unsigned long long)__float_as_uint(row[mi]) << 8) | (unsigned long long)(255 - m); cnt[k] = 0; }
                for (int m2 = 1; m2 <= c - 2; m2 += 8) { unsigned long long kx[8];
#pragma unroll
                    for (int j = 0; j < 8; ++j) { const int mm = m2 + j; const int mi = mm <= 128 ? mm : 128; const float x = row[mi]; kx[j] = mm <= c - 2 ? (((unsigned long long)__float_as_uint(x) << 8) | (unsigned long long)(255 - mm)) : 0ull; }
#pragma unroll
                    for (int j = 0; j < 8; ++j)
#pragma unroll
                        for (int k = 0; k < 16; ++k) cnt[k] += kx[j] > kv[k] ? 1 : 0; }
#pragma unroll
                for (int k = 0; k < 16; ++k) { const int m = 1 + sub + 8 * k; if (m <= c - 2 && cnt[k] < 13) atomicOr((unsigned*)&selm[qi * 4 + (m >> 5)], 1u << (m & 31)); } }
            if (sub == 0) { atomicOr((unsigned*)&selm[qi * 4], 1u); atomicOr((unsigned*)&selm[qi * 4 + ((c - 1) >> 5)], 1u << ((c - 1) & 31)); atomicOr((unsigned*)&selm[qi * 4 + (c >> 5)], 1u << (c & 31)); }
        } else if (sub == 0) selm[qi * 4] = (1u << (c + 1)) - 1u;
    }
    __syncthreads();
    const unsigned sel0 = selm[ql * 4], sel1 = selm[ql * 4 + 1], sel2 = selm[ql * 4 + 2], sel3 = selm[ql * 4 + 3];
    { const bf16_t* Ks = (const bf16_t*)(hb + HB_KS * MiB) + (size_t)bg * SEQ * 64; const bf16_t* Vs = (const bf16_t*)(hb + HB_VST * MiB) + (size_t)bg * 64 * SEQ;
        zero_ot(ot); lsum = 0.f;
        TILE_LOOP(Ks, Vs, SEQ, 0, c + 1, {
            const int m = key0 >> 6; const unsigned sw = m < 32 ? sel0 : (m < 64 ? sel1 : (m < 96 ? sel2 : sel3));
            const bool lane_valid = ((sw >> (m & 31)) & 1u) != 0u;
            if (__ballot(lane_valid) != 0ull) { const int dist00 = t - (key0 + 8 * h);
                if ((c - m) < 3) tile_soft<1>(ks, vs, qf, ot, lsum, lane_valid, dist00, 0, bt, r, h);
                else tile_soft<0>(ks, vs, qf, ot, lsum, lane_valid, dist00, 0, bt, r, h); } });
        const float l = lsum + __shfl_xor(lsum, 32); const float gs = gate[8] / fmaxf(l, 1e-30f);
#pragma unroll
        for (int i = 0; i < 8; ++i) { const unsigned a0 = oal[i * 64], a1 = oal[(8 + i) * 64];
            oal[i * 64] = pk2(bflo(a0) + ot[0][2 * i] * gs, bfhi(a0) + ot[0][2 * i + 1] * gs); oal[(8 + i) * 64] = pk2(bflo(a1) + ot[1][2 * i] * gs, bfhi(a1) + ot[1][2 * i + 1] * gs); } }
    { const bf16_t* Kw = (const bf16_t*)(hb + HB_KW * MiB) + (size_t)bg * SEQ * 64; const bf16_t* Vw = (const bf16_t*)(hb + HB_VWT * MiB) + (size_t)bg * 64 * SEQ;
        zero_ot(ot); lsum = 0.f;
        const int kfirst = q0 >= 512 ? q0 - 512 : 0; const int ntw = ((q0 - kfirst) >> 6) + 1;
        TILE_LOOP(Kw, Vw, SEQ, kfirst, ntw, {
            const int dist00 = t - (key0 + 8 * h);
            if (key0 >= q0 - 128) tile_soft<1>(ks, vs, qf, ot, lsum, true, dist00, 0, bt, r, h);
            else if (key0 == q0 - 512) tile_soft<2>(ks, vs, qf, ot, lsum, true, dist00, 512, bt, r, h);
            else tile_soft<0>(ks, vs, qf, ot, lsum, true, dist00, 0, bt, r, h); });
        const float l = lsum + __shfl_xor(lsum, 32); const float gw = gate[16] / fmaxf(l, 1e-30f);
#pragma unroll
        for (int i = 0; i < 8; ++i) { const unsigned a0 = oal[i * 64], a1 = oal[(8 + i) * 64];
            ot[0][2 * i] = bflo(a0) + ot[0][2 * i] * gw; ot[0][2 * i + 1] = bfhi(a0) + ot[0][2 * i + 1] * gw; ot[1][2 * i] = bflo(a1) + ot[1][2 * i] * gw; ot[1][2 * i + 1] = bfhi(a1) + ot[1][2 * i + 1] * gw; } }
    store_ot(omix + ((size_t)b * SEQ + t) * DM + 512 + hq * 64, ot, h);
}

constexpr int FG_STAGE = 55296, FG_B = 36864, FG_PATCH = 110592;
__device__ __forceinline__ void fg_ld(const bf16_t* A, const bf16_t* Bt, int kt, int tid, u32x4 (&ra)[4], u32x4 (&rb)[2]) {
#pragma unroll
    for (int i = 0; i < 4; ++i) { const unsigned p = (unsigned)(tid + 512 * i); ra[i] = *(const u32x4*)(A + 64 * kt + ((p >> 3) * 1024u + 8u * (p & 7u))); }
#pragma unroll
    for (int i = 0; i < 2; ++i) { const unsigned p = (unsigned)(tid + 512 * i); rb[i] = *(const u32x4*)(Bt + 64 * kt + ((p >> 3) * 1024u + 8u * (p & 7u))); }
}
__device__ __forceinline__ void fg_st(LAS unsigned char* st, int tid, const u32x4 (&ra)[4], const u32x4 (&rb)[2]) {
#pragma unroll
    for (int i = 0; i < 4; ++i) { const int p = tid + 512 * i; *(LAS u32x4*)(st + (p >> 3) * 144 + (p & 7) * 16) = ra[i]; }
#pragma unroll
    for (int i = 0; i < 2; ++i) { const int p = tid + 512 * i; *(LAS u32x4*)(st + FG_B + (p >> 3) * 144 + (p & 7) * 16) = rb[i]; }
}
__device__ __forceinline__ void branch_tile(LAS unsigned char* lds, const bf16_t* omix, const bf16_t* wbr, const bf16_t* brg, bf16_t* mix, int pm, int pn, int tid) {
    const int lane = tid & 63, w = tid >> 6, r = lane & 31, h = lane >> 5, wr = w >> 1, wc = w & 1;
    const bf16_t* A = omix + (size_t)pm * 256 * DM; const bf16_t* Bt = wbr + (size_t)pn * 128 * DM;
    LAS unsigned char* patch = lds + FG_PATCH + w * 2560;
    f32x16 seg[2][2]; unsigned tot[2][2][8];
#pragma unroll
    for (int a = 0; a < 2; ++a)
#pragma unroll
        for (int c = 0; c < 2; ++c)
#pragma unroll
            for (int i = 0; i < 16; ++i) { seg[a][c][i] = 0.f; tot[a][c][i >> 1] = 0u; }
    u32x4 ra0[4], rb0[2], ra1[4], rb1[2];
    __syncthreads();
    fg_ld(A, Bt, 0, tid, ra0, rb0); fg_st(lds, tid, ra0, rb0);
    fg_ld(A, Bt, 1, tid, ra1, rb1);
    __syncthreads();
#define FG_COMPUTE(BUF) { LAS const unsigned char* sa = lds + (BUF) * FG_STAGE + (64 * wr + r) * 144 + h * 16; LAS const unsigned char* sb = lds + (BUF) * FG_STAGE + FG_B + (64 * wc + r) * 144 + h * 16; \
        _Pragma("unroll") for (int kk = 0; kk < 4; ++kk) { const bf16x8 a0 = *(LAS const bf16x8*)(sa + kk * 32), a1 = *(LAS const bf16x8*)(sa + 32 * 144 + kk * 32); \
            const bf16x8 b0 = *(LAS const bf16x8*)(sb + kk * 32), b1 = *(LAS const bf16x8*)(sb + 32 * 144 + kk * 32); \
            seg[0][0] = MFMA32(a0, b0, seg[0][0]); seg[0][1] = MFMA32(a0, b1, seg[0][1]); seg[1][0] = MFMA32(a1, b0, seg[1][0]); seg[1][1] = MFMA32(a1, b1, seg[1][1]); } }
#define FG_BAR() do { asm volatile("s_waitcnt lgkmcnt(0)" ::: "memory"); __builtin_amdgcn_s_barrier(); asm volatile("" ::: "memory"); } while (0)
#pragma unroll 1
    for (int kt = 0; kt < 16; kt += 2) {
        fg_ld(A, Bt, (kt + 2 < 16 ? kt + 2 : 15), tid, ra0, rb0);
        FG_COMPUTE(0);
        fg_st(lds + FG_STAGE, tid, ra1, rb1);
        FG_BAR();
        fg_ld(A, Bt, (kt + 3 < 16 ? kt + 3 : 15), tid, ra1, rb1);
        const bool segend = (kt == 2) || (kt == 6) || (kt == 14);
        const int s = kt == 2 ? 0 : (kt == 6 ? 1 : 2);
        u32x4 g0, g1;
#define FG_GLD(dst, rt_, ct_) { dst = *(const u32x4*)((const unsigned char*)brg + ((unsigned)(pm * 256 + 64 * wr + 32 * (rt_) + (lane >> 1)) * 3072u + (unsigned)(1024 * s + pn * 128 + 64 * wc + 32 * (ct_) + 16 * (lane & 1)))); }
#define FG_GATE(src, rt_, ct_) { *(LAS u32x4*)(patch + (lane >> 1) * 48 + (lane & 1) * 16) = src; }
#define FG_ACC(rt_, ct_) { float gg[16]; \
            _Pragma("unroll") for (int i = 0; i < 16; ++i) { const int tr = 8 * (i >> 2) + 4 * h + (i & 3); gg[i] = (float)(*(LAS const unsigned char*)(patch + tr * 48 + r)) * (1.0f / 255.0f); } \
            _Pragma("unroll") for (int p2 = 0; p2 < 8; ++p2) { const unsigned tv = tot[rt_][ct_][p2]; \
                tot[rt_][ct_][p2] = pk2(fmaf(gg[2 * p2], seg[rt_][ct_][2 * p2], bflo(tv)), fmaf(gg[2 * p2 + 1], seg[rt_][ct_][2 * p2 + 1], bfhi(tv))); seg[rt_][ct_][2 * p2] = 0.f; seg[rt_][ct_][2 * p2 + 1] = 0.f; } }
        if (segend) { FG_GLD(g0, 0, 0); FG_GLD(g1, 0, 1); }
        FG_COMPUTE(1);
        if (segend) {
            FG_GATE(g0, 0, 0); FG_GLD(g0, 1, 0); FG_ACC(0, 0);
            FG_GATE(g1, 0, 1); FG_GLD(g1, 1, 1); FG_ACC(0, 1);
            FG_GATE(g0, 1, 0); FG_ACC(1, 0);
            FG_GATE(g1, 1, 1); FG_ACC(1, 1);
        }
#undef FG_GLD
#undef FG_GATE
#undef FG_ACC
        fg_st(lds, tid, ra0, rb0);
        FG_BAR();
    }
#undef FG_COMPUTE
#undef FG_BAR
#pragma unroll
    for (int rt = 0; rt < 2; ++rt)
#pragma unroll
        for (int ct = 0; ct < 2; ++ct) { const int tok0 = pm * 256 + 64 * wr + 32 * rt, n0 = pn * 128 + 64 * wc + 32 * ct;
#pragma unroll
            for (int p2 = 0; p2 < 8; ++p2) { const int tr = 8 * (p2 >> 1) + 4 * h + 2 * (p2 & 1); const unsigned tv = tot[rt][ct][p2];
                *(LAS unsigned short*)(patch + tr * 80 + r * 2) = (unsigned short)(tv & 0xffffu); *(LAS unsigned short*)(patch + (tr + 1) * 80 + r * 2) = (unsigned short)(tv >> 16); }
#pragma unroll
            for (int j = 0; j < 2; ++j) { const int p = lane + 64 * j; const u32x4 ov = *(LAS const u32x4*)(patch + (p >> 2) * 80 + (p & 3) * 16);
                *(u32x4*)(mix + ((unsigned)(tok0 + (p >> 2)) * 1024u + (unsigned)(n0 + 8 * (p & 3)))) = ov; } }
}

#define LAUNDER_S(x) asm volatile("" : "+s"(x))
#define GAS __attribute__((address_space(1)))
#define INP(k) ({ int k_ = (k); LAUNDER_S(k_); (const float*)(const GAS float*)P.in[k_]; })
#define POUT ((float*)(GAS float*)P.out)
#define PHASE_BEGIN int L = layer; LAUNDER_S(L); GAS unsigned char* wsg_ = (GAS unsigned char*)P.ws; LAUNDER_S(wsg_); unsigned char* ws = (unsigned char*)wsg_; int G = gridDim.x, bx = blockIdx.x; LAUNDER_S(G); LAUNDER_S(bx); int tid = threadIdx.x; asm volatile("" : "+v"(tid)); const int lane = tid & 63, wave = __builtin_amdgcn_readfirstlane(tid >> 6); (void)lane; (void)wave; (void)G; (void)bx; (void)L; (void)ws;
__global__ void __launch_bounds__(512, 2) hybrid_fwd(Params P) {
    extern __shared__ __attribute__((aligned(16))) unsigned char lds_raw[];
    LAS unsigned char* lds = (LAS unsigned char*)lds_raw;
    cg::grid_group grid = cg::this_grid();
#pragma unroll 1
    for (int layer = 0; layer < 2; ++layer) {
#ifndef REP_A
#define REP_A 1
#endif
#ifndef REP_CD
#define REP_CD 1
#endif
        for (int repa_ = 0; repa_ < REP_A; ++repa_)
        { PHASE_BEGIN
            const int gtid = bx * 512 + tid, gthreads = G * 512, gwave = bx * 8 + wave, nwaves = G * 8;
            prep_w<1>(INP(3) + (size_t)L * DM * NIN, DM, NIN, (bf16_t*)(ws + WS_WIN), NINP, DM, lds, tid, bx, G);
            prep_w<3>(INP(11) + (size_t)L * DM * DM, DM, DM, (bf16_t*)(ws + WS_WBR), DM, DM, lds, tid, bx, G);
            prep_w<0>(INP(12) + (size_t)L * DM * DM, DM, DM, (bf16_t*)(ws + WS_WOUT), DM, DM, lds, tid, bx, G);
            prep_w<2>(INP(14) + (size_t)L * DM * 2 * DFF, DM, 2 * DFF, (bf16_t*)(ws + WS_WGU), 2 * DFF, DM, lds, tid, bx, G, INP(13) + L * DM);
            for (int i = gtid; i < MTOK; i += gthreads) ((float*)(ws + WS_SMALL + 262144))[i] = 0.f;
            prep_w<0>(INP(15) + (size_t)L * DFF * DM, DFF, DM, (bf16_t*)(ws + WS_WDN), DM, DFF, lds, tid, bx, G);
            const float* cw1 = INP(9) + (size_t)L * 2 * 2048 * 256;
            prep_w<0>(cw1, 2048, 256, (bf16_t*)(ws + WS_WC1), 256, 2048, lds, tid, bx, G);
            prep_w<0>(cw1 + 2048 * 256, 2048, 256, (bf16_t*)(ws + WS_WC1) + 256 * 2048, 256, 2048, lds, tid, bx, G);
            rmsnorm_rows(L == 0 ? INP(0) : (const float*)POUT, INP(2) + L * DM, (bf16_t*)(ws + WS_H), gwave, nwaves, lane);
            if (gwave < 512) { const int kv = gwave >> 8, j = gwave & 255; const float* pp = INP(8) + (size_t)L * 2 * 2048 + kv * 2048; const float* ww = cw1 + (size_t)kv * 2048 * 256 + j; float a = 0.f;
#pragma unroll 8
                for (int i = lane; i < 2048; i += 64) a = fmaf(pp[i], ww[(size_t)i * 256], a);
                a = wave_sum(a);
                if (lane == 0) ((float*)(ws + WS_SMALL))[kv * 256 + j] = a; }
            if (bx == 1 && tid < 384) { float* nw = (float*)(ws + WS_SMALL + 2048); const float v = tid < 64 ? (INP(4) + L * 64)[tid] : (tid < 128 ? (INP(5) + L * 64)[tid - 64] : (tid < 192 ? (INP(6) + L * 64)[tid - 128] : (INP(7) + L * 192)[tid - 192])); nw[tid] = v; }
        }
        grid.sync();

        { PHASE_BEGIN
            pg8::Gemm g{(const bf16_t*)(ws + WS_H), (const bf16_t*)(ws + WS_WIN), MTOK, NINP, DM, DM, DM}; pg8::StaticOrder S; S.init(MTOK, NINP, G, bx);
            EpiInproj E{ws, (const float*)(ws + WS_SMALL + 2048)};
#ifndef SKIP_B
            pg8::gemm_phase<EpiInproj, pg8::StaticOrder, true, true>(lds, g, S, E, tid);
#endif
        }
        grid.sync();

        for (int repcd_ = 0; repcd_ < REP_CD; ++repcd_) {
        { PHASE_BEGIN
            if (bx < 128) { const int kv = bx >> 6, ks = (bx >> 4) & 3;
                pg8::Gemm g{(const bf16_t*)(ws + WS_B + (kv ? HB_VCR : HB_KCR) * MiB) + ks * 512, (const bf16_t*)(ws + WS_WC1) + (size_t)kv * 256 * 2048 + ks * 512, 4096, 256, 512, 1024, 2048};
                pg8::StaticOrder S; S.init(4096, 256, G, bx & 15);
                EpiStoreF32 E{(float*)(ws + WS_H) + (size_t)(kv * 4 + ks) * 4096 * 256};
#ifndef SKIP_C
                pg8::gemm_phase<EpiStoreF32, pg8::StaticOrder, true, true>(lds, g, S, E, tid);
#endif
            } else {
                const bf16_t* mbk = (const bf16_t*)(ws + WS_B + HB_MBK * MiB); float* KMEAN = (float*)(ws + WS_SMALL + 4096);
                for (int item = (bx - 128) * 8 + wave; item < 512; item += (G - 128) * 8) { const int bh = item >> 5, n = item & 31;
                    const bf16_t* kp = mbk + ((size_t)bh * SEQ + 256 * n) * 64 + lane; float a = 0.f;
#pragma unroll 8
                    for (int j = 0; j < 256; ++j) a += bf2f(kp[(size_t)j * 64]);
                    KMEAN[(size_t)item * 64 + lane] = a * (1.0f / 256.0f); }
            }
        }
        grid.sync();

        { PHASE_BEGIN
            const int gwave = bx * 8 + wave, nwaves = G * 8;
            const float* cw2 = INP(10) + (size_t)L * 2 * 256 * 64; const float* nkn = INP(7) + L * 192;
            bf16_t* KC = (bf16_t*)(ws + WS_KC); bf16_t* VCT = (bf16_t*)(ws + WS_VCT);
            for (int row = gwave; row < 8192; row += nwaves) { const int kv = row >> 12, rr = row & 4095, bg = rr >> 9, n = rr & 511;
                f32x4 hv = *(const f32x4*)((const float*)(ws + WS_SMALL) + kv * 256 + 4 * lane);
                { const float* pp = (const float*)(ws + WS_H) + ((size_t)(kv * 4) * 4096 + rr) * 256 + 4 * lane;
#pragma unroll
                    for (int ks = 0; ks < 4; ++ks) hv += *(const f32x4*)(pp + (size_t)ks * 4096 * 256);
#pragma unroll
                    for (int e = 0; e < 4; ++e) { const float t = hv[e], z = 0.7978845608028654f * (t + 0.044715f * t * t * t);
                        const float th = 1.0f - 2.0f * __builtin_amdgcn_rcpf(1.0f + __expf(2.0f * z)); hv[e] = 0.5f * t * (1.0f + th); } }
                const float* wp = cw2 + (size_t)kv * 256 * 64 + lane; float a = 0.f;
#pragma unroll
                for (int k = 0; k < 256; ++k) { const float hk = __uint_as_float(__builtin_amdgcn_readlane(__float_as_uint(hv[k & 3]), k >> 2)); a = fmaf(hk, wp[k * 64], a); }
                if (kv == 0) { const float ss = wave_sum(a * a); float y = a * __builtin_amdgcn_rsqf(ss * (1.0f / 64.0f) + 1e-6f) * nkn[lane]; if (n == 511) y = 0.f;
                    KC[((size_t)bg * 512 + n) * 64 + lane] = (bf16_t)(pk2(y, 0.f) & 0xffffu); }
                else { if (n == 511) a = 0.f; VCT[((size_t)bg * 64 + lane) * 512 + n] = (bf16_t)(pk2(a, 0.f) & 0xffffu); } }
        }
        grid.sync();

        }
        { PHASE_BEGIN
            LAS unsigned* misc = (LAS unsigned*)(lds + ATT_MISC); LAS float* btab = (LAS float*)(lds + ATT_BT);
            const float* rel_bias = INP(1);
            __syncthreads();
            if (wave == 0) { const float* mqn = INP(4) + L * 64; const float* mkn = INP(5) + L * 64; const float* nqn = INP(6) + L * 64; const float* nkn = INP(7) + L * 192;
                float gq = fmaxf(fabsf(mqn[lane]), fabsf(nqn[lane])); float gk = fmaxf(fmaxf(fabsf(mkn[lane]), fabsf(nkn[lane])), fmaxf(fabsf(nkn[64 + lane]), fabsf(nkn[128 + lane])));
                float bm = 0.f;
#pragma unroll
                for (int i = 0; i < 6; ++i) bm = fmaxf(bm, fabsf(rel_bias[lane + 64 * i]));
                gq = wave_max(gq); gk = wave_max(gk); bm = wave_max(bm);
                if (lane == 0) ((LAS float*)misc)[2] = 8.0f * gq * gk + bm; }
            __syncthreads();
            const float shift = ((LAS float*)misc)[2];
            for (int i = tid; i < 12 * BT_N; i += 512) { const int hd = i / BT_N, jx = i - hd * BT_N; const int d = jx - 64;
                float v = -3.0e38f;
                if (d >= 0) { int bk; if (d < 16) bk = d; else if (d >= 128) bk = 31; else { bk = 16 + (int)(__log2f((float)d * (1.0f / 16.0f)) * (16.0f / 3.0f)); bk = bk > 31 ? 31 : bk; }
                    v = (rel_bias[bk * 12 + hd] - shift) * L2E; }
                btab[i] = v; }
            __syncthreads();
#ifndef REP_E
#define REP_E 1
#endif
            for (int rep_ = 0; rep_ < REP_E; ++rep_) {
            unsigned* ctl = (unsigned*)(ws + WS_CTL) + L + 2 * rep_;
            unsigned char* HBUF = ws + WS_B; bf16_t* OMIX = (bf16_t*)(ws + WS_H);
            for (;;) {
                __syncthreads();
                if (tid == 0) misc[0] = atomicAdd(ctl, 1u);
                __syncthreads();
                const int u = (int)misc[0];
                if (u >= 2048) break;
                int tidu = tid; asm volatile("" : "+v"(tidu));
                if (u < 1024) { const int c = 127 - (u >> 3), bg = u & 7;
#ifndef SKIP_NSA
                    nsa_unit(lds, HBUF, (const bf16_t*)(ws + WS_KC), (const bf16_t*)(ws + WS_VCT), (const float*)(ws + WS_NSG), OMIX, bg >> 1, bg & 1, c, tidu);
#endif
                }
                else if (u < 1536) { const int v = u - 1024;
#ifndef SKIP_MOBA
                    moba_unit(lds, HBUF, (const float*)(ws + WS_SMALL + 4096), OMIX, (v & 15) >> 2, v & 3, 31 - (v >> 4), tidu);
#endif
                }
                else { const int v = u - 1536;
#ifndef SKIP_SB
                    sb_unit(lds, HBUF, OMIX, (v & 15) >> 2, v & 3, 31 - (v >> 4), tidu);
#endif
                }
            }
            }
        }
        grid.sync();

        { PHASE_BEGIN
            for (int it = bx; it < 256; it += G)
                for (int i = 0; i < 4; ++i) { int tidu = tid; asm volatile("" : "+v"(tidu));
                    branch_tile(lds, (const bf16_t*)(ws + WS_H), (const bf16_t*)(ws + WS_WBR), (const bf16_t*)(ws + WS_A), (bf16_t*)(ws + WS_B), it >> 1, 4 * (it & 1) + i, tidu); }
        }
        grid.sync();

        { PHASE_BEGIN
            pg8::Gemm g{(const bf16_t*)(ws + WS_B), (const bf16_t*)(ws + WS_WOUT), MTOK, DM, DM, DM, DM}; pg8::StaticOrder S; S.init(MTOK, DM, G, bx);
            EpiResNormB E{L == 0 ? INP(0) : (const float*)POUT, (bf16_t*)(ws + WS_H), (float*)(ws + WS_SMALL + 262144)};
#ifndef SKIP_GJ
            pg8::gemm_phase<EpiResNormB, pg8::StaticOrder, true, true>(lds, g, S, E, tid);
#endif
        }
        grid.sync();

        { PHASE_BEGIN
            pg8::Gemm g{(const bf16_t*)(ws + WS_H), (const bf16_t*)(ws + WS_WGU), MTOK, 2 * DFF, DM, DM, DM}; pg8::StaticOrder S; S.init(MTOK, 2 * DFF, G, bx); EpiSwiglu E{(bf16_t*)(ws + WS_A), (const float*)(ws + WS_SMALL + 262144)};
#ifndef SKIP_I
            pg8::gemm_phase<EpiSwiglu, pg8::StaticOrder, true, true>(lds, g, S, E, tid);
#endif
        }
        grid.sync();

        { PHASE_BEGIN
            pg8::Gemm g{(const bf16_t*)(ws + WS_A), (const bf16_t*)(ws + WS_WDN), MTOK, DM, DFF, DFF, DFF}; pg8::StaticOrder S; S.init(MTOK, DM, G, bx); EpiResB E{(const bf16_t*)(ws + WS_H), POUT};
#ifndef SKIP_GJ
            pg8::gemm_phase<EpiResB, pg8::StaticOrder, true, true>(lds, g, S, E, tid);
#endif
        }
        if (layer == 0) grid.sync();
    }
}

extern "C" void kernel_launch(void* const* d_in, const int* in_sizes, int n_in, void* d_out, int out_size, void* d_ws, size_t ws_size, hipStream_t stream) {
    static int grid = 0;
    if (grid == 0) {
        if (n_in != 16 || out_size != MTOK * DM || ws_size < WS_END) { fprintf(stderr, "kernel_launch: unexpected shapes (n_in %d out %d ws %zu, need ws >= %zu)\n", n_in, out_size, ws_size, (size_t)WS_END); grid = -1; return; }
        int dev = 0, cus = 0, per_cu = 0;
        hipGetDevice(&dev); hipDeviceGetAttribute(&cus, hipDeviceAttributeMultiprocessorCount, dev);
        if (hipFuncSetAttribute((const void*)hybrid_fwd, hipFuncAttributeMaxDynamicSharedMemorySize, LDS_BYTES) != hipSuccess) { fprintf(stderr, "kernel_launch: hipFuncSetAttribute failed\n"); grid = -1; return; }
        if (hipOccupancyMaxActiveBlocksPerMultiprocessor(&per_cu, (const void*)hybrid_fwd, 512, LDS_BYTES) != hipSuccess || per_cu < 1) { fprintf(stderr, "kernel_launch: occupancy query gave %d\n", per_cu); per_cu = 1; }
        (void)hipGetLastError();
        grid = cus * 1;
    }
    if (grid < 0) return;
    hipMemsetAsync((char*)d_ws + WS_CTL, 0, 4096, stream);
    Params p{};
    for (int i = 0; i < 16; ++i) p.in[i] = (const float*)d_in[i];
    p.out = (float*)d_out; p.ws = (unsigned char*)d_ws;
    void* args[] = {&p};
    hipError_t e = hipLaunchCooperativeKernel((const void*)hybrid_fwd, dim3(grid), dim3(512), args, LDS_BYTES, stream);
    if (e != hipSuccess) fprintf(stderr, "cooperative launch failed: %s (grid %d)\n", hipGetErrorString(e), grid);
}
```

```cpp
#include <hip/hip_runtime.h>
#include <hip/hip_cooperative_groups.h>
#include <cstdio>
#include <cstdint>
namespace cg = cooperative_groups;
namespace pg8 {
#define PG8_LAS __attribute__((address_space(3)))
typedef unsigned short bf16_t;
typedef short bf16x8 __attribute__((ext_vector_type(8)));
typedef float f32x4 __attribute__((ext_vector_type(4)));
typedef unsigned u32x4 __attribute__((ext_vector_type(4)));
constexpr int BM = 256, BK = 64, HALF = 128, HTB = HALF * BK * 2  , STAGE_BYTES = 8 * HTB, NXCD = 8, WGM = 8;

__host__ __device__ __forceinline__ int lds_byte(int r, int c) { const int st = (r >> 4) * 2 + (c >> 5), rr = r & 15, cc = c & 31, ob = rr * 64 + cc * 2; return st * 1024 + (ob ^ (((ob >> 9) & 1) << 5)); }
__host__ __device__ __forceinline__ void stage_rc(int b, int& R, int& C) { const int st = b / 1024, sb = b % 1024, swz = sb ^ (((sb >> 9) & 1) << 5); R = (st >> 1) * 16 + swz / 64; C = (st & 1) * 32 + (swz % 64) / 2; }
__host__ __device__ __forceinline__ int perm32(int rho) { const int n = rho >> 4, i = rho & 15; return 8 * (i >> 2) + 4 * n + (i & 3); }

struct Unit { int pm, pn; };
struct Gemm { const bf16_t* A; const bf16_t* Bt; int M, N, K, lda, ldb; };

struct StaticOrder {
    int nM, nN, nwg, G, c;
    __host__ __device__ void init(int M, int N, int G_, int c_) { nM = M / BM; nN = N / BM; nwg = nM * nN; G = G_; c = c_; }
    __host__ __device__ bool next(int i, Unit& u) const {
        const long L = (long)i * G + c; if (L >= nwg) return false;
        int wgid = (int)L; { const int q = nwg / NXCD, r = nwg % NXCD, xcd = wgid % NXCD, off = wgid / NXCD; wgid = (xcd < r ? xcd * (q + 1) : r * (q + 1) + (xcd - r) * q) + off; }
        const int nig = WGM * nN, gid = wgid / nig, fm = gid * WGM, gsz = (nM - fm) < WGM ? (nM - fm) : WGM;
        u.pm = fm + ((wgid % nig) % gsz); u.pn = (wgid % nig) / gsz; return true;
    }
    __device__ __forceinline__ void a_ready(const Unit&) const {}
    __device__ __forceinline__ void done(const Unit&) const {}
};
template <class Epi, class Sched, bool ALIGN_EPI = false, bool SP2 = false>
__device__ __forceinline__ void gemm_phase(PG8_LAS unsigned char* lds, const Gemm g, const Sched& S, const Epi& E, int tid_in) {
    const int tid = tid_in, wid = __builtin_amdgcn_readfirstlane(tid >> 6), lane = tid & 63, wr = wid >> 2, wc = wid & 3, fr = lane & 15, fq = lane >> 4;
    const int K = g.K, nt = K / BK;
    unsigned voffA[2], voffB[2];
#pragma unroll
    for (int i = 0; i < 2; ++i) { int R, C; stage_rc(tid * 16 + i * 8192, R, C); const int Rb = Epi::PERM ? ((R & ~31) + perm32(R & 31)) : R;
        voffA[i] = (unsigned)(R * g.lda + C) * 2u; voffB[i] = (unsigned)(Rb * g.ldb + C) * 2u; }
    const size_t kstep = (size_t)(BK * 2);
    const size_t hstepA = (size_t)HALF * g.lda * 2, hstepB = (size_t)HALF * g.ldb * 2;
    const size_t tstepA = 2 * hstepA, tstepB = 2 * hstepB;
    const unsigned ldsw = (unsigned)wid * 1024u;
    const int aoff = lds_byte(wr * 64 + fr, fq * 8), boff = lds_byte(wc * 32 + fr, fq * 8);
#define PG8_SA(b, h) (((b) * 2 + (h)) * HTB)
#define PG8_SB(b, h) ((4 + (b) * 2 + (h)) * HTB)
#define PG8_STAGE(bufoff, gbase, voff) do { _Pragma("unroll") for (int _i = 0; _i < 2; ++_i) \
        __builtin_amdgcn_global_load_lds((const unsigned*)((const char*)(gbase) + (voff)[_i]), (PG8_LAS unsigned*)(lds + (bufoff) + ldsw + _i * 8192), 16, 0, 0); } while (0)
#define PG8_LDA(dst, b, h) do { _Pragma("unroll") for (int m = 0; m < 4; ++m) _Pragma("unroll") for (int k = 0; k < 2; ++k) dst[m][k] = *(const PG8_LAS bf16x8*)(lds + PG8_SA(b, h) + aoff + m * 2048 + k * 1024); } while (0)
#define PG8_LDB(dst, b, h) do { _Pragma("unroll") for (int n = 0; n < 2; ++n) _Pragma("unroll") for (int k = 0; k < 2; ++k) dst[n][k] = *(const PG8_LAS bf16x8*)(lds + PG8_SB(b, h) + boff + n * 2048 + k * 1024); } while (0)
#define PG8_MMA(ai, bj, At, Bt) do { __builtin_amdgcn_s_setprio(1); _Pragma("unroll") for (int m = 0; m < 4; ++m) _Pragma("unroll") for (int n = 0; n < 2; ++n) _Pragma("unroll") for (int k = 0; k < 2; ++k) \
        acc[ai][bj][m][n] = __builtin_amdgcn_mfma_f32_16x16x32_bf16(Bt[n][k], At[m][k], acc[ai][bj][m][n], 0, 0, 0); __builtin_amdgcn_s_setprio(0); } while (0)
#define PG8_WAIT_V(n) asm volatile("s_waitcnt vmcnt(" #n ")" ::: "memory")
#define PG8_WAIT_L(n) asm volatile("s_waitcnt lgkmcnt(" #n ")" ::: "memory")
#define PG8_BAR __builtin_amdgcn_s_barrier()
#define PG8_SCHED __builtin_amdgcn_sched_barrier(0)
    Unit cur, nxt; int ui = 0;
    if (!S.next(0, cur)) return;
    f32x4 acc[2][2][4][2];
#pragma unroll
    for (int a = 0; a < 2; ++a)
#pragma unroll
        for (int b = 0; b < 2; ++b)
#pragma unroll
            for (int m = 0; m < 4; ++m)
#pragma unroll
                for (int n = 0; n < 2; ++n) acc[a][b][m][n] = (f32x4){0.f, 0.f, 0.f, 0.f};
    bf16x8 At[4][2], B0[2][2], B1[2][2];
    const char* cA = (const char*)g.A + (size_t)cur.pm * tstepA; const char* cB = (const char*)g.Bt + (size_t)cur.pn * tstepB;
    S.a_ready(cur);
    if constexpr (SP2) {
        PG8_STAGE(PG8_SB(0, 0), cB, voffB); PG8_STAGE(PG8_SB(0, 1), cB + hstepB, voffB); PG8_STAGE(PG8_SA(0, 0), cA, voffA); PG8_STAGE(PG8_SA(0, 1), cA + hstepA, voffA);
        if (wr == 1) PG8_BAR;
        PG8_WAIT_V(2); PG8_BAR;
        PG8_STAGE(PG8_SB(1, 0), cB + kstep, voffB); PG8_STAGE(PG8_SA(1, 0), cA + kstep, voffA); PG8_STAGE(PG8_SB(1, 1), cB + hstepB + kstep, voffB);
        PG8_WAIT_V(6); PG8_BAR;
    } else {
        PG8_STAGE(PG8_SB(0, 0), cB, voffB); PG8_STAGE(PG8_SA(0, 0), cA, voffA); PG8_STAGE(PG8_SB(0, 1), cB + hstepB, voffB); PG8_STAGE(PG8_SA(0, 1), cA + hstepA, voffA);
        if (wr == 1) PG8_BAR;
        PG8_WAIT_V(4); PG8_BAR;
        PG8_STAGE(PG8_SB(1, 0), cB + kstep, voffB); PG8_STAGE(PG8_SA(1, 0), cA + kstep, voffA); PG8_STAGE(PG8_SB(1, 1), cB + hstepB + kstep, voffB);
        PG8_WAIT_V(6); PG8_BAR;
    }
    for (;;) {
        const bool has_next = S.next(ui + 1, nxt);
        const char* nA = has_next ? (const char*)g.A + (size_t)nxt.pm * tstepA : cA; const char* nB = has_next ? (const char*)g.Bt + (size_t)nxt.pn * tstepB : cB;
#pragma unroll 1
        for (int t = 0; t < nt; t += 2) {
            const bool last = (t == nt - 2);
            const char* a1 = cA + (size_t)(t + 1) * kstep;
            const char* a2 = last ? nA : cA + (size_t)(t + 2) * kstep; const char* b2 = last ? nB : cB + (size_t)(t + 2) * kstep;
            const char* a3 = a2 + kstep; const char* b3 = b2 + kstep;
            if (last && has_next) S.a_ready(nxt);
            if constexpr (SP2) {
            PG8_LDB(B0, 0, 0); PG8_LDB(B1, 0, 1); PG8_SCHED; PG8_LDA(At, 0, 0); PG8_STAGE(PG8_SA(1, 1), a1 + hstepA, voffA);
            PG8_WAIT_V(8); PG8_WAIT_L(0); PG8_BAR; PG8_MMA(0, 0, At, B0); PG8_MMA(0, 1, At, B1); PG8_BAR; PG8_SCHED;
            PG8_LDA(At, 0, 1); PG8_STAGE(PG8_SB(0, 0), b2, voffB); PG8_STAGE(PG8_SB(0, 1), b2 + hstepB, voffB); PG8_STAGE(PG8_SA(0, 0), a2, voffA);
            PG8_WAIT_V(8); PG8_WAIT_L(0); PG8_BAR; PG8_MMA(1, 0, At, B0); PG8_MMA(1, 1, At, B1); PG8_BAR; PG8_SCHED;
            PG8_LDB(B0, 1, 0); PG8_LDB(B1, 1, 1); PG8_SCHED; PG8_LDA(At, 1, 0); PG8_STAGE(PG8_SA(0, 1), a2 + hstepA, voffA);
            PG8_WAIT_V(8); PG8_WAIT_L(0); PG8_BAR; PG8_MMA(0, 0, At, B0); PG8_MMA(0, 1, At, B1); PG8_BAR; PG8_SCHED;
            PG8_LDA(At, 1, 1); PG8_STAGE(PG8_SB(1, 0), b3, voffB); PG8_STAGE(PG8_SB(1, 1), b3 + hstepB, voffB); PG8_STAGE(PG8_SA(1, 0), a3, voffA);
            PG8_WAIT_V(8); PG8_WAIT_L(0); PG8_BAR; PG8_MMA(1, 0, At, B0); PG8_MMA(1, 1, At, B1); PG8_BAR; PG8_SCHED;
            } else {
            PG8_LDB(B0, 0, 0); PG8_SCHED; PG8_LDA(At, 0, 0); PG8_STAGE(PG8_SA(1, 1), a1 + hstepA, voffA);
            PG8_WAIT_L(8); PG8_BAR; PG8_WAIT_L(0); PG8_MMA(0, 0, At, B0); PG8_BAR; PG8_SCHED;
            PG8_LDB(B1, 0, 1); PG8_STAGE(PG8_SB(0, 0), b2, voffB);
            PG8_BAR; PG8_WAIT_L(0); PG8_MMA(0, 1, At, B1); PG8_BAR;
            PG8_LDA(At, 0, 1); PG8_STAGE(PG8_SA(0, 0), a2, voffA);
            PG8_BAR; PG8_WAIT_L(0); PG8_MMA(1, 0, At, B0); PG8_BAR; PG8_SCHED;
            PG8_STAGE(PG8_SB(0, 1), b2 + hstepB, voffB);
            PG8_WAIT_V(6); PG8_BAR; PG8_MMA(1, 1, At, B1); PG8_BAR;
            PG8_LDB(B0, 1, 0); PG8_SCHED; PG8_LDA(At, 1, 0); PG8_STAGE(PG8_SA(0, 1), a2 + hstepA, voffA);
            PG8_WAIT_L(8); PG8_BAR; PG8_WAIT_L(0); PG8_MMA(0, 0, At, B0); PG8_BAR; PG8_SCHED;
            PG8_LDB(B1, 1, 1); PG8_STAGE(PG8_SB(1, 0), b3, voffB);
            PG8_BAR; PG8_WAIT_L(0); PG8_MMA(0, 1, At, B1); PG8_BAR;
            PG8_LDA(At, 1, 1); PG8_STAGE(PG8_SA(1, 0), a3, voffA);
            PG8_BAR; PG8_WAIT_L(0); PG8_MMA(1, 0, At, B0); PG8_BAR; PG8_SCHED;
            PG8_STAGE(PG8_SB(1, 1), b3 + hstepB, voffB);
            PG8_WAIT_V(6); PG8_BAR; PG8_MMA(1, 1, At, B1); PG8_BAR;
            }
        }
        if constexpr (ALIGN_EPI) { if (wr == 0) PG8_BAR; }
        if constexpr (!Epi::AFTER_DRAIN) { E(acc, cur, wr, wc, fr, fq); S.done(cur); }
        if (!has_next) break;
#pragma unroll
        for (int a = 0; a < 2; ++a)
#pragma unroll
            for (int b = 0; b < 2; ++b)
#pragma unroll
                for (int m = 0; m < 4; ++m)
#pragma unroll
                    for (int n = 0; n < 2; ++n) acc[a][b][m][n] = (f32x4){0.f, 0.f, 0.f, 0.f};
        cur = nxt; cA = nA; cB = nB; ++ui;
        if constexpr (ALIGN_EPI) { if (wr == 1) PG8_BAR; }
    }
    PG8_WAIT_V(0);
    if constexpr (!ALIGN_EPI) { if (wr == 0) PG8_BAR; }
    PG8_BAR;
    if constexpr (Epi::AFTER_DRAIN) { E.fused(acc, cur, wr, wc, fr, fq, lds, wid, lane); S.done(cur); }
#undef PG8_SA
#undef PG8_SB
#undef PG8_STAGE
#undef PG8_LDA
#undef PG8_LDB
#undef PG8_MMA
#undef PG8_WAIT_V
#undef PG8_WAIT_L
#undef PG8_BAR
#undef PG8_SCHED
}
}

#define LAS __attribute__((address_space(3)))
typedef unsigned short bf16_t;
typedef short bf16x8 __attribute__((ext_vector_type(8)));
typedef float f32x4 __attribute__((ext_vector_type(4)));
typedef float f32x16 __attribute__((ext_vector_type(16)));
typedef unsigned u32x4 __attribute__((ext_vector_type(4)));
typedef unsigned u32x2 __attribute__((ext_vector_type(2)));
typedef float f32x2_t __attribute__((ext_vector_type(2)));
typedef __bf16 bf16x2_t __attribute__((ext_vector_type(2)));

constexpr int MTOK = 32768, DM = 1024, SEQ = 8192;
constexpr int NIN = 5912, NINP = 6144, DFF = 2816;
constexpr float L2E = 1.4426950408889634f;
constexpr size_t MiB = 1048576;
constexpr size_t WS_CTL = 0, WS_WIN = 1 * MiB, WS_WBR = 13 * MiB, WS_WOUT = 15 * MiB, WS_WGU = 17 * MiB, WS_WDN = 28 * MiB, WS_WC1 = 34 * MiB,
                 WS_SMALL = 36 * MiB, WS_CMPH = 37 * MiB, WS_KC = 45 * MiB, WS_VCT = 45 * MiB + 512 * 1024, WS_NSG = 46 * MiB,
                 WS_H = 49 * MiB  , WS_A = 113 * MiB  ,
                 WS_B = 305 * MiB  , WS_END = 481 * MiB;
constexpr size_t HB_SBQ = 0, HB_SBK = 16, HB_SBVT = 32, HB_MBQ = 48, HB_MBK = 64, HB_MBVT = 80, HB_NSQ = 96, HB_KCR = 128, HB_VCR = 136,
                 HB_KS = 144, HB_VST = 152, HB_KW = 160, HB_VWT = 168;
constexpr int LDS_BYTES = 147456;
constexpr int ATT_BT = 36864, ATT_MISC = 50688, ATT_SEL = 50944, ATT_X = 51968, ATT_OA = 93952;

struct Params { const float* in[16]; float* out; unsigned char* ws; };

__device__ __forceinline__ unsigned pk2(float lo, float hi) { f32x2_t v = {lo, hi}; bf16x2_t b = __builtin_convertvector(v, bf16x2_t); return __builtin_bit_cast(unsigned, b); }
__device__ __forceinline__ float bf2f(unsigned v16) { return __uint_as_float(v16 << 16); }
__device__ __forceinline__ float bflo(unsigned w) { return __uint_as_float(w << 16); }
__device__ __forceinline__ float bfhi(unsigned w) { return __uint_as_float(w & 0xffff0000u); }
__device__ __forceinline__ float wave_sum(float v) { v += __shfl_xor(v, 1); v += __shfl_xor(v, 2); v += __shfl_xor(v, 4); v += __shfl_xor(v, 8); v += __shfl_xor(v, 16); v += __shfl_xor(v, 32); return v; }
__device__ __forceinline__ float wave_max(float v) { v = fmaxf(v, __shfl_xor(v, 1)); v = fmaxf(v, __shfl_xor(v, 2)); v = fmaxf(v, __shfl_xor(v, 4)); v = fmaxf(v, __shfl_xor(v, 8)); v = fmaxf(v, __shfl_xor(v, 16)); v = fmaxf(v, __shfl_xor(v, 32)); return v; }
__device__ __forceinline__ float sigmoidf_(float x) { return __builtin_amdgcn_rcpf(1.0f + __expf(-x)); }
__device__ __forceinline__ float ex2(float x) { return __builtin_amdgcn_exp2f(x); }
__device__ __forceinline__ float lg2(float x) { return __builtin_amdgcn_logf(x); }

template <int MAP> __device__ __forceinline__ int mapcol(int p) {
    const int pn = p >> 8, q = p & 255, bj = q >> 7, wc = (q >> 5) & 3, n = (q >> 4) & 1, fq = (q >> 2) & 3, e = q & 3;
    const int lc = 64 * wc + 32 * bj + 8 * fq + 4 * n + e;
    if (MAP == 3) return p;
    if (MAP == 0) return 256 * pn + lc;
    if (MAP == 1) { if (pn <= 10) return 256 * pn + lc; if (pn == 11) return lc < 24 ? 2816 + lc : -1; return 2840 + 256 * (pn - 12) + lc; }
    const int j = 128 * pn + 32 * wc + 8 * fq + 4 * n + e; return bj ? DFF + j : j;
}

struct EpiRes {
    static constexpr bool PERM = false, AFTER_DRAIN = false;
    const float* res; float* out;
    __device__ __forceinline__ void operator()(const f32x4 (&acc)[2][2][4][2], const pg8::Unit& u, int wr, int wc, int fr_, int fq_) const {
        int fr = fr_, fq = fq_; asm volatile("" : "+v"(fr), "+v"(fq));
#pragma unroll
        for (int ai = 0; ai < 2; ++ai)
#pragma unroll
            for (int m = 0; m < 4; ++m) { const unsigned row = (unsigned)(u.pm * 256 + 128 * ai + 64 * wr + 16 * m + fr);
#pragma unroll
                for (int bj = 0; bj < 2; ++bj)
#pragma unroll
                    for (int n = 0; n < 2; ++n) { const unsigned o = row * 1024u + (unsigned)(u.pn * 256 + 64 * wc + 32 * bj + 8 * fq + 4 * n);
                        const f32x4 r = *(const f32x4*)(res + o); *(f32x4*)(out + o) = r + acc[ai][bj][m][n]; }
                __builtin_amdgcn_sched_barrier(0); }
    }
};
struct EpiResNormB {
    static constexpr bool PERM = false, AFTER_DRAIN = false;
    const float* res; bf16_t* xb; float* ssq;
    __device__ __forceinline__ void operator()(const f32x4 (&acc)[2][2][4][2], const pg8::Unit& u, int wr, int wc, int fr_, int fq_) const {
        int fr = fr_, fq = fq_; asm volatile("" : "+v"(fr), "+v"(fq));
#pragma unroll
        for (int ai = 0; ai < 2; ++ai)
#pragma unroll
            for (int m = 0; m < 4; ++m) { const unsigned row = (unsigned)(u.pm * 256 + 128 * ai + 64 * wr + 16 * m + fr); float ss = 0.f;
#pragma unroll
                for (int bj = 0; bj < 2; ++bj) { const unsigned o = row * 1024u + (unsigned)(u.pn * 256 + 64 * wc + 32 * bj + 8 * fq);
                    const f32x4 r0 = *(const f32x4*)(res + o), r1 = *(const f32x4*)(res + o + 4);
                    const f32x4 x0 = r0 + acc[ai][bj][m][0], x1 = r1 + acc[ai][bj][m][1];
                    u32x4 w; w.x = pk2(x0[0], x0[1]); w.y = pk2(x0[2], x0[3]); w.z = pk2(x1[0], x1[1]); w.w = pk2(x1[2], x1[3]);
                    *(u32x4*)(xb + o) = w;
                    ss += (x0[0] * x0[0] + x0[1] * x0[1]) + (x0[2] * x0[2] + x0[3] * x0[3]) + (x1[0] * x1[0] + x1[1] * x1[1]) + (x1[2] * x1[2] + x1[3] * x1[3]); }
                ss += __shfl_xor(ss, 16); ss += __shfl_xor(ss, 32);
                if (fq == 0) atomicAdd(ssq + row, ss);
                __builtin_amdgcn_sched_barrier(0); }
    }
};
struct EpiResNormBB {
    static constexpr bool PERM = false, AFTER_DRAIN = false;
    const bf16_t* resb; bf16_t* xb; float* ssq;
    __device__ __forceinline__ void operator()(const f32x4 (&acc)[2][2][4][2], const pg8::Unit& u, int wr, int wc, int fr_, int fq_) const {
        int fr = fr_, fq = fq_; asm volatile("" : "+v"(fr), "+v"(fq));
#pragma unroll
        for (int ai = 0; ai < 2; ++ai)
#pragma unroll
            for (int m = 0; m < 4; ++m) { const unsigned row = (unsigned)(u.pm * 256 + 128 * ai + 64 * wr + 16 * m + fr); float ss = 0.f;
#pragma unroll
                for (int bj = 0; bj < 2; ++bj) { const unsigned o = row * 1024u + (unsigned)(u.pn * 256 + 64 * wc + 32 * bj + 8 * fq);
                    const u32x4 rb = *(const u32x4*)(resb + o); const f32x4 a0 = acc[ai][bj][m][0], a1 = acc[ai][bj][m][1];
                    const float y0 = bflo(rb.x) + a0[0], y1 = bfhi(rb.x) + a0[1], y2 = bflo(rb.y) + a0[2], y3 = bfhi(rb.y) + a0[3];
                    const float y4 = bflo(rb.z) + a1[0], y5 = bfhi(rb.z) + a1[1], y6 = bflo(rb.w) + a1[2], y7 = bfhi(rb.w) + a1[3];
                    u32x4 w; w.x = pk2(y0, y1); w.y = pk2(y2, y3); w.z = pk2(y4, y5); w.w = pk2(y6, y7);
                    *(u32x4*)(xb + o) = w;
                    ss += (y0 * y0 + y1 * y1) + (y2 * y2 + y3 * y3) + (y4 * y4 + y5 * y5) + (y6 * y6 + y7 * y7); }
                ss += __shfl_xor(ss, 16); ss += __shfl_xor(ss, 32);
                if (fq == 0) atomicAdd(ssq + row, ss);
                __builtin_amdgcn_sched_barrier(0); }
    }
};
struct EpiResB {
    static constexpr bool PERM = false, AFTER_DRAIN = false;
    const bf16_t* resb; float* out;
    __device__ __forceinline__ void operator()(const f32x4 (&acc)[2][2][4][2], const pg8::Unit& u, int wr, int wc, int fr_, int fq_) const {
        int fr = fr_, fq = fq_; asm volatile("" : "+v"(fr), "+v"(fq));
#pragma unroll
        for (int ai = 0; ai < 2; ++ai)
#pragma unroll
            for (int m = 0; m < 4; ++m) { const unsigned row = (unsigned)(u.pm * 256 + 128 * ai + 64 * wr + 16 * m + fr);
#pragma unroll
                for (int bj = 0; bj < 2; ++bj) { const unsigned o = row * 1024u + (unsigned)(u.pn * 256 + 64 * wc + 32 * bj + 8 * fq);
                    const u32x4 rb = *(const u32x4*)(resb + o); const f32x4 a0 = acc[ai][bj][m][0], a1 = acc[ai][bj][m][1];
                    f32x4 y0, y1; y0[0] = bflo(rb.x) + a0[0]; y0[1] = bfhi(rb.x) + a0[1]; y0[2] = bflo(rb.y) + a0[2]; y0[3] = bfhi(rb.y) + a0[3];
                    y1[0] = bflo(rb.z) + a1[0]; y1[1] = bfhi(rb.z) + a1[1]; y1[2] = bflo(rb.w) + a1[2]; y1[3] = bfhi(rb.w) + a1[3];
                    *(f32x4*)(out + o) = y0; *(f32x4*)(out + o + 4) = y1; }
                __builtin_amdgcn_sched_barrier(0); }
    }
};
struct EpiSwiglu {
    static constexpr bool PERM = false, AFTER_DRAIN = false;
    bf16_t* act; const float* ssq;
    __device__ __forceinline__ void operator()(const f32x4 (&acc)[2][2][4][2], const pg8::Unit& u, int wr, int wc, int fr_, int fq_) const {
        int fr = fr_, fq = fq_; asm volatile("" : "+v"(fr), "+v"(fq));
#pragma unroll
        for (int ai = 0; ai < 2; ++ai)
#pragma unroll
            for (int m = 0; m < 4; ++m) { const unsigned row = (unsigned)(u.pm * 256 + 128 * ai + 64 * wr + 16 * m + fr);
                float v[8]; const float rs = __builtin_amdgcn_rsqf(ssq[row] * (1.0f / DM) + 1e-6f);
#pragma unroll
                for (int n = 0; n < 2; ++n)
#pragma unroll
                    for (int e = 0; e < 4; ++e) { const float g = acc[ai][0][m][n][e] * rs, up = acc[ai][1][m][n][e] * rs; v[4 * n + e] = g * sigmoidf_(g) * up; }
                u32x4 w; w.x = pk2(v[0], v[1]); w.y = pk2(v[2], v[3]); w.z = pk2(v[4], v[5]); w.w = pk2(v[6], v[7]);
                *(u32x4*)(act + (row * 2816u + (unsigned)(u.pn * 128 + 32 * wc + 8 * fq))) = w; }
    }
};
template <int MODE> struct EpiBranch {
    static constexpr bool PERM = false, AFTER_DRAIN = false;
    const bf16_t* brg; bf16_t* mix; int s;
    __device__ __forceinline__ void operator()(const f32x4 (&acc)[2][2][4][2], const pg8::Unit& u, int wr, int wc, int fr_, int fq_) const {
        int fr = fr_, fq = fq_; asm volatile("" : "+v"(fr), "+v"(fq));
#pragma unroll
        for (int ai = 0; ai < 2; ++ai)
#pragma unroll
            for (int m = 0; m < 4; ++m) { const unsigned row = (unsigned)(u.pm * 256 + 128 * ai + 64 * wr + 16 * m + fr);
#pragma unroll
                for (int bj = 0; bj < 2; ++bj)
#pragma unroll
                    for (int n = 0; n < 2; ++n) { const unsigned c = (unsigned)(u.pn * 256 + 64 * wc + 32 * bj + 8 * fq + 4 * n);
                        const u32x2 g = *(const u32x2*)(brg + (row * 3072u + 1024u * (unsigned)s + c));
                        u32x2 o = {0u, 0u}; if (MODE) o = *(const u32x2*)(mix + (row * 1024u + c));
                        const f32x4 a = acc[ai][bj][m][n];
                        u32x2 w;
                        w.x = pk2(bflo(o.x) + bflo(g.x) * a[0], bfhi(o.x) + bfhi(g.x) * a[1]);
                        w.y = pk2(bflo(o.y) + bflo(g.y) * a[2], bfhi(o.y) + bfhi(g.y) * a[3]);
                        *(u32x2*)(mix + (row * 1024u + c)) = w; }
                __builtin_amdgcn_sched_barrier(0); }
    }
};
struct EpiCmp1 {
    static constexpr bool PERM = false, AFTER_DRAIN = false;
    const float* bias; float* hid;
    __device__ __forceinline__ void operator()(const f32x4 (&acc)[2][2][4][2], const pg8::Unit& u, int wr, int wc, int fr_, int fq_) const {
        int fr = fr_, fq = fq_; asm volatile("" : "+v"(fr), "+v"(fq));
#pragma unroll
        for (int ai = 0; ai < 2; ++ai)
#pragma unroll
            for (int m = 0; m < 4; ++m) { const unsigned row = (unsigned)(u.pm * 256 + 128 * ai + 64 * wr + 16 * m + fr);
#pragma unroll
                for (int bj = 0; bj < 2; ++bj)
#pragma unroll
                    for (int n = 0; n < 2; ++n) { const int c = 64 * wc + 32 * bj + 8 * fq + 4 * n;
                        const f32x4 b = *(const f32x4*)(bias + c); f32x4 x = acc[ai][bj][m][n] + b, y;
#pragma unroll
                        for (int e = 0; e < 4; ++e) { const float t = x[e], z = 0.7978845608028654f * (t + 0.044715f * t * t * t);
                            const float th = 1.0f - 2.0f * __builtin_amdgcn_rcpf(1.0f + __expf(2.0f * z)); y[e] = 0.5f * t * (1.0f + th); }
                        *(f32x4*)(hid + (row * 256u + (unsigned)c)) = y; } }
    }
};
struct EpiStoreF32 {
    static constexpr bool PERM = false, AFTER_DRAIN = false;
    float* hid;
    __device__ __forceinline__ void operator()(const f32x4 (&acc)[2][2][4][2], const pg8::Unit& u, int wr, int wc, int fr_, int fq_) const {
        int fr = fr_, fq = fq_; asm volatile("" : "+v"(fr), "+v"(fq));
#pragma unroll
        for (int ai = 0; ai < 2; ++ai)
#pragma unroll
            for (int m = 0; m < 4; ++m) { const unsigned row = (unsigned)(u.pm * 256 + 128 * ai + 64 * wr + 16 * m + fr);
#pragma unroll
                for (int bj = 0; bj < 2; ++bj)
#pragma unroll
                    for (int n = 0; n < 2; ++n) *(f32x4*)(hid + (row * 256u + (unsigned)(64 * wc + 32 * bj + 8 * fq + 4 * n))) = acc[ai][bj][m][n]; }
    }
};
__device__ __forceinline__ unsigned gq8(float x) { return (unsigned)(sigmoidf_(x) * 255.0f + 0.5f); }
struct EpiInproj {
    static constexpr bool PERM = false, AFTER_DRAIN = false;
    unsigned char* wsb; const float* nwb; const float* rsq;
    __device__ __forceinline__ void operator()(const f32x4 (&acc)[2][2][4][2], const pg8::Unit& u, int wr, int wc, int fr_, int fq_) const {
        int fr = fr_, fq = fq_; asm volatile("" : "+v"(fr), "+v"(fq));
        const int t = u.pn; unsigned char* hb = wsb + WS_B; float* nsg = (float*)(wsb + WS_NSG); bf16_t* brg = (bf16_t*)(wsb + WS_A);
        const float* mqn = nwb; const float* mkn = nwb + 64; const float* nqn = nwb + 128; const float* nkn = nwb + 192;
        if (t <= 10) {
            const int hd = 4 * t + wc;
            const int grp = hd < 24 ? (hd >> 2) : (hd < 32 ? 6 : 7 + ((hd - 32) >> 1));
            const int hh = hd < 24 ? (hd & 3) : (hd < 32 ? hd - 24 : (hd & 1));
            const int H = grp < 6 ? 4 : (grp == 6 ? 8 : 2);
            bf16_t* base = (bf16_t*)(hb + (grp <= 6 ? (size_t)16 * grp : (size_t)(128 + 8 * (grp - 7))) * MiB);
            const bool trans = (grp == 2) | (grp == 5) | (grp == 10) | (grp == 12);
            const bool norm = (grp == 3) | (grp == 4) | (grp == 6) | (grp == 9) | (grp == 11);
            const float qs = ((grp == 0) | (grp == 3) | (grp == 6)) ? 0.125f * L2E : 1.0f;
            const float* nw = grp == 3 ? mqn : (grp == 4 ? mkn : (grp == 6 ? nqn : (grp == 9 ? nkn + 64 : nkn + 128)));
#pragma unroll
            for (int ai = 0; ai < 2; ++ai)
#pragma unroll
                for (int m = 0; m < 4; ++m) { const int row = u.pm * 256 + 128 * ai + 64 * wr + 16 * m + fr; const int b = row >> 13, s = row & 8191;
                    const float rin = rsq ? __builtin_amdgcn_rsqf(rsq[row] * (1.0f / DM) + 1e-6f) : 1.0f;
                    float v[2][8];
#pragma unroll
                    for (int bj = 0; bj < 2; ++bj)
#pragma unroll
                        for (int n = 0; n < 2; ++n)
#pragma unroll
                            for (int e = 0; e < 4; ++e) v[bj][4 * n + e] = acc[ai][bj][m][n][e] * rin;
                    float sc = qs;
                    if (norm) { float ss = 0.f;
#pragma unroll
                        for (int bj = 0; bj < 2; ++bj)
#pragma unroll
                            for (int j = 0; j < 8; ++j) ss += v[bj][j] * v[bj][j];
                        ss += __shfl_xor(ss, 16); ss += __shfl_xor(ss, 32);
                        sc = qs * __builtin_amdgcn_rsqf(ss * (1.0f / 64.0f) + 1e-6f);
#pragma unroll
                        for (int bj = 0; bj < 2; ++bj) { const f32x4 w0 = *(const f32x4*)(nw + 32 * bj + 8 * fq), w1 = *(const f32x4*)(nw + 32 * bj + 8 * fq + 4);
#pragma unroll
                            for (int e = 0; e < 4; ++e) { v[bj][e] *= w0[e]; v[bj][4 + e] *= w1[e]; } } }
                    if (!trans) {
#pragma unroll
                        for (int bj = 0; bj < 2; ++bj) { u32x4 w; w.x = pk2(v[bj][0] * sc, v[bj][1] * sc); w.y = pk2(v[bj][2] * sc, v[bj][3] * sc); w.z = pk2(v[bj][4] * sc, v[bj][5] * sc); w.w = pk2(v[bj][6] * sc, v[bj][7] * sc);
                            *(u32x4*)(base + (unsigned)(((b * H + hh) * SEQ + s) * 64 + 32 * bj + 8 * fq)) = w; }
                    } else {
#pragma unroll
                        for (int bj = 0; bj < 2; ++bj)
#pragma unroll
                            for (int j = 0; j < 8; j += 2) { const unsigned w = pk2(v[bj][j], v[bj][j + 1]); bf16_t* d = base + (unsigned)(((b * H + hh) * 64 + 32 * bj + 8 * fq + j) * SEQ + s);
                                d[0] = (bf16_t)(w & 0xffffu); d[SEQ] = (bf16_t)(w >> 16); }
                    } }
        } else if (t == 11) {
            if (wc == 0 && fq < 3) {
#pragma unroll
                for (int ai = 0; ai < 2; ++ai)
#pragma unroll
                    for (int m = 0; m < 4; ++m) { const unsigned row = (unsigned)(u.pm * 256 + 128 * ai + 64 * wr + 16 * m + fr);
                        const float rin = rsq ? __builtin_amdgcn_rsqf(rsq[row] * (1.0f / DM) + 1e-6f) : 1.0f;
#pragma unroll
                        for (int n = 0; n < 2; ++n) { f32x4 y;
#pragma unroll
                            for (int e = 0; e < 4; ++e) y[e] = sigmoidf_(acc[ai][0][m][n][e] * rin);
                            *(f32x4*)(nsg + (row * 24u + (unsigned)(8 * fq + 4 * n))) = y; } }
            }
        } else {
#pragma unroll
            for (int ai = 0; ai < 2; ++ai)
#pragma unroll
                for (int m = 0; m < 4; ++m) { const unsigned row = (unsigned)(u.pm * 256 + 128 * ai + 64 * wr + 16 * m + fr);
                    const float rin = rsq ? __builtin_amdgcn_rsqf(rsq[row] * (1.0f / DM) + 1e-6f) : 1.0f;
#pragma unroll
                    for (int bj = 0; bj < 2; ++bj) { const f32x4 a0 = acc[ai][bj][m][0] * rin, a1 = acc[ai][bj][m][1] * rin; u32x2 w;
                        w.x = gq8(a0[0]) | (gq8(a0[1]) << 8) | (gq8(a0[2]) << 16) | (gq8(a0[3]) << 24);
                        w.y = gq8(a1[0]) | (gq8(a1[1]) << 8) | (gq8(a1[2]) << 16) | (gq8(a1[3]) << 24);
                        *(u32x2*)((unsigned char*)brg + (row * 3072u + (unsigned)((t - 12) * 256 + 64 * wc + 32 * bj + 8 * fq))) = w; } }
        }
    }
};

template <int MAP> __device__ __forceinline__ void prep_w(const float* __restrict__ W, int K, int ldw, bf16_t* __restrict__ Bt, int Np, int ldb, LAS unsigned char* lds, int tid, int bx, int G, const float* kscale = nullptr) {
    const int ntp = Np >> 6, ntiles = ntp * (K >> 6), w = tid >> 6, lane = tid & 63;
    float v[8];
    int tile = bx;
    if (tile < ntiles) { const int tk = tile / ntp, tp = tile - tk * ntp; const int col = mapcol<MAP>(tp * 64 + lane); const float* s = W + (size_t)(tk * 64 + 8 * w) * ldw + (col < 0 ? 0 : col);
#pragma unroll
        for (int i = 0; i < 8; ++i) v[i] = col >= 0 ? s[(size_t)i * ldw] * (kscale ? kscale[tk * 64 + 8 * w + i] : 1.0f) : 0.f; }
    for (; tile < ntiles; tile += G) {
        const int tk = tile / ntp, tp = tile - tk * ntp;
        u32x4 pw; pw.x = pk2(v[0], v[1]); pw.y = pk2(v[2], v[3]); pw.z = pk2(v[4], v[5]); pw.w = pk2(v[6], v[7]);
        *(LAS u32x4*)(lds + lane * 144 + w * 16) = pw;
        __syncthreads();
        const int nx = tile + G;
        if (nx < ntiles) { const int tk2 = nx / ntp, tp2 = nx - tk2 * ntp; const int col = mapcol<MAP>(tp2 * 64 + lane); const float* s = W + (size_t)(tk2 * 64 + 8 * w) * ldw + (col < 0 ? 0 : col);
#pragma unroll
            for (int i = 0; i < 8; ++i) v[i] = col >= 0 ? s[(size_t)i * ldw] * (kscale ? kscale[tk2 * 64 + 8 * w + i] : 1.0f) : 0.f; }
        { const int p = tid >> 3, pc = tid & 7; const u32x4 o = *(LAS const u32x4*)(lds + p * 144 + pc * 16);
            *(u32x4*)(Bt + (size_t)(tp * 64 + p) * ldb + tk * 64 + pc * 8) = o; }
        __syncthreads();
    }
}
__device__ __forceinline__ void rmsnorm_rows(const float* __restrict__ x, const float* __restrict__ g, bf16_t* __restrict__ h, int gwave, int nwaves, int lane) {
    for (int row = gwave; row < MTOK; row += nwaves) {
        const f32x4* xr = (const f32x4*)(x + (size_t)row * DM); f32x4 v[4]; float ss = 0.f;
#pragma unroll
        for (int i = 0; i < 4; ++i) { v[i] = xr[lane + 64 * i]; ss += v[i][0] * v[i][0] + v[i][1] * v[i][1] + v[i][2] * v[i][2] + v[i][3] * v[i][3]; }
        ss = wave_sum(ss); const float rs = __builtin_amdgcn_rsqf(ss * (1.0f / DM) + 1e-6f);
#pragma unroll
        for (int i = 0; i < 4; ++i) { const f32x4 gv = ((const f32x4*)g)[lane + 64 * i]; u32x2 w; w.x = pk2(v[i][0] * rs * gv[0], v[i][1] * rs * gv[1]); w.y = pk2(v[i][2] * rs * gv[2], v[i][3] * rs * gv[3]);
            *(u32x2*)(h + (size_t)row * DM + (lane + 64 * i) * 4) = w; }
    }
}

#define MFMA32(a, b, c) __builtin_amdgcn_mfma_f32_32x32x16_bf16((a), (b), (c), 0, 0, 0)
__device__ __forceinline__ void stage_ld(const bf16_t* K, const bf16_t* Vt, int ldvt, int key0, int tid, u32x4& rk, u32x4& rv) {
    const int row = tid >> 3, pc = tid & 7;
    rk = *(const u32x4*)(K + (size_t)(key0 + row) * 64 + pc * 8);
    rv = *(const u32x4*)(Vt + (size_t)row * ldvt + key0 + pc * 8);
}
__device__ __forceinline__ void stage_st(LAS unsigned char* lds, int buf, int tid, const u32x4& rk, const u32x4& rv) {
    const int row = tid >> 3, pc = tid & 7; LAS unsigned char* p = lds + buf * 18432 + row * 144 + pc * 16;
    *(LAS u32x4*)p = rk; *(LAS u32x4*)(p + 9216) = rv;
}
__device__ __forceinline__ void load_q(const bf16_t* qrow, int h, bf16x8 (&qf)[4]) {
#pragma unroll
    for (int kk = 0; kk < 4; ++kk) qf[kk] = *(const bf16x8*)(qrow + 16 * kk + 8 * h);
}
__device__ __forceinline__ f32x16 qk_sub(LAS const unsigned char* ks, int sub, const bf16x8 (&qf)[4], int r, int h, float init = 0.f) {
    const int pr = (r & 0x13) | ((r & 4) << 1) | ((r & 8) >> 1);
    LAS const unsigned char* p = ks + (32 * sub + pr) * 144 + h * 16;
    f32x16 st;
#pragma unroll
    for (int i = 0; i < 16; ++i) st[i] = init;
#pragma unroll
    for (int kk = 0; kk < 4; ++kk) { const bf16x8 kf = *(LAS const bf16x8*)(p + kk * 32); st = MFMA32(kf, qf[kk], st); }
    return st;
}
__device__ __forceinline__ void pv_sub(LAS const unsigned char* vs, int sub, const f32x16& p, f32x16 (&ot)[2], int r, int h) {
#pragma unroll
    for (int j = 0; j < 2; ++j) {
        u32x4 w; w.x = pk2(p[8 * j], p[8 * j + 1]); w.y = pk2(p[8 * j + 2], p[8 * j + 3]); w.z = pk2(p[8 * j + 4], p[8 * j + 5]); w.w = pk2(p[8 * j + 6], p[8 * j + 7]);
        const bf16x8 pf = __builtin_bit_cast(bf16x8, w);
#pragma unroll
        for (int mt = 0; mt < 2; ++mt) { const bf16x8 vf = *(LAS const bf16x8*)(vs + (32 * mt + r) * 144 + (32 * sub + 16 * j + 8 * h) * 2); ot[mt] = MFMA32(vf, pf, ot[mt]); }
    }
}
constexpr int BT_N = 288, BT_FAR = 64 + 223;
template <int MODE> __device__ __forceinline__ void soft_sub(f32x16& st, float& lsum, bool lane_valid, int dist0, int dmax, LAS const float* bt) {
    if (MODE == 0) {
#pragma unroll
        for (int i = 0; i < 16; ++i) { const float p = ex2(st[i]); lsum += p; st[i] = p; }
    } else if (MODE == 2) {
        const float cf = lane_valid ? bt[BT_FAR] : -3.0e38f;
#pragma unroll
        for (int i = 0; i < 16; ++i) { const int dist = dist0 - (16 * (i >> 3) + (i & 7)); const float b = dist < dmax ? cf : -3.0e38f;
            const float p = ex2(st[i] + b); lsum += p; st[i] = p; }
    } else if (MODE == 1) {
        float bb[16];
#pragma unroll
        for (int j = 0; j < 2; ++j) { int db = dist0 - 16 * j; db = db < -57 ? -57 : (db > 223 ? 223 : db); if (!lane_valid) db = -57;
            LAS const float* p = bt + (db + 64);
#pragma unroll
            for (int k = 0; k < 8; ++k) bb[8 * j + k] = p[-k]; }
#pragma unroll
        for (int i = 0; i < 16; ++i) { const float p = ex2(st[i] + bb[i]); lsum += p; st[i] = p; }
    } else {
        float bb[16];
#pragma unroll
        for (int i = 0; i < 16; ++i) { int d = dist0 - 16 * (16 * (i >> 3) + (i & 7)); d = d < -64 ? -64 : (d > 223 ? 223 : d); bb[i] = bt[d + 64]; }
#pragma unroll
        for (int i = 0; i < 16; ++i) { const float p = ex2(st[i] + bb[i]); lsum += p; st[i] = p; }
    }
}
__device__ __forceinline__ bf16x8 pack_p(const f32x16& p, int j) {
    u32x4 w; w.x = pk2(p[8 * j], p[8 * j + 1]); w.y = pk2(p[8 * j + 2], p[8 * j + 3]); w.z = pk2(p[8 * j + 4], p[8 * j + 5]); w.w = pk2(p[8 * j + 6], p[8 * j + 7]);
    return __builtin_bit_cast(bf16x8, w);
}
template <int MODE> __device__ __forceinline__ void tile_soft_gen(LAS const unsigned char* ks, LAS const unsigned char* vs, const bf16x8 (&qf)[4], f32x16 (&ot)[2], float& lsum,
                                                              bool lane_valid, int dist00, int dmax, LAS const float* bt, int r, int h) {
    const float init = MODE == 0 ? (lane_valid ? bt[BT_FAR] : -3.0e38f) : 0.f;
    const int pr = (r & 0x13) | ((r & 4) << 1) | ((r & 8) >> 1);
    LAS const unsigned char* kp = ks + pr * 144 + h * 16; LAS const unsigned char* vp = vs + r * 144 + h * 16;
    bf16x8 k0[4], k1[4], v0[2][2], v1[2][2];
#pragma unroll
    for (int kk = 0; kk < 4; ++kk) { k0[kk] = *(LAS const bf16x8*)(kp + kk * 32); k1[kk] = *(LAS const bf16x8*)(kp + 32 * 144 + kk * 32); }
    __builtin_amdgcn_sched_barrier(0);
    f32x16 s0, s1;
#pragma unroll
    for (int i = 0; i < 16; ++i) { s0[i] = init; s1[i] = init; }
#pragma unroll
    for (int kk = 0; kk < 4; ++kk) s0 = MFMA32(k0[kk], qf[kk], s0);
#pragma unroll
    for (int mt = 0; mt < 2; ++mt)
#pragma unroll
        for (int j = 0; j < 2; ++j) v0[mt][j] = *(LAS const bf16x8*)(vp + 32 * mt * 144 + 32 * j);
    __builtin_amdgcn_sched_barrier(0);
#pragma unroll
    for (int kk = 0; kk < 4; ++kk) s1 = MFMA32(k1[kk], qf[kk], s1);
#pragma unroll
    for (int mt = 0; mt < 2; ++mt)
#pragma unroll
        for (int j = 0; j < 2; ++j) v1[mt][j] = *(LAS const bf16x8*)(vp + 32 * mt * 144 + 64 + 32 * j);
    soft_sub<MODE>(s0, lsum, lane_valid, dist00, dmax, bt);
    __builtin_amdgcn_sched_barrier(0);
#pragma unroll
    for (int j = 0; j < 2; ++j) { const bf16x8 pf = pack_p(s0, j); ot[0] = MFMA32(v0[0][j], pf, ot[0]); ot[1] = MFMA32(v0[1][j], pf, ot[1]); }
    soft_sub<MODE>(s1, lsum, lane_valid, dist00 - (MODE == 3 ? 512 : 32), dmax, bt);
    __builtin_amdgcn_sched_barrier(0);
#pragma unroll
    for (int j = 0; j < 2; ++j) { const bf16x8 pf = pack_p(s1, j); ot[0] = MFMA32(v1[0][j], pf, ot[0]); ot[1] = MFMA32(v1[1][j], pf, ot[1]); }
}
#define SOFT4(st_, i0_) { _Pragma("unroll") for (int i_ = (i0_); i_ < (i0_) + 4; ++i_) { const float p_ = ex2(st_[i_]); lsum += p_; st_[i_] = p_; } }
__device__ __forceinline__ void tile_soft_far(LAS const unsigned char* ks, LAS const unsigned char* vs, const bf16x8 (&qf)[4], f32x16 (&ot)[2], float& lsum, bool lane_valid, LAS const float* bt, int r, int h) {
    const float init = lane_valid ? bt[BT_FAR] : -3.0e38f;
    const int pr = (r & 0x13) | ((r & 4) << 1) | ((r & 8) >> 1);
    LAS const unsigned char* kp = ks + pr * 144 + h * 16; LAS const unsigned char* vp = vs + r * 144 + h * 16;
    bf16x8 k0[4], k1[4], v0[2][2], v1[2][2];
#pragma unroll
    for (int kk = 0; kk < 4; ++kk) { k0[kk] = *(LAS const bf16x8*)(kp + kk * 32); k1[kk] = *(LAS const bf16x8*)(kp + 32 * 144 + kk * 32); }
    __builtin_amdgcn_sched_barrier(0);
    f32x16 s0, s1;
#pragma unroll
    for (int i = 0; i < 16; ++i) { s0[i] = init; s1[i] = init; }
#pragma unroll
    for (int kk = 0; kk < 4; ++kk) s0 = MFMA32(k0[kk], qf[kk], s0);
#pragma unroll
    for (int mt = 0; mt < 2; ++mt)
#pragma unroll
        for (int j = 0; j < 2; ++j) { v0[mt][j] = *(LAS const bf16x8*)(vp + 32 * mt * 144 + 32 * j); v1[mt][j] = *(LAS const bf16x8*)(vp + 32 * mt * 144 + 64 + 32 * j); }
    __builtin_amdgcn_sched_barrier(0);
    s1 = MFMA32(k1[0], qf[0], s1); SOFT4(s0, 0);  __builtin_amdgcn_sched_barrier(0);
    s1 = MFMA32(k1[1], qf[1], s1); SOFT4(s0, 4);  __builtin_amdgcn_sched_barrier(0);
    s1 = MFMA32(k1[2], qf[2], s1); SOFT4(s0, 8);  __builtin_amdgcn_sched_barrier(0);
    s1 = MFMA32(k1[3], qf[3], s1); SOFT4(s0, 12); __builtin_amdgcn_sched_barrier(0);
    const bf16x8 pa = pack_p(s0, 0);
    ot[0] = MFMA32(v0[0][0], pa, ot[0]); SOFT4(s1, 0);  __builtin_amdgcn_sched_barrier(0);
    ot[1] = MFMA32(v0[1][0], pa, ot[1]); SOFT4(s1, 4);  const bf16x8 pb = pack_p(s0, 1); __builtin_amdgcn_sched_barrier(0);
    ot[0] = MFMA32(v0[0][1], pb, ot[0]); SOFT4(s1, 8);  __builtin_amdgcn_sched_barrier(0);
    ot[1] = MFMA32(v0[1][1], pb, ot[1]); SOFT4(s1, 12); __builtin_amdgcn_sched_barrier(0);
#pragma unroll
    for (int j = 0; j < 2; ++j) { const bf16x8 pf = pack_p(s1, j); ot[0] = MFMA32(v1[0][j], pf, ot[0]); ot[1] = MFMA32(v1[1][j], pf, ot[1]); }
}
template <int MODE> __device__ __forceinline__ void tile_soft(LAS const unsigned char* ks, LAS const unsigned char* vs, const bf16x8 (&qf)[4], f32x16 (&ot)[2], float& lsum,
                                                              bool lane_valid, int dist00, int dmax, LAS const float* bt, int r, int h) {
    if (MODE == 0) tile_soft_far(ks, vs, qf, ot, lsum, lane_valid, bt, r, h);
    else tile_soft_gen<MODE>(ks, vs, qf, ot, lsum, lane_valid, dist00, dmax, bt, r, h);
}
__device__ __forceinline__ void zero_ot(f32x16 (&ot)[2]) {
#pragma unroll
    for (int i = 0; i < 16; ++i) { ot[0][i] = 0.f; ot[1][i] = 0.f; }
}
__device__ __forceinline__ void store_ot(bf16_t* orow, const f32x16 (&ot)[2], int h) {
#pragma unroll
    for (int mt = 0; mt < 2; ++mt)
#pragma unroll
        for (int g = 0; g < 4; ++g) { u32x2 w; w.x = pk2(ot[mt][4 * g], ot[mt][4 * g + 1]); w.y = pk2(ot[mt][4 * g + 2], ot[mt][4 * g + 3]);
            *(u32x2*)(orow + 32 * mt + 8 * g + 4 * h) = w; }
}

#define TILE_LOOP(KP, VP, LDV, KEY_FIRST, NT, BODY) do { \
    int key0 = (KEY_FIRST); const int nt_ = (NT); u32x4 rkA_, rvA_, rkB_, rvB_; \
    __syncthreads(); \
    stage_ld((KP), (VP), (LDV), key0, tid, rkA_, rvA_); stage_st(lds, 0, tid, rkA_, rvA_); \
    if (nt_ > 1) stage_ld((KP), (VP), (LDV), key0 + 64, tid, rkA_, rvA_); \
    __syncthreads(); \
    for (int it_ = 0; it_ < nt_; ++it_) { const int buf_ = it_ & 1; \
        if (it_ + 2 < nt_) stage_ld((KP), (VP), (LDV), key0 + 128, tid, rkB_, rvB_); \
        { LAS const unsigned char* ks = lds + buf_ * 18432; LAS const unsigned char* vs = ks + 9216; BODY } \
        if (it_ + 1 < nt_) stage_st(lds, buf_ ^ 1, tid, rkA_, rvA_); \
        __syncthreads(); key0 += 64; rkA_ = rkB_; rvA_ = rvB_; } } while (0)

__device__ __forceinline__ void sb_sub(LAS const unsigned char* vs, int sb, f32x16& st, f32x16 (&ot)[2], float& C, int key0, int t, int r, int h) {
    float ls[16]; float Rlo = 0.f, Rhi = 0.f;
#pragma unroll
    for (int i = 0; i < 16; ++i) { const int s = key0 + 32 * sb + 16 * (i >> 3) + 8 * h + (i & 7); const bool causal = s < t;
        const float u = st[i]; const float sp = fmaxf(u, 0.f) + lg2(1.0f + ex2(-fabsf(u)));
        ls[i] = causal ? -sp : 0.f; st[i] = causal ? (u - sp) : -3.0e38f;
        if (i < 8) Rlo += ls[i]; else Rhi += ls[i]; }
    const float Plo = __shfl_xor(Rlo, 32), Phi = __shfl_xor(Rhi, 32);
    float la = C + (h == 0 ? Phi : 0.f);
#pragma unroll
    for (int i = 15; i >= 8; --i) { const float a = ex2(st[i] + la); la += ls[i]; st[i] = a; }
    la = C + Rhi + Phi + (h == 0 ? Plo : 0.f);
#pragma unroll
    for (int i = 7; i >= 0; --i) { const float a = ex2(st[i] + la); la += ls[i]; st[i] = a; }
    C += (Rlo + Rhi) + (Plo + Phi);
    pv_sub(vs, sb, st, ot, r, h);
}
__device__ __forceinline__ void sb_unit(LAS unsigned char* lds, const unsigned char* hb, bf16_t* omix, int b, int hd, int qblk, int tid) {
    const int lane = tid & 63, w = tid >> 6, r = lane & 31, h = lane >> 5;
    const int bh = b * 4 + hd, q0 = qblk * 256, t = q0 + 32 * w + r;
    const bf16_t* Q = (const bf16_t*)(hb + HB_SBQ * MiB) + ((size_t)bh * SEQ + t) * 64;
    const bf16_t* K = (const bf16_t*)(hb + HB_SBK * MiB) + (size_t)bh * SEQ * 64;
    const bf16_t* Vt = (const bf16_t*)(hb + HB_SBVT * MiB) + (size_t)bh * 64 * SEQ;
    bf16x8 qf[4]; load_q(Q, h, qf);
    f32x16 ot[2]; zero_ot(ot);
    float C = 0.f;
    int key0 = q0 + 192; u32x4 rkA_, rvA_, rkB_, rvB_;
    __syncthreads();
    stage_ld(K, Vt, SEQ, key0, tid, rkA_, rvA_); stage_st(lds, 0, tid, rkA_, rvA_);
    if (key0 >= 64) stage_ld(K, Vt, SEQ, key0 - 64, tid, rkA_, rvA_);
    __syncthreads();
    int buf = 0;
    for (;;) {
        const bool has_next = key0 >= 64;
        if (key0 >= 128) stage_ld(K, Vt, SEQ, key0 - 128, tid, rkB_, rvB_);
        if (key0 <= q0 + 32 * w + 31) {
            LAS const unsigned char* ks = lds + buf * 18432; LAS const unsigned char* vs = ks + 9216;
            f32x16 s1 = qk_sub(ks, 1, qf, r, h); f32x16 s0 = qk_sub(ks, 0, qf, r, h);
            if (key0 + 32 <= q0 + 32 * w + 31) sb_sub(vs, 1, s1, ot, C, key0, t, r, h);
            sb_sub(vs, 0, s0, ot, C, key0, t, r, h);
        }
        const int alive = __syncthreads_or(C > -150.0f ? 1 : 0);
        if (!(has_next && alive)) break;
        stage_st(lds, buf ^ 1, tid, rkA_, rvA_);
        __syncthreads(); buf ^= 1; key0 -= 64; rkA_ = rkB_; rvA_ = rvB_;
    }
    store_ot(omix + ((size_t)b * SEQ + t) * DM + hd * 64, ot, h);
}

__device__ __forceinline__ void moba_unit(LAS unsigned char* lds, const unsigned char* hb, const float* kmean, bf16_t* omix, int b, int hd, int blk, int tid) {
    const int lane = tid & 63, w = tid >> 6, r = lane & 31, h = lane >> 5;
    const int bh = b * 4 + hd, q0 = blk * 256, t = q0 + 32 * w + r;
    const bf16_t* Qb = (const bf16_t*)(hb + HB_MBQ * MiB) + ((size_t)bh * SEQ + q0) * 64;
    const bf16_t* K = (const bf16_t*)(hb + HB_MBK * MiB) + (size_t)bh * SEQ * 64;
    const bf16_t* Vt = (const bf16_t*)(hb + HB_MBVT * MiB) + (size_t)bh * 64 * SEQ;
    LAS unsigned* misc = (LAS unsigned*)(lds + ATT_MISC); LAS unsigned* selm = (LAS unsigned*)(lds + ATT_SEL);
    LAS float* km = (LAS float*)(lds + ATT_X); LAS float* sc = km + 32 * 64;
    LAS const float* bt = (LAS const float*)(lds + ATT_BT) + hd * BT_N;
    __syncthreads();
    if (tid == 0) misc[1] = 0u;
    if (blk > 3) {
        for (int i = tid; i < blk * 64; i += 512) km[i] = kmean[(size_t)bh * 32 * 64 + i];
        __syncthreads();
        { const int qi = tid & 255, part = tid >> 8; float q[64];
            const u32x4* qp = (const u32x4*)(Qb + (size_t)qi * 64);
#pragma unroll
            for (int c = 0; c < 8; ++c) { const u32x4 v = qp[c]; q[8 * c] = bflo(v.x); q[8 * c + 1] = bfhi(v.x); q[8 * c + 2] = bflo(v.y); q[8 * c + 3] = bfhi(v.y); q[8 * c + 4] = bflo(v.z); q[8 * c + 5] = bfhi(v.z); q[8 * c + 6] = bflo(v.w); q[8 * c + 7] = bfhi(v.w); }
            for (int n = part; n < blk; n += 2) { float a = 0.f;
#pragma unroll
                for (int d = 0; d < 64; ++d) a = fmaf(q[d], km[n * 64 + d], a);
                sc[qi * 33 + n] = a; } }
        __syncthreads();
        if (tid < 256) { unsigned m = 0u; float sv[32];
#pragma unroll
            for (int n = 0; n < 32; ++n) sv[n] = n < blk ? sc[tid * 33 + n] : -3.0e38f;
#pragma unroll
            for (int k = 0; k < 3; ++k) { float best = -3.0e38f; int bi = 0;
#pragma unroll
                for (int n = 0; n < 32; ++n) { const bool take = !((m >> n) & 1u) && sv[n] > best; best = take ? sv[n] : best; bi = take ? n : bi; }
                m |= 1u << bi; }
            selm[tid] = m; atomicOr((unsigned*)&misc[1], m); }
    } else {
        const unsigned m = (1u << blk) - 1u; if (tid < 256) selm[tid] = m; if (tid == 0) misc[1] = m;
    }
    __syncthreads();
    const unsigned uni = misc[1], sel = selm[32 * w + r];
    bf16x8 qf[4]; load_q(Qb + (size_t)(32 * w + r) * 64, h, qf);
    f32x16 ot[2]; zero_ot(ot); float lsum = 0.f;
    const int kend = q0 + 256;
#define MOBA_NEXT(k_, out_) do { int kk_ = (k_) + 64; while (kk_ < q0 && !((uni >> (kk_ >> 8)) & 1u)) kk_ = (kk_ | 255) + 1; (out_) = kk_; } while (0)
    int key0, knext, knext2; MOBA_NEXT(-64, key0); MOBA_NEXT(key0, knext);
    u32x4 rkA_, rvA_, rkB_, rvB_;
    stage_ld(K, Vt, SEQ, key0, tid, rkA_, rvA_); stage_st(lds, 0, tid, rkA_, rvA_);
    if (knext < kend) stage_ld(K, Vt, SEQ, knext, tid, rkA_, rvA_);
    __syncthreads();
    int buf = 0;
    while (key0 < kend) {
        MOBA_NEXT(knext, knext2);
        if (knext < kend && knext2 < kend) stage_ld(K, Vt, SEQ, knext2, tid, rkB_, rvB_);
        {
            LAS const unsigned char* ks = lds + buf * 18432; LAS const unsigned char* vs = ks + 9216;
            const int n = key0 >> 8; const bool own = (n == blk);
            const bool lane_valid = own ? true : (((sel >> n) & 1u) != 0u);
            const bool skip = own ? (key0 > q0 + 32 * w + 31) : (__ballot(lane_valid) == 0ull);
            if (!skip) {
                const bool near = (q0 + 32 * w) - (key0 + 63) < 128;
                const int dist00 = t - (key0 + 8 * h);
                if (near) tile_soft<1>(ks, vs, qf, ot, lsum, lane_valid, dist00, 0, bt, r, h);
                else tile_soft<0>(ks, vs, qf, ot, lsum, lane_valid, dist00, 0, bt, r, h);
            }
        }
        if (knext < kend) stage_st(lds, buf ^ 1, tid, rkA_, rvA_);
        __syncthreads(); buf ^= 1; key0 = knext; knext = knext2; rkA_ = rkB_; rvA_ = rvB_;
    }
#undef MOBA_NEXT
    const float l = lsum + __shfl_xor(lsum, 32); const float inv = 1.0f / fmaxf(l, 1e-30f);
#pragma unroll
    for (int i = 0; i < 16; ++i) { ot[0][i] *= inv; ot[1][i] *= inv; }
    store_ot(omix + ((size_t)b * SEQ + t) * DM + 256 + hd * 64, ot, h);
}

__device__ __forceinline__ void imp_sub(f32x16& st, float invc, int nbase, LAS float* improw, int r) {
#pragma unroll
    for (int j = 0; j < 2; ++j) { const int a = (nbase + 16 * j) >> 3;
        float s0 = ((st[8 * j] + st[8 * j + 1]) + (st[8 * j + 2] + st[8 * j + 3])) * invc;
        float s1 = ((st[8 * j + 3] + st[8 * j + 4]) + (st[8 * j + 5] + st[8 * j + 6]) + st[8 * j + 7]) * invc;
        float s2 = st[8 * j + 7] * invc;
        s0 += __shfl_xor(s0, 8); s0 += __shfl_xor(s0, 16); s1 += __shfl_xor(s1, 8); s1 += __shfl_xor(s1, 16); s2 += __shfl_xor(s2, 8); s2 += __shfl_xor(s2, 16);
        if (r < 8) { LAS float* ip = improw + 2 * a; ip[0] += s0; ip[1] += s1; if (2 * a + 2 < 128) ip[2] += s2; } }
}
__device__ __forceinline__ void nsa_unit(LAS unsigned char* lds, const unsigned char* hb, const bf16_t* kc, const bf16_t* vct, const float* nsg, bf16_t* omix, int b, int g, int c, int tid) {
    const int lane = tid & 63, w = tid >> 6, r = lane & 31, h = lane >> 5;
    const int bg = b * 2 + g, q0 = c * 64, ql = 8 * w + (r & 7), t = q0 + ql, hq = 4 * g + (r >> 3);
    const bf16_t* Q = (const bf16_t*)(hb + HB_NSQ * MiB) + ((size_t)(b * 8 + hq) * SEQ + t) * 64;
    LAS unsigned* selm = (LAS unsigned*)(lds + ATT_SEL); LAS float* imp = (LAS float*)(lds + ATT_X);
    LAS const float* bt = (LAS const float*)(lds + ATT_BT) + (4 + hq) * BT_N;
    const float* gate = nsg + ((size_t)b * SEQ + t) * 24 + hq;
    bf16x8 qf[4]; load_q(Q, h, qf);
    f32x16 ot[2]; zero_ot(ot);
    LAS unsigned* oal = (LAS unsigned*)(lds + ATT_OA) + (w * 16) * 64 + lane;
    const bf16_t* Kc = kc + (size_t)bg * 512 * 64; const bf16_t* Vc = vct + (size_t)bg * 64 * 512;
    const int ntc = (4 * c + 3 + 63) >> 6;
    float lsum = 0.f;
    TILE_LOOP(Kc, Vc, 512, 0, ntc, {
        tile_soft<3>(ks, vs, qf, ot, lsum, true, t - 31 - 16 * (key0 + 8 * h), 0, bt, r, h); });
    const float lc = lsum + __shfl_xor(lsum, 32); const float invc = 1.0f / fmaxf(lc, 1e-30f);
    { const float gc = gate[0] * invc;
#pragma unroll
        for (int i = 0; i < 8; ++i) { oal[i * 64] = pk2(ot[0][2 * i] * gc, ot[0][2 * i + 1] * gc); oal[(8 + i) * 64] = pk2(ot[1][2 * i] * gc, ot[1][2 * i + 1] * gc); } }
    for (int i = tid; i < 64 * 129; i += 512) imp[i] = 0.f;
    if (tid < 256) selm[tid] = 0u;
    TILE_LOOP(Kc, Vc, 512, 0, ntc, {
        f32x16 s0 = qk_sub(ks, 0, qf, r, h); f32x16 s1 = qk_sub(ks, 1, qf, r, h); float dummy = 0.f;
        const int dist00 = t - 31 - 16 * (key0 + 8 * h);
        soft_sub<3>(s0, dummy, true, dist00, 0, bt); imp_sub(s0, invc, key0 + 8 * h, imp + ql * 129, r);
        soft_sub<3>(s1, dummy, true, dist00 - 512, 0, bt); imp_sub(s1, invc, key0 + 32 + 8 * h, imp + ql * 129, r); });
    { const int qi = tid >> 3, sub = tid & 7;
        if (c >= 16) {
            { LAS const float* row = imp + qi * 129; unsigned long long kv[16]; int cnt[16];
#pragma unroll
                for (int k = 0; k < 16; ++k) { const int m = 1 + sub + 8 * k; const int mi = m <= 128 ? m : 128; kv[k] = ((unsigned long long)__float_as_uint(row[mi]) << 8) | (unsigned long long)(255 - m); cnt[k] = 0; }
                for (int m2 = 1; m2 <= c - 2; m2 += 8) { unsigned long long kx[8];
#pragma unroll
                    for (int j = 0; j < 8; ++j) { const int mm = m2 + j; const int mi = mm <= 128 ? mm : 128; const float x = row[mi]; kx[j] = mm <= c - 2 ? (((unsigned long long)__float_as_uint(x) << 8) | (unsigned long long)(255 - mm)) : 0ull; }
#pragma unroll
                    for (int j = 0; j < 8; ++j)
#pragma unroll
                        for (int k = 0; k < 16; ++k) cnt[k] += kx[j] > kv[k] ? 1 : 0; }
#pragma unroll
                for (int k = 0; k < 16; ++k) { const int m = 1 + sub + 8 * k; if (m <= c - 2 && cnt[k] < 13) atomicOr((unsigned*)&selm[qi * 4 + (m >> 5)], 1u << (m & 31)); } }
            if (sub == 0) { atomicOr((unsigned*)&selm[qi * 4], 1u); atomicOr((unsigned*)&selm[qi * 4 + ((c - 1) >> 5)], 1u << ((c - 1) & 31)); atomicOr((unsigned*)&selm[qi * 4 + (c >> 5)], 1u << (c & 31)); }
        } else if (sub == 0) selm[qi * 4] = (1u << (c + 1)) - 1u;
    }
    __syncthreads();
    const unsigned sel0 = selm[ql * 4], sel1 = selm[ql * 4 + 1], sel2 = selm[ql * 4 + 2], sel3 = selm[ql * 4 + 3];
    { const bf16_t* Ks = (const bf16_t*)(hb + HB_KS * MiB) + (size_t)bg * SEQ * 64; const bf16_t* Vs = (const bf16_t*)(hb + HB_VST * MiB) + (size_t)bg * 64 * SEQ;
        zero_ot(ot); lsum = 0.f;
        TILE_LOOP(Ks, Vs, SEQ, 0, c + 1, {
            const int m = key0 >> 6; const unsigned sw = m < 32 ? sel0 : (m < 64 ? sel1 : (m < 96 ? sel2 : sel3));
            const bool lane_valid = ((sw >> (m & 31)) & 1u) != 0u;
            if (__ballot(lane_valid) != 0ull) { const int dist00 = t - (key0 + 8 * h);
                if ((c - m) < 3) tile_soft<1>(ks, vs, qf, ot, lsum, lane_valid, dist00, 0, bt, r, h);
                else tile_soft<0>(ks, vs, qf, ot, lsum, lane_valid, dist00, 0, bt, r, h); } });
        const float l = lsum + __shfl_xor(lsum, 32); const float gs = gate[8] / fmaxf(l, 1e-30f);
#pragma unroll
        for (int i = 0; i < 8; ++i) { const unsigned a0 = oal[i * 64], a1 = oal[(8 + i) * 64];
            oal[i * 64] = pk2(bflo(a0) + ot[0][2 * i] * gs, bfhi(a0) + ot[0][2 * i + 1] * gs); oal[(8 + i) * 64] = pk2(bflo(a1) + ot[1][2 * i] * gs, bfhi(a1) + ot[1][2 * i + 1] * gs); } }
    { const bf16_t* Kw = (const bf16_t*)(hb + HB_KW * MiB) + (size_t)bg * SEQ * 64; const bf16_t* Vw = (const bf16_t*)(hb + HB_VWT * MiB) + (size_t)bg * 64 * SEQ;
        zero_ot(ot); lsum = 0.f;
        const int kfirst = q0 >= 512 ? q0 - 512 : 0; const int ntw = ((q0 - kfirst) >> 6) + 1;
        TILE_LOOP(Kw, Vw, SEQ, kfirst, ntw, {
            const int dist00 = t - (key0 + 8 * h);
            if (key0 >= q0 - 128) tile_soft<1>(ks, vs, qf, ot, lsum, true, dist00, 0, bt, r, h);
            else if (key0 == q0 - 512) tile_soft<2>(ks, vs, qf, ot, lsum, true, dist00, 512, bt, r, h);
            else tile_soft<0>(ks, vs, qf, ot, lsum, true, dist00, 0, bt, r, h); });
        const float l = lsum + __shfl_xor(lsum, 32); const float gw = gate[16] / fmaxf(l, 1e-30f);
#pragma unroll
        for (int i = 0; i < 8; ++i) { const unsigned a0 = oal[i * 64], a1 = oal[(8 + i) * 64];
            ot[0][2 * i] = bflo(a0) + ot[0][2 * i] * gw; ot[0][2 * i + 1] = bfhi(a0) + ot[0][2 * i + 1] * gw; ot[1][2 * i] = bflo(a1) + ot[1][2 * i] * gw; ot[1][2 * i + 1] = bfhi(a1) + ot[1][2 * i + 1] * gw; } }
    store_ot(omix + ((size_t)b * SEQ + t) * DM + 512 + hq * 64, ot, h);
}

constexpr int FG_STAGE = 55296, FG_B = 36864, FG_PATCH = 110592;
__device__ __forceinline__ void fg_ld(const bf16_t* A, const bf16_t* Bt, int kt, int tid, u32x4 (&ra)[4], u32x4 (&rb)[2]) {
#pragma unroll
    for (int i = 0; i < 4; ++i) { const unsigned p = (unsigned)(tid + 512 * i); ra[i] = *(const u32x4*)(A + 64 * kt + ((p >> 3) * 1024u + 8u * (p & 7u))); }
#pragma unroll
    for (int i = 0; i < 2; ++i) { const unsigned p = (unsigned)(tid + 512 * i); rb[i] = *(const u32x4*)(Bt + 64 * kt + ((p >> 3) * 1024u + 8u * (p & 7u))); }
}
__device__ __forceinline__ void fg_st(LAS unsigned char* st, int tid, const u32x4 (&ra)[4], const u32x4 (&rb)[2]) {
#pragma unroll
    for (int i = 0; i < 4; ++i) { const int p = tid + 512 * i; *(LAS u32x4*)(st + (p >> 3) * 144 + (p & 7) * 16) = ra[i]; }
#pragma unroll
    for (int i = 0; i < 2; ++i) { const int p = tid + 512 * i; *(LAS u32x4*)(st + FG_B + (p >> 3) * 144 + (p & 7) * 16) = rb[i]; }
}
__device__ __forceinline__ void branch_tile(LAS unsigned char* lds, const bf16_t* omix, const bf16_t* wbr, const bf16_t* brg, bf16_t* mix, int pm, int pn, int tid) {
    const int lane = tid & 63, w = tid >> 6, r = lane & 31, h = lane >> 5, wr = w >> 1, wc = w & 1;
    const bf16_t* A = omix + (size_t)pm * 256 * DM; const bf16_t* Bt = wbr + (size_t)pn * 128 * DM;
    LAS unsigned char* patch = lds + FG_PATCH + w * 2560;
    f32x16 seg[2][2]; unsigned tot[2][2][8];
#pragma unroll
    for (int a = 0; a < 2; ++a)
#pragma unroll
        for (int c = 0; c < 2; ++c)
#pragma unroll
            for (int i = 0; i < 16; ++i) { seg[a][c][i] = 0.f; tot[a][c][i >> 1] = 0u; }
    u32x4 ra0[4], rb0[2], ra1[4], rb1[2];
    __syncthreads();
    fg_ld(A, Bt, 0, tid, ra0, rb0); fg_st(lds, tid, ra0, rb0);
    fg_ld(A, Bt, 1, tid, ra1, rb1);
    __syncthreads();
#define FG_COMPUTE(BUF) { LAS const unsigned char* sa = lds + (BUF) * FG_STAGE + (64 * wr + r) * 144 + h * 16; LAS const unsigned char* sb = lds + (BUF) * FG_STAGE + FG_B + (64 * wc + r) * 144 + h * 16; \
        _Pragma("unroll") for (int kk = 0; kk < 4; ++kk) { const bf16x8 a0 = *(LAS const bf16x8*)(sa + kk * 32), a1 = *(LAS const bf16x8*)(sa + 32 * 144 + kk * 32); \
            const bf16x8 b0 = *(LAS const bf16x8*)(sb + kk * 32), b1 = *(LAS const bf16x8*)(sb + 32 * 144 + kk * 32); \
            seg[0][0] = MFMA32(a0, b0, seg[0][0]); seg[0][1] = MFMA32(a0, b1, seg[0][1]); seg[1][0] = MFMA32(a1, b0, seg[1][0]); seg[1][1] = MFMA32(a1, b1, seg[1][1]); } }
#define FG_BAR() do { asm volatile("s_waitcnt lgkmcnt(0)" ::: "memory"); __builtin_amdgcn_s_barrier(); asm volatile("" ::: "memory"); } while (0)
#pragma unroll 1
    for (int kt = 0; kt < 16; kt += 2) {
        fg_ld(A, Bt, (kt + 2 < 16 ? kt + 2 : 15), tid, ra0, rb0);
        FG_COMPUTE(0);
        fg_st(lds + FG_STAGE, tid, ra1, rb1);
        FG_BAR();
        fg_ld(A, Bt, (kt + 3 < 16 ? kt + 3 : 15), tid, ra1, rb1);
        const bool segend = (kt == 2) || (kt == 6) || (kt == 14);
        const int s = kt == 2 ? 0 : (kt == 6 ? 1 : 2);
        u32x4 g0, g1;
#define FG_GLD(dst, rt_, ct_) { dst = *(const u32x4*)((const unsigned char*)brg + ((unsigned)(pm * 256 + 64 * wr + 32 * (rt_) + (lane >> 1)) * 3072u + (unsigned)(1024 * s + pn * 128 + 64 * wc + 32 * (ct_) + 16 * (lane & 1)))); }
#define FG_GATE(src, rt_, ct_) { *(LAS u32x4*)(patch + (lane >> 1) * 48 + (lane & 1) * 16) = src; }
#define FG_ACC(rt_, ct_) { float gg[16]; \
            _Pragma("unroll") for (int i = 0; i < 16; ++i) { const int tr = 8 * (i >> 2) + 4 * h + (i & 3); gg[i] = (float)(*(LAS const unsigned char*)(patch + tr * 48 + r)) * (1.0f / 255.0f); } \
            _Pragma("unroll") for (int p2 = 0; p2 < 8; ++p2) { const unsigned tv = tot[rt_][ct_][p2]; \
                tot[rt_][ct_][p2] = pk2(fmaf(gg[2 * p2], seg[rt_][ct_][2 * p2], bflo(tv)), fmaf(gg[2 * p2 + 1], seg[rt_][ct_][2 * p2 + 1], bfhi(tv))); seg[rt_][ct_][2 * p2] = 0.f; seg[rt_][ct_][2 * p2 + 1] = 0.f; } }
        if (segend) { FG_GLD(g0, 0, 0); FG_GLD(g1, 0, 1); }
        FG_COMPUTE(1);
        if (segend) {
            FG_GATE(g0, 0, 0); FG_GLD(g0, 1, 0); FG_ACC(0, 0);
            FG_GATE(g1, 0, 1); FG_GLD(g1, 1, 1); FG_ACC(0, 1);
            FG_GATE(g0, 1, 0); FG_ACC(1, 0);
            FG_GATE(g1, 1, 1); FG_ACC(1, 1);
        }
#undef FG_GLD
#undef FG_GATE
#undef FG_ACC
        fg_st(lds, tid, ra0, rb0);
        FG_BAR();
    }
#undef FG_COMPUTE
#undef FG_BAR
#pragma unroll
    for (int rt = 0; rt < 2; ++rt)
#pragma unroll
        for (int ct = 0; ct < 2; ++ct) { const int tok0 = pm * 256 + 64 * wr + 32 * rt, n0 = pn * 128 + 64 * wc + 32 * ct;
#pragma unroll
            for (int p2 = 0; p2 < 8; ++p2) { const int tr = 8 * (p2 >> 1) + 4 * h + 2 * (p2 & 1); const unsigned tv = tot[rt][ct][p2];
                *(LAS unsigned short*)(patch + tr * 80 + r * 2) = (unsigned short)(tv & 0xffffu); *(LAS unsigned short*)(patch + (tr + 1) * 80 + r * 2) = (unsigned short)(tv >> 16); }
#pragma unroll
            for (int j = 0; j < 2; ++j) { const int p = lane + 64 * j; const u32x4 ov = *(LAS const u32x4*)(patch + (p >> 2) * 80 + (p & 3) * 16);
                *(u32x4*)(mix + ((unsigned)(tok0 + (p >> 2)) * 1024u + (unsigned)(n0 + 8 * (p & 3)))) = ov; } }
}

#define LAUNDER_S(x) asm volatile("" : "+s"(x))
#define GAS __attribute__((address_space(1)))
#define INP(k) ({ int k_ = (k); LAUNDER_S(k_); (const float*)(const GAS float*)P.in[k_]; })
#define POUT ((float*)(GAS float*)P.out)
#define PHASE_BEGIN int L = layer; LAUNDER_S(L); GAS unsigned char* wsg_ = (GAS unsigned char*)P.ws; LAUNDER_S(wsg_); unsigned char* ws = (unsigned char*)wsg_; int G = gridDim.x, bx = blockIdx.x; LAUNDER_S(G); LAUNDER_S(bx); int tid = threadIdx.x; asm volatile("" : "+v"(tid)); const int lane = tid & 63, wave = __builtin_amdgcn_readfirstlane(tid >> 6); (void)lane; (void)wave; (void)G; (void)bx; (void)L; (void)ws;
__global__ void __launch_bounds__(512, 2) hybrid_fwd(Params P) {
    extern __shared__ __attribute__((aligned(16))) unsigned char lds_raw[];
    LAS unsigned char* lds = (LAS unsigned char*)lds_raw;
    cg::grid_group grid = cg::this_grid();
#pragma unroll 1
    for (int layer = 0; layer < 2; ++layer) {
#ifndef REP_A
#define REP_A 1
#endif
#ifndef REP_CD
#define REP_CD 1
#endif
        for (int repa_ = 0; repa_ < REP_A; ++repa_)
        { PHASE_BEGIN
            const int gtid = bx * 512 + tid, gthreads = G * 512, gwave = bx * 8 + wave, nwaves = G * 8;
            prep_w<1>(INP(3) + (size_t)L * DM * NIN, DM, NIN, (bf16_t*)(ws + WS_WIN), NINP, DM, lds, tid, bx, G, L == 0 ? (const float*)nullptr : INP(2) + L * DM);
            prep_w<3>(INP(11) + (size_t)L * DM * DM, DM, DM, (bf16_t*)(ws + WS_WBR), DM, DM, lds, tid, bx, G);
            prep_w<0>(INP(12) + (size_t)L * DM * DM, DM, DM, (bf16_t*)(ws + WS_WOUT), DM, DM, lds, tid, bx, G);
            prep_w<2>(INP(14) + (size_t)L * DM * 2 * DFF, DM, 2 * DFF, (bf16_t*)(ws + WS_WGU), 2 * DFF, DM, lds, tid, bx, G, INP(13) + L * DM);
            for (int i = gtid; i < MTOK; i += gthreads) { ((float*)(ws + WS_SMALL + 262144))[i] = 0.f; if (L == 0) ((float*)(ws + WS_SMALL + 393216))[i] = 0.f; }
            prep_w<0>(INP(15) + (size_t)L * DFF * DM, DFF, DM, (bf16_t*)(ws + WS_WDN), DM, DFF, lds, tid, bx, G);
            const float* cw1 = INP(9) + (size_t)L * 2 * 2048 * 256;
            prep_w<0>(cw1, 2048, 256, (bf16_t*)(ws + WS_WC1), 256, 2048, lds, tid, bx, G);
            prep_w<0>(cw1 + 2048 * 256, 2048, 256, (bf16_t*)(ws + WS_WC1) + 256 * 2048, 256, 2048, lds, tid, bx, G);
            if (L == 0) rmsnorm_rows(INP(0), INP(2), (bf16_t*)(ws + WS_H), gwave, nwaves, lane);
            if (gwave < 512) { const int kv = gwave >> 8, j = gwave & 255; const float* pp = INP(8) + (size_t)L * 2 * 2048 + kv * 2048; const float* ww = cw1 + (size_t)kv * 2048 * 256 + j; float a = 0.f;
#pragma unroll 8
                for (int i = lane; i < 2048; i += 64) a = fmaf(pp[i], ww[(size_t)i * 256], a);
                a = wave_sum(a);
                if (lane == 0) ((float*)(ws + WS_SMALL))[kv * 256 + j] = a; }
            if (bx == 1 && tid < 384) { float* nw = (float*)(ws + WS_SMALL + 2048); const float v = tid < 64 ? (INP(4) + L * 64)[tid] : (tid < 128 ? (INP(5) + L * 64)[tid - 64] : (tid < 192 ? (INP(6) + L * 64)[tid - 128] : (INP(7) + L * 192)[tid - 192])); nw[tid] = v; }
        }
        grid.sync();

        { PHASE_BEGIN
            pg8::Gemm g{L == 0 ? (const bf16_t*)(ws + WS_H) : (const bf16_t*)POUT, (const bf16_t*)(ws + WS_WIN), MTOK, NINP, DM, DM, DM}; pg8::StaticOrder S; S.init(MTOK, NINP, G, bx);
            EpiInproj E{ws, (const float*)(ws + WS_SMALL + 2048), L == 0 ? (const float*)nullptr : (const float*)(ws + WS_SMALL + 393216)};
#ifndef SKIP_B
            pg8::gemm_phase<EpiInproj, pg8::StaticOrder, true, true>(lds, g, S, E, tid);
#endif
        }
        grid.sync();

        for (int repcd_ = 0; repcd_ < REP_CD; ++repcd_) {
        { PHASE_BEGIN
            if (bx < 128) { const int kv = bx >> 6, ks = (bx >> 4) & 3;
                pg8::Gemm g{(const bf16_t*)(ws + WS_B + (kv ? HB_VCR : HB_KCR) * MiB) + ks * 512, (const bf16_t*)(ws + WS_WC1) + (size_t)kv * 256 * 2048 + ks * 512, 4096, 256, 512, 1024, 2048};
                pg8::StaticOrder S; S.init(4096, 256, G, bx & 15);
                EpiStoreF32 E{(float*)(ws + WS_H) + (size_t)(kv * 4 + ks) * 4096 * 256};
#ifndef SKIP_C
                pg8::gemm_phase<EpiStoreF32, pg8::StaticOrder, true, true>(lds, g, S, E, tid);
#endif
            } else {
                const bf16_t* mbk = (const bf16_t*)(ws + WS_B + HB_MBK * MiB); float* KMEAN = (float*)(ws + WS_SMALL + 4096);
                for (int item = (bx - 128) * 8 + wave; item < 512; item += (G - 128) * 8) { const int bh = item >> 5, n = item & 31;
                    const bf16_t* kp = mbk + ((size_t)bh * SEQ + 256 * n) * 64 + lane; float a = 0.f;
#pragma unroll 8
                    for (int j = 0; j < 256; ++j) a += bf2f(kp[(size_t)j * 64]);
                    KMEAN[(size_t)item * 64 + lane] = a * (1.0f / 256.0f); }
            }
        }
        grid.sync();

        { PHASE_BEGIN
            const int gwave = bx * 8 + wave, nwaves = G * 8;
            const float* cw2 = INP(10) + (size_t)L * 2 * 256 * 64; const float* nkn = INP(7) + L * 192;
            bf16_t* KC = (bf16_t*)(ws + WS_KC); bf16_t* VCT = (bf16_t*)(ws + WS_VCT);
            for (int row = gwave; row < 8192; row += nwaves) { const int kv = row >> 12, rr = row & 4095, bg = rr >> 9, n = rr & 511;
                f32x4 hv = *(const f32x4*)((const float*)(ws + WS_SMALL) + kv * 256 + 4 * lane);
                { const float* pp = (const float*)(ws + WS_H) + ((size_t)(kv * 4) * 4096 + rr) * 256 + 4 * lane;
#pragma unroll
                    for (int ks = 0; ks < 4; ++ks) hv += *(const f32x4*)(pp + (size_t)ks * 4096 * 256);
#pragma unroll
                    for (int e = 0; e < 4; ++e) { const float t = hv[e], z = 0.7978845608028654f * (t + 0.044715f * t * t * t);
                        const float th = 1.0f - 2.0f * __builtin_amdgcn_rcpf(1.0f + __expf(2.0f * z)); hv[e] = 0.5f * t * (1.0f + th); } }
                const float* wp = cw2 + (size_t)kv * 256 * 64 + lane; float a = 0.f;
#pragma unroll
                for (int k = 0; k < 256; ++k) { const float hk = __uint_as_float(__builtin_amdgcn_readlane(__float_as_uint(hv[k & 3]), k >> 2)); a = fmaf(hk, wp[k * 64], a); }
                if (kv == 0) { const float ss = wave_sum(a * a); float y = a * __builtin_amdgcn_rsqf(ss * (1.0f / 64.0f) + 1e-6f) * nkn[lane]; if (n == 511) y = 0.f;
                    KC[((size_t)bg * 512 + n) * 64 + lane] = (bf16_t)(pk2(y, 0.f) & 0xffffu); }
                else { if (n == 511) a = 0.f; VCT[((size_t)bg * 64 + lane) * 512 + n] = (bf16_t)(pk2(a, 0.f) & 0xffffu); } }
        }
        grid.sync();

        }
        { PHASE_BEGIN
            LAS unsigned* misc = (LAS unsigned*)(lds + ATT_MISC); LAS float* btab = (LAS float*)(lds + ATT_BT);
            const float* rel_bias = INP(1);
            __syncthreads();
            if (wave == 0) { const float* mqn = INP(4) + L * 64; const float* mkn = INP(5) + L * 64; const float* nqn = INP(6) + L * 64; const float* nkn = INP(7) + L * 192;
                float gq = fmaxf(fabsf(mqn[lane]), fabsf(nqn[lane])); float gk = fmaxf(fmaxf(fabsf(mkn[lane]), fabsf(nkn[lane])), fmaxf(fabsf(nkn[64 + lane]), fabsf(nkn[128 + lane])));
                float bm = 0.f;
#pragma unroll
                for (int i = 0; i < 6; ++i) bm = fmaxf(bm, fabsf(rel_bias[lane + 64 * i]));
                gq = wave_max(gq); gk = wave_max(gk); bm = wave_max(bm);
                if (lane == 0) ((LAS float*)misc)[2] = 8.0f * gq * gk + bm; }
            __syncthreads();
            const float shift = ((LAS float*)misc)[2];
            for (int i = tid; i < 12 * BT_N; i += 512) { const int hd = i / BT_N, jx = i - hd * BT_N; const int d = jx - 64;
                float v = -3.0e38f;
                if (d >= 0) { int bk; if (d < 16) bk = d; else if (d >= 128) bk = 31; else { bk = 16 + (int)(__log2f((float)d * (1.0f / 16.0f)) * (16.0f / 3.0f)); bk = bk > 31 ? 31 : bk; }
                    v = (rel_bias[bk * 12 + hd] - shift) * L2E; }
                btab[i] = v; }
            __syncthreads();
#ifndef REP_E
#define REP_E 1
#endif
            for (int rep_ = 0; rep_ < REP_E; ++rep_) {
            unsigned* ctl = (unsigned*)(ws + WS_CTL) + L + 2 * rep_;
            unsigned char* HBUF = ws + WS_B; bf16_t* OMIX = (bf16_t*)(ws + WS_H);
            for (;;) {
                __syncthreads();
                if (tid == 0) misc[0] = atomicAdd(ctl, 1u);
                __syncthreads();
                const int u = (int)misc[0];
                if (u >= 2048) break;
                int tidu = tid; asm volatile("" : "+v"(tidu));
                if (u < 1024) { const int c = 127 - (u >> 3), bg = u & 7;
#ifndef SKIP_NSA
                    nsa_unit(lds, HBUF, (const bf16_t*)(ws + WS_KC), (const bf16_t*)(ws + WS_VCT), (const float*)(ws + WS_NSG), OMIX, bg >> 1, bg & 1, c, tidu);
#endif
                }
                else if (u < 1536) { const int v = u - 1024;
#ifndef SKIP_MOBA
                    moba_unit(lds, HBUF, (const float*)(ws + WS_SMALL + 4096), OMIX, (v & 15) >> 2, v & 3, 31 - (v >> 4), tidu);
#endif
                }
                else { const int v = u - 1536;
#ifndef SKIP_SB
                    sb_unit(lds, HBUF, OMIX, (v & 15) >> 2, v & 3, 31 - (v >> 4), tidu);
#endif
                }
            }
            }
        }
        grid.sync();

        { PHASE_BEGIN
            for (int it = bx; it < 256; it += G)
                for (int i = 0; i < 4; ++i) { int tidu = tid; asm volatile("" : "+v"(tidu));
                    branch_tile(lds, (const bf16_t*)(ws + WS_H), (const bf16_t*)(ws + WS_WBR), (const bf16_t*)(ws + WS_A), (bf16_t*)(ws + WS_B), it >> 1, 4 * (it & 1) + i, tidu); }
        }
        grid.sync();

        { PHASE_BEGIN
            pg8::Gemm g{(const bf16_t*)(ws + WS_B), (const bf16_t*)(ws + WS_WOUT), MTOK, DM, DM, DM, DM}; pg8::StaticOrder S; S.init(MTOK, DM, G, bx);
            if (L == 0) { EpiResNormB E{INP(0), (bf16_t*)(ws + WS_H), (float*)(ws + WS_SMALL + 262144)};
                pg8::gemm_phase<EpiResNormB, pg8::StaticOrder, true, true>(lds, g, S, E, tid); }
            else { EpiResNormBB E{(const bf16_t*)POUT, (bf16_t*)(ws + WS_H), (float*)(ws + WS_SMALL + 262144)};
                pg8::gemm_phase<EpiResNormBB, pg8::StaticOrder, true, true>(lds, g, S, E, tid); }
        }
        grid.sync();

        { PHASE_BEGIN
            pg8::Gemm g{(const bf16_t*)(ws + WS_H), (const bf16_t*)(ws + WS_WGU), MTOK, 2 * DFF, DM, DM, DM}; pg8::StaticOrder S; S.init(MTOK, 2 * DFF, G, bx); EpiSwiglu E{(bf16_t*)(ws + WS_A), (const float*)(ws + WS_SMALL + 262144)};
#ifndef SKIP_I
            pg8::gemm_phase<EpiSwiglu, pg8::StaticOrder, true, true>(lds, g, S, E, tid);
#endif
        }
        grid.sync();

        { PHASE_BEGIN
            pg8::Gemm g{(const bf16_t*)(ws + WS_A), (const bf16_t*)(ws + WS_WDN), MTOK, DM, DFF, DFF, DFF}; pg8::StaticOrder S; S.init(MTOK, DM, G, bx); if (L == 0) { EpiResNormBB E{(const bf16_t*)(ws + WS_H), (bf16_t*)POUT, (float*)(ws + WS_SMALL + 393216)};
                pg8::gemm_phase<EpiResNormBB, pg8::StaticOrder, true, true>(lds, g, S, E, tid); }
            else { EpiResB E{(const bf16_t*)(ws + WS_H), POUT};
                pg8::gemm_phase<EpiResB, pg8::StaticOrder, true, true>(lds, g, S, E, tid); }
        }
        if (layer == 0) grid.sync();
    }
}

extern "C" void kernel_launch(void* const* d_in, const int* in_sizes, int n_in, void* d_out, int out_size, void* d_ws, size_t ws_size, hipStream_t stream) {
    static int grid = 0;
    if (grid == 0) {
        if (n_in != 16 || out_size != MTOK * DM || ws_size < WS_END) { fprintf(stderr, "kernel_launch: unexpected shapes (n_in %d out %d ws %zu, need ws >= %zu)\n", n_in, out_size, ws_size, (size_t)WS_END); grid = -1; return; }
        int dev = 0, cus = 0, per_cu = 0;
        hipGetDevice(&dev); hipDeviceGetAttribute(&cus, hipDeviceAttributeMultiprocessorCount, dev);
        if (hipFuncSetAttribute((const void*)hybrid_fwd, hipFuncAttributeMaxDynamicSharedMemorySize, LDS_BYTES) != hipSuccess) { fprintf(stderr, "kernel_launch: hipFuncSetAttribute failed\n"); grid = -1; return; }
        if (hipOccupancyMaxActiveBlocksPerMultiprocessor(&per_cu, (const void*)hybrid_fwd, 512, LDS_BYTES) != hipSuccess || per_cu < 1) { fprintf(stderr, "kernel_launch: occupancy query gave %d\n", per_cu); per_cu = 1; }
        (void)hipGetLastError();
        grid = cus * 1;
    }
    if (grid < 0) return;
    hipMemsetAsync((char*)d_ws + WS_CTL, 0, 4096, stream);
    Params p{};
    for (int i = 0; i < 16; ++i) p.in[i] = (const float*)d_in[i];
    p.out = (float*)d_out; p.ws = (unsigned char*)d_ws;
    void* args[] = {&p};
    hipError_t e = hipLaunchCooperativeKernel((const void*)hybrid_fwd, dim3(grid), dim3(512), args, LDS_BYTES, stream);
    if (e != hipSuccess) fprintf(stderr, "cooperative launch failed: %s (grid %d)\n", hipGetErrorString(e), grid);
}
```
